# Optimizing an MI355X kernel written in HIP

```python
import jax
import jax.numpy as jnp
from jax import lax
import numpy as np

D_MODEL = 1024
BATCH = 8
SEQ = 4096
DEPTH = 4

GRID_W = 64
CTX_LEN = 256
EPS = 1e-6
ROPE_THETA = 10000.0
NEG_BIG = -1e30
F_FLOOR = 1e-20

HEAD_DIM = D_MODEL // 16
GROUP_HEADS = 4
GROUP_W = GROUP_HEADS * HEAD_DIM
D_MIX = 4 * GROUP_W

MLA_H = GROUP_HEADS
MLA_Q_LORA = 3 * D_MODEL // 16
MLA_KV_LORA = D_MODEL // 8
MLA_NOPE = HEAD_DIM
MLA_ROPE = HEAD_DIM // 2
MLA_V = HEAD_DIM
MLA_SCALE = (MLA_NOPE + MLA_ROPE) ** -0.5
ATTN_BLOCK = 128
NA_H = GROUP_HEADS
NA_KH_MAX = 8
NA_KW = 16
NA_SCALE = HEAD_DIM ** -0.5
RET_H = GROUP_HEADS
RET_DK = HEAD_DIM
RET_DV = HEAD_DIM
RET_CHUNK = 128
HG_H = GROUP_HEADS
HG_DK = HEAD_DIM
HG_DV = HEAD_DIM
HG_CHUNK = 16
MOE_GROUPS = 4
MOE_PER_GROUP = 8
MOE_EXPERTS = MOE_GROUPS * MOE_PER_GROUP
MOE_TOPK = 2
MOE_FF = D_MODEL // 2
MOE_BLOCK = 256

IN_SPLITS = (MLA_Q_LORA, MLA_KV_LORA, MLA_ROPE,
             NA_H * HEAD_DIM, NA_H * HEAD_DIM, NA_H * HEAD_DIM,
             RET_H * RET_DK, RET_H * RET_DK, RET_H * RET_DV, RET_H * RET_DV,
             HG_H * HG_DK, HG_H * HG_DK, HG_H * HG_DK, HG_H * HG_DV, HG_H * HG_DV)
P_TOT = sum(IN_SPLITS)

kernel_name = 'hybrid_mla_na_retnet_hgrn2_hmoe_dit'


def rms_norm(x, gain=None):
    x32 = x.astype(jnp.float32)
    y = x32 * lax.rsqrt(jnp.mean(jnp.square(x32), axis=-1, keepdims=True) + EPS)
    if gain is not None:
        y = y * gain.astype(jnp.float32)
    return y.astype(x.dtype)


def modulate(x, shift, scale):
    return rms_norm(x) * (1 + scale) + shift


def split_cols(p):
    offsets = [int(o) for o in np.cumsum(IN_SPLITS)[:-1]]
    return jnp.split(p, offsets, axis=-1)


def split_heads(t, n_heads):
    b, n, _ = t.shape
    return t.reshape(b, n, n_heads, -1).transpose(0, 2, 1, 3)


def flip_t(t):
    return jnp.flip(t, axis=2)


def gated_head_norm(o, g, gain):
    b, h, n, dv = o.shape
    return rms_norm(o.transpose(0, 2, 1, 3), gain).reshape(b, n, h * dv) * jax.nn.silu(g)


def axial_rope_tables(n_tokens):
    pos = jnp.arange(n_tokens)
    rows = (pos // GRID_W).astype(jnp.float32)
    cols = (pos % GRID_W).astype(jnp.float32)
    per_axis = MLA_ROPE // 2
    inv_freq = ROPE_THETA ** (-jnp.arange(0, per_axis, 2, dtype=jnp.float32) / per_axis)
    ang = jnp.concatenate([rows[:, None] * inv_freq, cols[:, None] * inv_freq], axis=-1)
    return jnp.cos(ang), jnp.sin(ang)


def _rotate_pairs(z, cos, sin):
    m = z.shape[-1] // 2
    z1, z2 = z[..., :m], z[..., m:]
    return jnp.concatenate([z1 * cos - z2 * sin, z2 * cos + z1 * sin], axis=-1)


def apply_axial_rope(x, cos, sin):
    half = x.shape[-1] // 2
    m = half // 2
    cos = cos.astype(x.dtype)
    sin = sin.astype(x.dtype)
    return jnp.concatenate([_rotate_pairs(x[..., :half], cos[..., :m], sin[..., :m]),
                            _rotate_pairs(x[..., half:], cos[..., m:], sin[..., m:])], axis=-1)


def mla_queries(cq, g_cq, w_uq, g_qn, g_qr):
    b, n, _ = cq.shape
    q = (rms_norm(cq, g_cq) @ w_uq).reshape(b, n, MLA_H, MLA_NOPE + MLA_ROPE)
    return rms_norm(q[..., :MLA_NOPE], g_qn), rms_norm(q[..., MLA_NOPE:], g_qr)


def mla_keys(ckv, kr, g_ckv, w_ukv, g_kn, g_kr):
    b, n, _ = ckv.shape
    kv = (rms_norm(ckv, g_ckv) @ w_ukv).reshape(b, n, MLA_H, MLA_NOPE + MLA_V)
    return rms_norm(kv[..., :MLA_NOPE], g_kn), rms_norm(kr, g_kr), kv[..., MLA_NOPE:]


def mla_scores(q_nope, q_rope, k_nope, k_rope):
    s = jnp.einsum('bqhd,bkhd->bhqk', q_nope, k_nope) + jnp.einsum('bqhr,bkr->bhqk', q_rope, k_rope)
    return s.astype(jnp.float32) * MLA_SCALE


def mla_mixer(lat, ctx, cos, sin, q_prm, k_prm, with_ctx_out):
    cq, ckv, kr = lat
    cq_c, ckv_c, kr_c = ctx
    qn, qr = mla_queries(cq, *q_prm)
    kn, kr, v = mla_keys(ckv, kr, *k_prm)
    kn_c, kr_c, v_c = mla_keys(ckv_c, kr_c, *k_prm)
    qr = apply_axial_rope(qr, cos[:, None, :], sin[:, None, :])
    kr = apply_axial_rope(kr, cos, sin)
    b, n = qn.shape[:2]
    nb = n // ATTN_BLOCK

    def to_blocks(t):
        return jnp.moveaxis(t.reshape(b, nb, ATTN_BLOCK, *t.shape[2:]), 1, 0)

    def attend_block(blk):
        qn_b, qr_b = blk
        s = jnp.concatenate([mla_scores(qn_b, qr_b, kn, kr), mla_scores(qn_b, qr_b, kn_c, kr_c)], axis=-1)
        p = jax.nn.softmax(s, axis=-1).astype(v.dtype)
        return (jnp.einsum('bhqk,bkhd->bqhd', p[..., :n], v)
                + jnp.einsum('bhqk,bkhd->bqhd', p[..., n:], v_c))

    o = lax.map(attend_block, (to_blocks(qn), to_blocks(qr)))
    y = jnp.moveaxis(o, 0, 1).reshape(b, n, MLA_H * MLA_V)
    if not with_ctx_out:
        return y, None
    qn_c, qr_c = mla_queries(cq_c, *q_prm)
    p_c = jax.nn.softmax(mla_scores(qn_c, qr_c, kn_c, kr_c), axis=-1).astype(v_c.dtype)
    y_c = jnp.einsum('bhqk,bkhd->bqhd', p_c, v_c).reshape(b, v_c.shape[1], MLA_H * MLA_V)
    return y, y_c


def na_mixer(lat, ctx, rows, g_q, g_k, rpb, with_ctx_out):
    q, k, v = lat
    qc, kc, vc = ctx
    b, n, _ = q.shape
    kh = min(NA_KH_MAX, rows)
    kw = min(NA_KW, GRID_W)

    def heads(t):
        return t.reshape(t.shape[0], t.shape[1], NA_H, HEAD_DIM)

    qg = rms_norm(heads(q), g_q).reshape(b, rows, GRID_W, NA_H, HEAD_DIM)
    kg = rms_norm(heads(k), g_k).reshape(b, rows, GRID_W, NA_H, HEAD_DIM)
    vg = heads(v).reshape(b, rows, GRID_W, NA_H, HEAD_DIM)
    k_c = rms_norm(heads(kc), g_k)
    v_c = heads(vc)
    r = jnp.arange(rows)
    w = jnp.arange(GRID_W)
    row_idx = jnp.clip(r - kh // 2, 0, rows - kh)[:, None] + jnp.arange(kh)[None, :]
    col_start = jnp.clip(w - kw // 2, 0, GRID_W - kw)
    col_valid = (w[None, :] >= col_start[:, None]) & (w[None, :] < col_start[:, None] + kw)
    k_band = kg[:, row_idx]
    v_band = vg[:, row_idx]
    dr = row_idx - r[:, None] + (NA_KH_MAX - 1)
    dc = jnp.clip(w[None, :] - w[:, None], 1 - kw, kw - 1) + (NA_KW - 1)
    bias = rpb[:, dr[:, None, :, None], dc[None, :, None, :]].astype(jnp.float32)
    s_win = jnp.einsum('brwhd,brkuhd->bhrwku', qg, k_band).astype(jnp.float32) * NA_SCALE + bias
    s_win = jnp.where(col_valid[:, None, :], s_win, NEG_BIG)
    s_ctx = jnp.einsum('brwhd,bchd->bhrwc', qg, k_c).astype(jnp.float32) * NA_SCALE
    n_win = kh * GRID_W
    s = jnp.concatenate([s_win.reshape(b, NA_H, rows, GRID_W, n_win), s_ctx], axis=-1)
    p = jax.nn.softmax(s, axis=-1).astype(vg.dtype)
    p_win = p[..., :n_win].reshape(b, NA_H, rows, GRID_W, kh, GRID_W)
    o = (jnp.einsum('bhrwku,brkuhd->brwhd', p_win, v_band)
         + jnp.einsum('bhrwc,bchd->brwhd', p[..., n_win:], v_c))
    y = o.reshape(b, n, NA_H * HEAD_DIM)
    if not with_ctx_out:
        return y, None
    q_c = rms_norm(heads(qc), g_q)
    p_c = jax.nn.softmax(jnp.einsum('bqhd,bkhd->bhqk', q_c, k_c).astype(jnp.float32) * NA_SCALE, axis=-1)
    y_c = jnp.einsum('bhqk,bkhd->bqhd', p_c.astype(v_c.dtype), v_c).reshape(b, qc.shape[1], NA_H * HEAD_DIM)
    return y, y_c


def retention_log_decays():
    j = jnp.arange(2 * RET_H, dtype=jnp.float32)
    lg = jnp.log1p(-jnp.exp2(-5.0 - j))
    return lg[0::2], lg[1::2]


def retention_scan(q, k, v, log_gamma, s0):
    b, h, n, dk = k.shape
    dv = v.shape[-1]
    dt = k.dtype
    cs = min(RET_CHUNK, n)
    nc = n // cs
    kc = k.reshape(b, h, nc, cs, dk)
    vc = v.reshape(b, h, nc, cs, dv)
    pos = jnp.arange(cs, dtype=jnp.float32)
    lg = log_gamma[:, None]
    k_w = jnp.exp((cs - 1 - pos)[None] * lg).astype(dt)
    d_state = jnp.einsum('bhncd,bhnce->bhnde', kc * k_w[None, :, None, :, None], vc)
    chunk_decay = jnp.exp(cs * log_gamma).astype(dt)[None, :, None, None]

    def step(s, ds):
        return chunk_decay * s + ds, s

    s_final, s_prev = lax.scan(step, s0, jnp.moveaxis(d_state, 2, 0))
    if q is None:
        return None, s_final
    qc = q.reshape(b, h, nc, cs, dk)
    diff = pos[:, None] - pos[None, :]
    decay = jnp.where(diff >= 0, jnp.exp(jnp.maximum(diff, 0.0)[None] * log_gamma[:, None, None]), 0.0).astype(dt)
    q_w = jnp.exp((pos + 1)[None] * lg).astype(dt)
    scores = jnp.einsum('bhntd,bhnsd->bhnts', qc, kc) * decay[None, :, None]
    o = (jnp.einsum('bhnts,bhnse->bhnte', scores, vc)
         + jnp.einsum('bhntd,bhnde->bhnte', qc * q_w[None, :, None, :, None], jnp.moveaxis(s_prev, 0, 2)))
    return o.reshape(b, h, n, dv), s_final


def retention_mixer(lat, ctx, g_out, with_ctx_out):
    q, k, v, g = lat
    qc, kc, vc, gc = ctx
    lg_f, lg_b = retention_log_decays()
    k_scale = RET_DK ** -0.5
    qh, kh, vh = split_heads(q, RET_H), split_heads(k, RET_H) * k_scale, split_heads(v, RET_H)
    qch = split_heads(qc, RET_H) if with_ctx_out else None
    kch, vch = split_heads(kc, RET_H) * k_scale, split_heads(vc, RET_H)
    zero = jnp.zeros((q.shape[0], RET_H, RET_DK, RET_DV), k.dtype)
    oc_f, s_f = retention_scan(qch, kch, vch, lg_f, zero)
    oc_b, s_b = retention_scan(None if qch is None else flip_t(qch), flip_t(kch), flip_t(vch), lg_b, zero)
    o_f, _ = retention_scan(qh, kh, vh, lg_f, s_f)
    o_b, _ = retention_scan(flip_t(qh), flip_t(kh), flip_t(vh), lg_b, s_b)
    y = gated_head_norm(o_f + flip_t(o_b), g, g_out)
    if not with_ctx_out:
        return y, None
    return y, gated_head_norm(oc_f + flip_t(oc_b), gc, g_out)


def hgrn2_log_forget(f_raw, lb):
    lb = lb.astype(jnp.float32)
    f = lb + (1.0 - lb) * jax.nn.sigmoid(f_raw.astype(jnp.float32))
    return split_heads(jnp.log(jnp.maximum(f, F_FLOOR)), HG_H)


def chunk_gla(q, k, v, log_f, s0):
    b, h, n, dk = k.shape
    dv = v.shape[-1]
    dt = k.dtype
    cs = min(HG_CHUNK, n)
    nc = n // cs
    kc = k.reshape(b, h, nc, cs, dk)
    vc = v.reshape(b, h, nc, cs, dv)
    a = jnp.cumsum(log_f.reshape(b, h, nc, cs, dk), axis=3)
    a_last = a[:, :, :, -1]
    k_state = kc * jnp.exp(a_last[:, :, :, None] - a).astype(dt)
    d_state = jnp.einsum('bhnsd,bhnse->bhnde', k_state, vc)
    chunk_decay = jnp.moveaxis(jnp.exp(a_last).astype(dt), 2, 0)[..., None]

    def step(s, inp):
        dec, ds = inp
        return dec * s + ds, s

    s_final, s_prev = lax.scan(step, s0, (chunk_decay, jnp.moveaxis(d_state, 2, 0)))
    if q is None:
        return None, s_final
    qc = q.reshape(b, h, nc, cs, dk)
    tri = jnp.tril(jnp.ones((cs, cs), bool))[:, :, None]
    rel = a[:, :, :, :, None, :] - a[:, :, :, None, :, :]
    decay = jnp.where(tri, jnp.exp(jnp.where(tri, rel, 0.0)), 0.0).astype(dt)
    scores = jnp.einsum('bhntd,bhnsd,bhntsd->bhnts', qc, kc, decay)
    o = (jnp.einsum('bhnts,bhnse->bhnte', scores, vc)
         + jnp.einsum('bhntd,bhnde->bhnte', qc * jnp.exp(a).astype(dt), jnp.moveaxis(s_prev, 0, 2)))
    return o.reshape(b, h, n, dv), s_final


def hgrn2_mixer(lat, ctx, lb, g_out, with_ctx_out):
    q, f_fw, f_bw, i, g = lat
    qc, fc_fw, fc_bw, ic, gc = ctx
    dt = q.dtype

    def gates(f_raw):
        lf = hgrn2_log_forget(f_raw, lb)
        return (-jnp.expm1(lf)).astype(dt), lf

    qh, vh = split_heads(jax.nn.silu(q), HG_H), split_heads(i, HG_H)
    k_f, lf_f = gates(f_fw)
    k_b, lf_b = gates(f_bw)
    qch = split_heads(jax.nn.silu(qc), HG_H) if with_ctx_out else None
    vch = split_heads(ic, HG_H)
    kc_f, lfc_f = gates(fc_fw)
    kc_b, lfc_b = gates(fc_bw)
    zero = jnp.zeros((q.shape[0], HG_H, HG_DK, HG_DV), dt)
    oc_f, s_f = chunk_gla(qch, kc_f, vch, lfc_f, zero)
    oc_b, s_b = chunk_gla(None if qch is None else flip_t(qch), flip_t(kc_b), flip_t(vch), flip_t(lfc_b), zero)
    o_f, _ = chunk_gla(qh, k_f, vh, lf_f, s_f)
    o_b, _ = chunk_gla(flip_t(qh), flip_t(k_b), flip_t(vh), flip_t(lf_b), s_b)
    y = gated_head_norm(o_f + flip_t(o_b), g, g_out)
    if not with_ctx_out:
        return y, None
    return y, gated_head_norm(oc_f + flip_t(oc_b), gc, g_out)


def hier_moe(h, w_rg, b_rg, w_re, b_re, w1, w3, w2):
    n, d = h.shape
    p_group = jax.nn.softmax((h @ w_rg + b_rg).astype(jnp.float32), axis=-1)
    pg_top, g_idx = lax.top_k(p_group, 1)
    fine = (h @ w_re + b_re).astype(jnp.float32).reshape(n, MOE_GROUPS, MOE_PER_GROUP)
    fine = fine[jnp.arange(n), g_idx[:, 0]]
    pe_top, e_local = lax.top_k(jax.nn.softmax(fine, axis=-1), MOE_TOPK)
    gate = pg_top * pe_top / jnp.sum(pe_top, axis=-1, keepdims=True)
    expert = g_idx * MOE_PER_GROUP + e_local

    n_assign = n * MOE_TOPK
    flat_e = expert.reshape(-1)
    flat_tok = jnp.repeat(jnp.arange(n, dtype=jnp.int32), MOE_TOPK)
    flat_gate = gate.reshape(-1).astype(h.dtype)
    order = jnp.argsort(flat_e)
    e_sorted = flat_e[order]
    counts = jnp.zeros((MOE_EXPERTS,), jnp.int32).at[flat_e].add(1)
    start = jnp.cumsum(counts) - counts
    padded = (counts + MOE_BLOCK - 1) // MOE_BLOCK * MOE_BLOCK
    pad_end = jnp.cumsum(padded)
    pad_start = pad_end - padded
    dest = pad_start[e_sorted] + jnp.arange(n_assign, dtype=jnp.int32) - start[e_sorted]
    n_blocks = -(-n_assign // MOE_BLOCK) + MOE_EXPERTS
    n_rows = n_blocks * MOE_BLOCK
    row_tok = jnp.full((n_rows,), n, jnp.int32).at[dest].set(flat_tok[order])
    row_gate = jnp.zeros((n_rows,), h.dtype).at[dest].set(flat_gate[order])
    block_expert = jnp.minimum(
        jnp.searchsorted(pad_end, jnp.arange(n_blocks, dtype=jnp.int32) * MOE_BLOCK, side='right'),
        MOE_EXPERTS - 1)
    h_pad = jnp.concatenate([h, jnp.zeros((1, d), h.dtype)], axis=0)
    x_rows = h_pad[row_tok].reshape(n_blocks, MOE_BLOCK, d)

    def expert_block(args):
        xb, e = args
        return (jax.nn.silu(xb @ w1[e]) * (xb @ w3[e])) @ w2[e]

    y_rows = lax.map(expert_block, (x_rows, block_expert)).reshape(n_rows, d) * row_gate[:, None]
    return jnp.zeros((n + 1, d), h.dtype).at[row_tok].add(y_rows)[:n]


def setup_inputs(seed: int = 0) -> dict:
    key = jax.random.key(seed)
    ks = iter(jax.random.split(key, 32))
    f32 = jnp.float32
    L, D = DEPTH, D_MODEL

    def nrm(shape, scale):
        return jax.random.normal(next(ks), shape, f32) * scale

    def gain(shape):
        return 1.0 + nrm(shape, 0.02)

    return {
        'x': nrm((BATCH, SEQ, D), 1.0),
        'c': nrm((BATCH, D), 1.0),
        'ctx': nrm((BATCH, CTX_LEN, D), 1.0),
        'c_ctx': nrm((D,), 1.0),
        'w_ada': nrm((L, D, 6 * D), 0.5 * D ** -0.5),
        'b_ada': nrm((L, 6 * D), 0.01),
        'w_in': nrm((L, D, P_TOT), D ** -0.5),
        'w_out': nrm((L, D_MIX, D), D_MIX ** -0.5),
        'mla_g_cq': gain((L, MLA_Q_LORA)),
        'mla_g_ckv': gain((L, MLA_KV_LORA)),
        'mla_w_uq': nrm((L, MLA_Q_LORA, MLA_H * (MLA_NOPE + MLA_ROPE)), MLA_Q_LORA ** -0.5),
        'mla_w_ukv': nrm((L, MLA_KV_LORA, MLA_H * (MLA_NOPE + MLA_V)), MLA_KV_LORA ** -0.5),
        'mla_g_qn': gain((L, MLA_NOPE)),
        'mla_g_qr': gain((L, MLA_ROPE)),
        'mla_g_kn': gain((L, MLA_NOPE)),
        'mla_g_kr': gain((L, MLA_ROPE)),
        'na_g_q': gain((L, HEAD_DIM)),
        'na_g_k': gain((L, HEAD_DIM)),
        'na_rpb': nrm((L, NA_H, 2 * NA_KH_MAX - 1, 2 * NA_KW - 1), 0.1),
        'ret_g_out': gain((L, RET_DV)),
        'hg_lb_raw': nrm((L, HG_H * HG_DK), 1.0),
        'hg_g_out': gain((L, HG_DV)),
        'moe_w_rg': nrm((L, D, MOE_GROUPS), D ** -0.5),
        'moe_b_rg': nrm((L, MOE_GROUPS), 0.01),
        'moe_w_re': nrm((L, D, MOE_EXPERTS), D ** -0.5),
        'moe_b_re': nrm((L, MOE_EXPERTS), 0.01),
        'moe_w1': nrm((L, MOE_EXPERTS, D, MOE_FF), D ** -0.5),
        'moe_w3': nrm((L, MOE_EXPERTS, D, MOE_FF), D ** -0.5),
        'moe_w2': nrm((L, MOE_EXPERTS, MOE_FF, D), MOE_FF ** -0.5),
    }


def reference(x, c, ctx, c_ctx, w_ada, b_ada, w_in, w_out, mla_g_cq, mla_g_ckv, mla_w_uq, mla_w_ukv,
              mla_g_qn, mla_g_qr, mla_g_kn, mla_g_kr, na_g_q, na_g_k, na_rpb, ret_g_out, hg_lb_raw,
              hg_g_out, moe_w_rg, moe_b_rg, moe_w_re, moe_b_re, moe_w1, moe_w3, moe_w2):
    b, n, d = x.shape
    n_ctx = ctx.shape[1]
    rows = n // GRID_W
    cos, sin = axial_rope_tables(n)
    lb_w = jax.nn.softmax(hg_lb_raw.astype(jnp.float32), axis=0)
    hg_lb = jnp.cumsum(lb_w, axis=0) - lb_w[0:1]
    silu_c = jax.nn.silu(c)
    silu_cc = jax.nn.silu(c_ctx)
    xc = ctx
    for l in range(DEPTH):
        last = l == DEPTH - 1
        mod = silu_c @ w_ada[l] + b_ada[l]
        mod_c = silu_cc @ w_ada[l] + b_ada[l]
        sh_a, sc_a, gt_a, sh_m, sc_m, gt_m = jnp.split(mod[:, None, :], 6, axis=-1)
        csh_a, csc_a, cgt_a, csh_m, csc_m, cgt_m = jnp.split(mod_c, 6)

        p = split_cols(modulate(x, sh_a, sc_a) @ w_in[l])
        pc = split_cols(modulate(xc, csh_a, csc_a) @ w_in[l])
        y_mla, yc_mla = mla_mixer(p[0:3], pc[0:3], cos, sin,
                                  (mla_g_cq[l], mla_w_uq[l], mla_g_qn[l], mla_g_qr[l]),
                                  (mla_g_ckv[l], mla_w_ukv[l], mla_g_kn[l], mla_g_kr[l]), not last)
        y_na, yc_na = na_mixer(p[3:6], pc[3:6], rows, na_g_q[l], na_g_k[l], na_rpb[l], not last)
        y_ret, yc_ret = retention_mixer(p[6:10], pc[6:10], ret_g_out[l], not last)
        y_hg, yc_hg = hgrn2_mixer(p[10:15], pc[10:15], hg_lb[l], hg_g_out[l], not last)
        x = x + gt_a * (jnp.concatenate([y_mla, y_na, y_ret, y_hg], axis=-1) @ w_out[l])

        moe_prm = (moe_w_rg[l], moe_b_rg[l], moe_w_re[l], moe_b_re[l], moe_w1[l], moe_w3[l], moe_w2[l])
        if last:
            h = modulate(x, sh_m, sc_m).reshape(b * n, d)
            x = x + gt_m * hier_moe(h, *moe_prm).reshape(b, n, d)
        else:
            xc = xc + cgt_a * (jnp.concatenate([yc_mla, yc_na, yc_ret, yc_hg], axis=-1) @ w_out[l])
            h = jnp.concatenate([modulate(x, sh_m, sc_m).reshape(b * n, d),
                                 modulate(xc, csh_m, csc_m).reshape(b * n_ctx, d)], axis=0)
            out = hier_moe(h, *moe_prm)
            x = x + gt_m * out[:b * n].reshape(b, n, d)
            xc = xc + cgt_m * out[b * n:].reshape(b, n_ctx, d)
    return x
```

```cpp
#ifndef CPU_EMU
#include <hip/hip_runtime.h>
#endif
#include <stdint.h>
#include <stddef.h>

#ifndef CFG_B
#define CFG_B 8
#define CFG_SEQ 4096
#define CFG_L 4
#define CFG_CTX 256
#endif

typedef _Float16 half_t;
typedef _Float16 half8 __attribute__((ext_vector_type(8)));
typedef _Float16 half4 __attribute__((ext_vector_type(4)));
typedef short s16x4 __attribute__((ext_vector_type(4)));
typedef float f32x4 __attribute__((ext_vector_type(4)));
typedef float f32x16 __attribute__((ext_vector_type(16)));

#ifdef CPU_EMU
#define DEV inline
#define SYNC() emu::block_sync()
#define WAVE_BARRIER() emu::wave_sync()
DEV f32x4 mfma16(half8 a, half8 b, f32x4 c) { return emu::mfma_16x16x32<half8, f32x4>(a, b, c); }
DEV f32x16 mfma32(half8 a, half8 b, f32x16 c) { return emu::mfma_32x32x16<half8, f32x16>(a, b, c); }
DEV f32x4 mfmaf(float a, float b, f32x4 c) { return emu::mfma_16x16x4_f32<f32x4>(a, b, c); }
DEV half4 tr16(const half_t* p) { return emu::ds_read_tr16<half4>((const void*)p); }
DEV float shfl_xor_f(float v, int m) { return emu::shfl_xor<float>(v, m); }
DEV float shfl_f(float v, int src) { return emu::shfl<float>(v, src); }
DEV int atomic_add_i(int* p, int v) { return __atomic_fetch_add(p, v, __ATOMIC_RELAXED); }
DEV float fexp2(float x) { return exp2f(x); }
DEV float fexp(float x) { return expf(x); }
DEV float flog(float x) { return logf(x); }
DEV float frsqrt(float x) { return 1.0f / sqrtf(x); }
#else
#define DEV __device__ __forceinline__
#define SYNC() __syncthreads()
#define WAVE_BARRIER() __builtin_amdgcn_wave_barrier()
#define LDSP __attribute__((address_space(3)))
DEV f32x4 mfma16(half8 a, half8 b, f32x4 c) { return __builtin_amdgcn_mfma_f32_16x16x32_f16(a, b, c, 0, 0, 0); }
DEV f32x16 mfma32(half8 a, half8 b, f32x16 c) { return __builtin_amdgcn_mfma_f32_32x32x16_f16(a, b, c, 0, 0, 0); }
DEV f32x4 mfmaf(float a, float b, f32x4 c) { return __builtin_amdgcn_mfma_f32_16x16x4f32(a, b, c, 0, 0, 0); }
DEV half4 tr16(const half_t* p) { s16x4 t = __builtin_amdgcn_ds_read_tr16_b64_v4i16((LDSP s16x4*)p); return __builtin_bit_cast(half4, t); }
DEV float shfl_xor_f(float v, int m) { return __shfl_xor(v, m, 64); }
DEV float shfl_f(float v, int src) { return __shfl(v, src, 64); }
DEV int atomic_add_i(int* p, int v) { return atomicAdd(p, v); }
DEV float fexp2(float x) { return __builtin_amdgcn_exp2f(x); }
DEV float fexp(float x) { return __expf(x); }
DEV float flog(float x) { return __logf(x); }
DEV float frsqrt(float x) { return __builtin_amdgcn_rsqf(x); }
#endif

#ifdef CPU_EMU
DEV int TID() { return (int)threadIdx.x; }
#else
DEV int TID() { int t = (int)threadIdx.x; asm volatile("" : "+v"(t)); return t; }
#endif
constexpr int B_ = CFG_B, SEQ = CFG_SEQ, NL = CFG_L, CTX = CFG_CTX, D = 1024;
constexpr int NLAT = B_ * SEQ, NCTX = B_ * CTX, NT = NLAT + NCTX;
constexpr int ROWS = SEQ / 64;
constexpr int KEYS = SEQ + CTX;
constexpr int PTOT = 3424, PPAD = 3456;
constexpr int O_CQ = 0, O_CKV = 192, O_KR = 320, O_NAQ = 352, O_NAK = 608, O_NAV = 864, O_RQ = 1120, O_RK = 1376, O_RV = 1632, O_RG = 1888,
              O_HQ = 2144, O_HF = 2400, O_HB = 2656, O_HI = 2912, O_HG = 3168;
constexpr int NCH = KEYS / 64, CG = CTX / 64, LG = SEQ / 64;
constexpr int NEXP = 32, ACT_ROWS = 2 * NT + NEXP * 128;
constexpr float EPS = 1e-6f;
constexpr float LOG2E = 1.4426950408889634f;
constexpr int MODW = 6 * D;
constexpr int NTHREADS = 256;
constexpr int SMEM_BYTES = 36864;

struct Params {
    const float *x, *c, *ctx, *c_ctx, *w_ada, *b_ada, *w_in, *w_out, *mla_g_cq, *mla_g_ckv, *mla_w_uq, *mla_w_ukv, *mla_g_qn, *mla_g_qr, *mla_g_kn,
        *mla_g_kr, *na_g_q, *na_g_k, *na_rpb, *ret_g_out, *hg_lb_raw, *hg_g_out, *moe_w_rg, *moe_b_rg, *moe_w_re, *moe_b_re, *moe_w1, *moe_w3, *moe_w2;
    float* out;
    unsigned* bar;
    float *xc, *mod, *hglb, *wr, *cshift, *list_gate, *gst, *gdec;
    int *cnt, *list_tok, *tokslot;
    half_t *win16, *wout16, *wuq16, *wukv16, *h, *p, *y, *qraw, *kvraw, *mq, *mk, *mv, *nq, *nk, *nv, *act, *yrows;
};

#ifdef CPU_EMU
typedef const Params CP;
#else
typedef const __attribute__((address_space(4))) Params CP;
#endif
DEV int tok_brow(int t) { return t < NLAT ? t / SEQ : B_; }
DEV float* xrow_ptr(CP& P, int t) { return t < NLAT ? P.out + (size_t)t * D : P.xc + (size_t)(t - NLAT) * D; }
DEV float silu_f(float x) { return x / (1.0f + fexp(-x)); }
DEV float sigmoid_f(float x) { return 1.0f / (1.0f + fexp(-x)); }
DEV float wave_sum(float v) {
    v += shfl_xor_f(v, 1); v += shfl_xor_f(v, 2); v += shfl_xor_f(v, 4); v += shfl_xor_f(v, 8); v += shfl_xor_f(v, 16); v += shfl_xor_f(v, 32);
    return v;
}
DEV half4 to_half4(f32x4 v) { half4 r; r[0] = (half_t)v[0]; r[1] = (half_t)v[1]; r[2] = (half_t)v[2]; r[3] = (half_t)v[3]; return r; }

constexpr int LDA_S = 72, LDB_S = 136;
struct BSrcH {
    const half_t* base; int ld;
    typedef half8 Raw;
    DEV Raw load(int k, int n) const { return *(const half8*)(base + (size_t)k * ld + n); }
    DEV half8 cvt(const Raw& r) const { return r; }
};
struct RawF { f32x4 a, b; };
DEV half8 cvt_rawf(const RawF& r) {
    half8 h; h[0] = (half_t)r.a[0]; h[1] = (half_t)r.a[1]; h[2] = (half_t)r.a[2]; h[3] = (half_t)r.a[3];
    h[4] = (half_t)r.b[0]; h[5] = (half_t)r.b[1]; h[6] = (half_t)r.b[2]; h[7] = (half_t)r.b[3]; return h;
}
struct BSrcF {
    const float* base; int ld;
    typedef RawF Raw;
    DEV Raw load(int k, int n) const { const float* s = base + (size_t)k * ld + n; RawF r; r.a = *(const f32x4*)s; r.b = *(const f32x4*)(s + 4); return r; }
    DEV half8 cvt(const Raw& r) const { return cvt_rawf(r); }
};
struct BSrcF2 {
    const float *b0, *b1; int ld;
    typedef RawF Raw;
    DEV Raw load(int k, int n) const { const float* s = (n < 64 ? b0 + n : b1 + (n - 64)) + (size_t)k * ld; RawF r; r.a = *(const f32x4*)s; r.b = *(const f32x4*)(s + 4); return r; }
    DEV half8 cvt(const Raw& r) const { return cvt_rawf(r); }
};
DEV half8 trfrag16(const half_t* Bs, int ld, int k0, int n0, int lane) {
    const int g = lane >> 4, i = lane & 15, q = i >> 2, pp = i & 3;
    const half4 lo = tr16(Bs + (k0 + 8 * g + q) * ld + n0 + 4 * pp);
    const half4 hi = tr16(Bs + (k0 + 8 * g + 4 + q) * ld + n0 + 4 * pp);
    half8 r; r[0] = lo[0]; r[1] = lo[1]; r[2] = lo[2]; r[3] = lo[3]; r[4] = hi[0]; r[5] = hi[1]; r[6] = hi[2]; r[7] = hi[3]; return r;
}
template <class ARow, class BS, class Epi>
DEV void gemm128(const ARow& arow, const BS& bs, int K, Epi& epi, unsigned char* smem) {
    half_t* As = (half_t*)smem;
    half_t* Bs = As + 128 * LDA_S;
    const int tid = TID(), lane = tid & 63, w = tid >> 6, g = lane >> 4, li = lane & 15;
    const int ar = tid >> 3, akc = (tid & 7) * 8, bk = tid >> 4, bn = (tid & 15) * 8;
    const half_t* ap[4];
#pragma unroll
    for (int i = 0; i < 4; ++i) ap[i] = arow(ar + 32 * i) + akc;
    half8 pa[4]; typename BS::Raw pb[4];
#pragma unroll
    for (int i = 0; i < 4; ++i) { pa[i] = *(const half8*)(ap[i]); pb[i] = bs.load(bk + 16 * i, bn); }
    f32x4 acc[2][8];
#pragma unroll
    for (int mt = 0; mt < 2; ++mt)
#pragma unroll
        for (int nt = 0; nt < 8; ++nt) acc[mt][nt] = (f32x4){0.f, 0.f, 0.f, 0.f};
    for (int k0 = 0; k0 < K; k0 += 64) {
        SYNC();
#pragma unroll
        for (int i = 0; i < 4; ++i) {
            *(half8*)(As + (ar + 32 * i) * LDA_S + akc) = pa[i];
            *(half8*)(Bs + (bk + 16 * i) * LDB_S + bn) = bs.cvt(pb[i]);
        }
        SYNC();
        if (k0 + 64 < K) {
#pragma unroll
            for (int i = 0; i < 4; ++i) { pa[i] = *(const half8*)(ap[i] + k0 + 64); pb[i] = bs.load(k0 + 64 + bk + 16 * i, bn); }
        }
#pragma unroll
        for (int ks = 0; ks < 2; ++ks) {
            half8 af[2];
#pragma unroll
            for (int mt = 0; mt < 2; ++mt) af[mt] = *(const half8*)(As + (32 * w + 16 * mt + li) * LDA_S + 32 * ks + 8 * g);
#pragma unroll
            for (int nt = 0; nt < 8; ++nt) {
                const half8 bf = trfrag16(Bs, LDB_S, 32 * ks, 16 * nt, lane);
#pragma unroll
                for (int mt = 0; mt < 2; ++mt) acc[mt][nt] = mfma16(af[mt], bf, acc[mt][nt]);
            }
        }
    }
    epi.run(acc, w, g, li);
}
struct ARowLin { const half_t* base; int ld; DEV const half_t* operator()(int r) const { return base + (size_t)r * ld; } };
struct ARowGather { const half_t* base; int ld; const int* idx; int nvalid; DEV const half_t* operator()(int r) const { const int t = r < nvalid ? idx[r] : 0; return base + (size_t)t * ld; } };

struct EpiStoreH {
    half_t* out; int ld;
    DEV void run(const f32x4 (&acc)[2][8], int w, int g, int li) const {
#pragma unroll
        for (int mt = 0; mt < 2; ++mt)
#pragma unroll
            for (int nt = 0; nt < 8; ++nt)
#pragma unroll
                for (int r = 0; r < 4; ++r) out[(size_t)(32 * w + 16 * mt + 4 * g + r) * ld + 16 * nt + li] = (half_t)acc[mt][nt][r];
    }
};
struct EpiResid {
    float* x; const float* gate;
    DEV void run(const f32x4 (&acc)[2][8], int w, int g, int li) const {
#pragma unroll
        for (int nt = 0; nt < 8; ++nt) {
            const float gt = gate[16 * nt + li];
#pragma unroll
            for (int mt = 0; mt < 2; ++mt)
#pragma unroll
                for (int r = 0; r < 4; ++r) { float* px = x + (size_t)(32 * w + 16 * mt + 4 * g + r) * D + 16 * nt + li; *px = *px + gt * acc[mt][nt][r]; }
        }
    }
};
struct EpiGlu {
    half_t* out; int ld;
    DEV void run(const f32x4 (&acc)[2][8], int w, int g, int li) const {
#pragma unroll
        for (int mt = 0; mt < 2; ++mt)
#pragma unroll
            for (int nt = 0; nt < 4; ++nt)
#pragma unroll
                for (int r = 0; r < 4; ++r) out[(size_t)(32 * w + 16 * mt + 4 * g + r) * ld + 16 * nt + li] = (half_t)(silu_f(acc[mt][nt][r]) * acc[mt][nt + 4][r]);
    }
};
struct EpiRowsGate {
    half_t* out; const float* gate; int nvalid;
    DEV void run(const f32x4 (&acc)[2][8], int w, int g, int li) const {
#pragma unroll
        for (int mt = 0; mt < 2; ++mt)
#pragma unroll
            for (int r = 0; r < 4; ++r) {
                const int row = 32 * w + 16 * mt + 4 * g + r;
                if (row < nvalid) {
                    const float gt = gate[row];
#pragma unroll
                    for (int nt = 0; nt < 8; ++nt) out[(size_t)row * D + 16 * nt + li] = (half_t)(gt * acc[mt][nt][r]);
                }
            }
    }
};

DEV void phase_prologue_a(CP& P, unsigned char* smem) {
    const int tid = TID(), gtid = blockIdx.x * NTHREADS + tid, gsz = gridDim.x * NTHREADS;
    for (size_t i = gtid; i < (size_t)NL * D * (PPAD / 8); i += gsz) {
        const int cc = (int)(i % (PPAD / 8)) * 8; const size_t rk = i / (PPAD / 8);
        half8 h;
#pragma unroll
        for (int j = 0; j < 8; ++j) h[j] = (cc + j < PTOT) ? (half_t)P.w_in[rk * PTOT + cc + j] : (half_t)0.f;
        *(half8*)(P.win16 + rk * PPAD + cc) = h;
    }
    for (size_t i = gtid; i < (size_t)NL * D * D / 8; i += gsz) {
        const f32x4 a = *(const f32x4*)(P.w_out + i * 8), b = *(const f32x4*)(P.w_out + i * 8 + 4);
        RawF r; r.a = a; r.b = b; *(half8*)(P.wout16 + i * 8) = cvt_rawf(r);
    }
    for (int i = gtid; i < NL * 192 * 384; i += gsz) { const int l = i / (192 * 384), k = (i / 384) % 192; P.wuq16[i] = (half_t)(P.mla_g_cq[l * 192 + k] * P.mla_w_uq[i]); }
    for (int i = gtid; i < NL * 128 * 512; i += gsz) { const int l = i / (128 * 512), k = (i / 512) % 128; P.wukv16[i] = (half_t)(P.mla_g_ckv[l * 128 + k] * P.mla_w_ukv[i]); }
    for (int i = gtid; i < 256; i += gsz) {
        float mx = -1e30f; for (int l = 0; l < NL; ++l) mx = fmaxf(mx, P.hg_lb_raw[l * 256 + i]);
        float den = 0.f; for (int l = 0; l < NL; ++l) den += fexp(P.hg_lb_raw[l * 256 + i] - mx);
        float cum = 0.f;
        for (int l = 0; l < NL; ++l) { const float wv = fexp(P.hg_lb_raw[l * 256 + i] - mx) / den; if (l > 0) cum += wv; P.hglb[l * 256 + i] = cum; }
    }
    for (int i = gtid; i < NL * D * 48; i += gsz) {
        const int n = i % 48, lk = i / 48;
        P.wr[i] = n < 4 ? P.moe_w_rg[lk * 4 + n] : (n < 36 ? P.moe_w_re[lk * 32 + (n - 4)] : 0.f);
    }
    for (int i = gtid; i < NL * NEXP; i += gsz) P.cnt[i] = 0;
    float* sc = (float*)smem;
    SYNC();
    for (int i = tid; i < (B_ + 1) * D; i += NTHREADS) { const int r = i / D, k = i % D; const float v = r < B_ ? P.c[r * D + k] : P.c_ctx[k]; sc[i] = silu_f(v); }
    SYNC();
    for (int item = blockIdx.x; item < NL * (MODW / 256); item += gridDim.x) {
        const int l = item / (MODW / 256), n = (item % (MODW / 256)) * 256 + tid;
        float acc[B_ + 1];
#pragma unroll
        for (int r = 0; r <= B_; ++r) acc[r] = 0.f;
        const float* wp = P.w_ada + (size_t)l * D * MODW + n;
        for (int k = 0; k < D; ++k) {
            const float wv = wp[(size_t)k * MODW];
#pragma unroll
            for (int r = 0; r <= B_; ++r) acc[r] += sc[r * D + k] * wv;
        }
        const float bv = P.b_ada[l * MODW + n];
#pragma unroll
        for (int r = 0; r <= B_; ++r) P.mod[((size_t)l * (B_ + 1) + r) * MODW + n] = acc[r] + bv;
    }
}

DEV void row_modulate_store(const f32x4 (&v)[4], const float* sh, const float* sc, half_t* hrow, int lane) {
    float ss = 0.f;
#pragma unroll
    for (int j = 0; j < 4; ++j) ss += v[j][0] * v[j][0] + v[j][1] * v[j][1] + v[j][2] * v[j][2] + v[j][3] * v[j][3];
    ss = wave_sum(ss);
    const float rstd = frsqrt(ss * (1.0f / D) + EPS);
#pragma unroll
    for (int j = 0; j < 4; ++j) {
        const int col = 256 * j + 4 * lane;
        const f32x4 s4 = *(const f32x4*)(sc + col), h4 = *(const f32x4*)(sh + col);
        f32x4 o;
#pragma unroll
        for (int e = 0; e < 4; ++e) o[e] = v[j][e] * rstd * (1.0f + s4[e]) + h4[e];
        *(half4*)(hrow + col) = to_half4(o);
    }
}
DEV void phase_prologue_b(CP& P) {
    const int lane = TID() & 63, gw = blockIdx.x * 4 + (TID() >> 6), nw = gridDim.x * 4;
    for (int t = gw; t < NT; t += nw) {
        const float* src = t < NLAT ? P.x + (size_t)t * D : P.ctx + (size_t)(t - NLAT) * D;
        float* dst = xrow_ptr(P, t);
        f32x4 v[4];
#pragma unroll
        for (int j = 0; j < 4; ++j) { v[j] = *(const f32x4*)(src + 256 * j + 4 * lane); *(f32x4*)(dst + 256 * j + 4 * lane) = v[j]; }
        const float* md = P.mod + (size_t)tok_brow(t) * MODW;
        row_modulate_store(v, md + 0, md + D, P.h + (size_t)t * D, lane);
    }
    for (int it = gw; it < NL * (B_ + 1) * 36; it += nw) {
        const int n = it % 36, lr = it / 36, l = lr / (B_ + 1);
        const float* sh = P.mod + (size_t)lr * MODW + 3 * D;
        float s = 0.f;
        for (int k = lane; k < D; k += 64) s += sh[k] * P.wr[((size_t)l * D + k) * 48 + n];
        s = wave_sum(s);
        if (lane == 0) P.cshift[lr * 48 + n] = s + (n < 4 ? P.moe_b_rg[l * 4 + n] : P.moe_b_re[l * 32 + n - 4]);
    }
}

DEV void phase_inproj(CP& P, int l, unsigned char* smem) {
    constexpr int NTN = PPAD / 128, NTM = NT / 128;
    for (int item = blockIdx.x; item < NTM * NTN; item += gridDim.x) {
        const int tm = item / NTN, tn = item % NTN;
        ARowLin ar{P.h + (size_t)tm * 128 * D, D};
        BSrcH bs{P.win16 + (size_t)l * D * PPAD + tn * 128, PPAD};
        EpiStoreH epi{P.p + (size_t)tm * 128 * PPAD + tn * 128, PPAD};
        gemm128(ar, bs, D, epi, smem);
    }
}

constexpr int GL = 68;
DEV float ret_loggamma(int h, int dir) { return log1pf(-exp2f(-5.0f - (float)(2 * h + dir))); }
template <int MIX, bool OUT>
DEV void gla_subblock(CP& P, int l, int h, int dir, int tok0, f32x4 (&st)[4], f32x4& oacc, float& totsum, float lgam, float* lds) {
    float* Qs = lds; float* Ks = Qs + 16 * GL; float* Kh = Ks + 16 * GL; float* Vs = Kh + 16 * GL; float* Ls = Vs + 16 * GL; float* dk = Ls + 16 * GL;
    const int tid = TID(), lane = tid & 63, w = tid >> 6, g = lane >> 4, li = lane & 15;
    float q[4], k[4], v[4];
#pragma unroll
    for (int i = 0; i < 4; ++i) {
        const int idx = tid + 256 * i, r = idx >> 6, d = idx & 63;
        const half_t* pr = P.p + (size_t)(tok0 + r) * PPAD + h * 64 + d;
        float lf;
        if (MIX == 0) {
            q[i] = OUT ? (float)pr[O_RQ] : 0.f; k[i] = (float)pr[O_RK] * 0.125f; v[i] = (float)pr[O_RV]; lf = lgam;
        } else {
            q[i] = OUT ? silu_f((float)pr[O_HQ]) : 0.f;
            const float fr = (float)pr[dir ? O_HB : O_HF], lb = P.hglb[l * 256 + h * 64 + d];
            const float sg = sigmoid_f(fr), f = lb + (1.0f - lb) * sg;
            lf = flog(fmaxf(f, 1e-20f)); k[i] = (1.0f - lb) * (1.0f - sg); v[i] = (float)pr[O_HI];
        }
        Ls[r * GL + d] = lf;
    }
    SYNC();
#pragma unroll
    for (int i = 0; i < 4; ++i) {
        const int idx = tid + 256 * i, r = idx >> 6, d = idx & 63;
        float tot = 0.f, bc = 0.f;
#pragma unroll
        for (int u = 0; u < 16; ++u) { const float x = Ls[u * GL + d]; tot += x; if (dir == 0 ? (u <= r) : (u >= r)) bc += x; }
        if (OUT) { Qs[r * GL + d] = q[i] * fexp(bc); Ks[r * GL + d] = k[i] * fexp(fminf(-bc, 80.0f)); }
        Kh[r * GL + d] = k[i] * fexp(tot - bc);
        Vs[r * GL + d] = v[i];
        if (r == 0) { dk[d] = fexp(tot); totsum += tot; }
    }
    SYNC();
    const int e = 16 * w + li;
    if (OUT) {
        f32x4 sc = {0.f, 0.f, 0.f, 0.f};
#pragma unroll
        for (int kk = 0; kk < 16; ++kk) sc = mfmaf(Ks[li * GL + 4 * kk + g], Qs[li * GL + 4 * kk + g], sc);
#pragma unroll
        for (int r = 0; r < 4; ++r) { const int s = 4 * g + r; const bool keep = dir == 0 ? (s <= li) : (s >= li); sc[r] = keep ? sc[r] : 0.f; }
#pragma unroll
        for (int kk = 0; kk < 4; ++kk) oacc = mfmaf(Vs[(4 * g + kk) * GL + e], sc[kk], oacc);
#pragma unroll
        for (int kk = 0; kk < 16; ++kk) { const int d = 16 * (kk >> 2) + 4 * g + (kk & 3); oacc = mfmaf(st[kk >> 2][kk & 3], Qs[li * GL + d], oacc); }
    }
#pragma unroll
    for (int dt = 0; dt < 4; ++dt) {
#pragma unroll
        for (int r = 0; r < 4; ++r) st[dt][r] *= dk[16 * dt + 4 * g + r];
#pragma unroll
        for (int kk = 0; kk < 4; ++kk) st[dt] = mfmaf(Kh[(4 * kk + g) * GL + 16 * dt + li], Vs[(4 * kk + g) * GL + e], st[dt]);
    }
}
DEV int gla_tok0(int b, int gidx) { return gidx < CG ? NLAT + b * CTX + 64 * gidx : b * SEQ + 64 * (gidx - CG); }
DEV int gla_chainpos(int gidx, int dir) { return dir == 0 ? gidx : (gidx < CG ? CG - 1 - gidx : CG + (LG - 1 - (gidx - CG))); }
DEV size_t gla_chain(int mix, int b, int h, int dir) { return (((size_t)mix * B_ + b) * 4 + h) * 2 + dir; }
template <int MIX>
DEV void gla_step_a(CP& P, int l, int b, int h, int dir, int gidx, unsigned char* smem) {
    const int tid = TID(), lane = tid & 63, w = tid >> 6, g = lane >> 4, li = lane & 15;
    f32x4 st[4]; f32x4 od = {0.f, 0.f, 0.f, 0.f};
#pragma unroll
    for (int dt = 0; dt < 4; ++dt) st[dt] = (f32x4){0.f, 0.f, 0.f, 0.f};
    float totsum = 0.f;
    const float lgam = MIX == 0 ? ret_loggamma(h, dir) : 0.f;
    const int tok0 = gla_tok0(b, gidx);
    for (int ii = 0; ii < 4; ++ii) { const int I = dir == 0 ? ii : 3 - ii; gla_subblock<MIX, false>(P, l, h, dir, tok0 + 16 * I, st, od, totsum, lgam, (float*)smem); }
    const size_t slot = gla_chain(MIX, b, h, dir) * NCH + gla_chainpos(gidx, dir);
    float* dst = P.gst + slot * 4096;
#pragma unroll
    for (int dt = 0; dt < 4; ++dt)
#pragma unroll
        for (int r = 0; r < 4; ++r) dst[(16 * dt + 4 * g + r) * 64 + 16 * w + li] = st[dt][r];
    if (tid < 64) P.gdec[slot * 64 + tid] = fexp(totsum);
    SYNC();
}
template <int MIX>
DEV void gla_step_c(CP& P, int l, int b, int h, int gidx, unsigned char* smem) {
    const int tid = TID(), lane = tid & 63, w = tid >> 6, g = lane >> 4, li = lane & 15;
    f32x4 oacc[4];
#pragma unroll
    for (int I = 0; I < 4; ++I) oacc[I] = (f32x4){0.f, 0.f, 0.f, 0.f};
    const int tok0 = gla_tok0(b, gidx);
    float totsum = 0.f;
#pragma unroll
    for (int dir = 0; dir < 2; ++dir) {
        const size_t slot = gla_chain(MIX, b, h, dir) * NCH + gla_chainpos(gidx, dir);
        const float* src = P.gst + slot * 4096;
        f32x4 st[4];
#pragma unroll
        for (int dt = 0; dt < 4; ++dt)
#pragma unroll
            for (int r = 0; r < 4; ++r) st[dt][r] = src[(16 * dt + 4 * g + r) * 64 + 16 * w + li];
        const float lgam = MIX == 0 ? ret_loggamma(h, dir) : 0.f;
#pragma unroll
        for (int ii = 0; ii < 4; ++ii) {
            const int I = dir == 0 ? ii : 3 - ii;
            gla_subblock<MIX, true>(P, l, h, dir, tok0 + 16 * I, st, oacc[I], totsum, lgam, (float*)smem);
        }
    }
    float* red = (float*)smem + 6 * 16 * GL;
    SYNC();
#pragma unroll
    for (int I = 0; I < 4; ++I) {
        float ss = oacc[I][0] * oacc[I][0] + oacc[I][1] * oacc[I][1] + oacc[I][2] * oacc[I][2] + oacc[I][3] * oacc[I][3];
        ss += shfl_xor_f(ss, 16); ss += shfl_xor_f(ss, 32);
        if (g == 0) red[w * 64 + 16 * I + li] = ss;
    }
    SYNC();
    const float* gain = (MIX == 0 ? P.ret_g_out : P.hg_g_out) + l * 64;
    const int ycol = (MIX == 0 ? 512 : 768) + h * 64 + 16 * w + 4 * g, gcol = (MIX == 0 ? O_RG : O_HG) + h * 64 + 16 * w + 4 * g;
#pragma unroll
    for (int I = 0; I < 4; ++I) {
        const int ti = 16 * I + li, t = tok0 + ti;
        const float tot = red[ti] + red[64 + ti] + red[128 + ti] + red[192 + ti];
        const float rstd = frsqrt(tot * (1.0f / 64.0f) + EPS);
        const half4 gt = *(const half4*)(P.p + (size_t)t * PPAD + gcol);
        f32x4 o;
#pragma unroll
        for (int r = 0; r < 4; ++r) o[r] = oacc[I][r] * rstd * gain[16 * w + 4 * g + r] * silu_f((float)gt[r]);
        *(half4*)(P.y + (size_t)t * D + ycol) = to_half4(o);
    }
    SYNC();
}
DEV void gla_scan(CP& P, int item) {
    const int chain = item >> 4, elem = ((item & 15) << 8) + TID(), d = elem >> 6;
    float* base = P.gst + (size_t)chain * NCH * 4096 + elem;
    const float* dec = P.gdec + (size_t)chain * NCH * 64 + d;
    float s = 0.f;
    for (int pos = 0; pos < NCH; ++pos) { const float ds = base[(size_t)pos * 4096], dc = dec[pos * 64]; base[(size_t)pos * 4096] = s; s = dc * s + ds; }
}

DEV void phase_up_glaa(CP& P, int l, unsigned char* smem) {
    constexpr int NTM = NT / 128, NQ = NTM * 3, NKV = NTM * 4, NGA = 2 * B_ * 4 * 2 * NCH;
    for (int item = blockIdx.x; item < NQ + NKV + NGA; item += gridDim.x) {
        if (item < NQ) {
            const int tm = item / 3, tn = item % 3;
            ARowLin ar{P.p + (size_t)tm * 128 * PPAD + O_CQ, PPAD};
            BSrcH bs{P.wuq16 + (size_t)l * 192 * 384 + tn * 128, 384};
            EpiStoreH epi{P.qraw + (size_t)tm * 128 * 384 + tn * 128, 384};
            gemm128(ar, bs, 192, epi, smem);
        } else if (item < NQ + NKV) {
            const int it = item - NQ, tm = it / 4, tn = it % 4;
            ARowLin ar{P.p + (size_t)tm * 128 * PPAD + O_CKV, PPAD};
            BSrcH bs{P.wukv16 + (size_t)l * 128 * 512 + tn * 128, 512};
            EpiStoreH epi{P.kvraw + (size_t)tm * 128 * 512 + tn * 128, 512};
            gemm128(ar, bs, 128, epi, smem);
        } else {
            int it = item - NQ - NKV;
            const int gidx = it % NCH; it /= NCH; const int dir = it & 1; it >>= 1; const int h = it & 3; it >>= 2; const int b = it % B_; const int mix = it / B_;
            SYNC();
            if (mix == 0) gla_step_a<0>(P, l, b, h, dir, gidx, smem); else gla_step_a<1>(P, l, b, h, dir, gidx, smem);
        }
    }
}

DEV void mixer_prep_token(CP& P, int l, int t, int lane) {
    const int b = t < NLAT ? t / SEQ : (t - NLAT) / CTX;
    const bool lat = t < NLAT;
    const int pos = lat ? t % SEQ : SEQ + (t - NLAT) % CTX;
    const half_t* pr = P.p + (size_t)t * PPAD;
    float s1 = 0.f, s2 = 0.f;
    for (int i = lane; i < 192; i += 64) { const float v = (float)pr[O_CQ + i]; s1 += v * v; }
    for (int i = lane; i < 128; i += 64) { const float v = (float)pr[O_CKV + i]; s2 += v * v; }
    s1 = wave_sum(s1); s2 = wave_sum(s2);
    const float rq = frsqrt(s1 * (1.0f / 192.0f) + EPS), rkv = frsqrt(s2 * (1.0f / 128.0f) + EPS);
    const int n = lat ? t % SEQ : 0;
    const int ai = lane & 7, axis = (lane >> 4) & 1;
    const float inv_freq = fexp(-9.210340371976184f * (float)ai * 0.125f);
    const float ang = (float)(axis == 0 ? n / 64 : n % 64) * inv_freq;
    float cs = 1.f, sn = 0.f;
    if (lat) { cs = cosf(ang); sn = sinf(ang); }
    const float sgn = (lane & 8) ? 1.f : -1.f;
    float krv = lane < 32 ? (float)pr[O_KR + lane] : 0.f;
    {
        const float ss = wave_sum(krv * krv);
        krv = krv * frsqrt(ss * (1.0f / 32.0f) + EPS) * (lane < 32 ? P.mla_g_kr[l * 32 + lane] : 0.f);
        const float partner = shfl_xor_f(krv, 8);
        krv = krv * cs + sgn * partner * sn;
    }
    for (int h = 0; h < 4; ++h) {
        const size_t row = ((size_t)(b * 4 + h) * KEYS + pos);
        float qn = (float)P.qraw[(size_t)t * 384 + h * 96 + lane] * rq;
        float ss = wave_sum(qn * qn);
        qn = qn * frsqrt(ss * (1.0f / 64.0f) + EPS) * P.mla_g_qn[l * 64 + lane];
        float qr = lane < 32 ? (float)P.qraw[(size_t)t * 384 + h * 96 + 64 + lane] * rq : 0.f;
        ss = wave_sum(qr * qr);
        qr = qr * frsqrt(ss * (1.0f / 32.0f) + EPS) * (lane < 32 ? P.mla_g_qr[l * 32 + lane] : 0.f);
        const float qpart = shfl_xor_f(qr, 8);
        qr = qr * cs + sgn * qpart * sn;
        const float qs = 0.10206207261596575f * LOG2E;
        P.mq[row * 96 + lane] = (half_t)(qn * qs);
        if (lane < 32) P.mq[row * 96 + 64 + lane] = (half_t)(qr * qs);
        float kn = (float)P.kvraw[(size_t)t * 512 + h * 128 + lane] * rkv;
        ss = wave_sum(kn * kn);
        kn = kn * frsqrt(ss * (1.0f / 64.0f) + EPS) * P.mla_g_kn[l * 64 + lane];
        P.mk[row * 96 + lane] = (half_t)kn;
        if (lane < 32) P.mk[row * 96 + 64 + lane] = (half_t)krv;
        P.mv[row * 64 + lane] = (half_t)((float)P.kvraw[(size_t)t * 512 + h * 128 + 64 + lane] * rkv);
        float nq = (float)pr[O_NAQ + h * 64 + lane];
        ss = wave_sum(nq * nq);
        P.nq[row * 64 + lane] = (half_t)(nq * frsqrt(ss * (1.0f / 64.0f) + EPS) * P.na_g_q[l * 64 + lane] * (0.125f * LOG2E));
        float nk = (float)pr[O_NAK + h * 64 + lane];
        ss = wave_sum(nk * nk);
        P.nk[row * 64 + lane] = (half_t)(nk * frsqrt(ss * (1.0f / 64.0f) + EPS) * P.na_g_k[l * 64 + lane]);
        P.nv[row * 64 + lane] = pr[O_NAV + h * 64 + lane];
    }
}
DEV void phase_prep_scan(CP& P, int l) {
    constexpr int NSCAN = 2 * B_ * 4 * 2 * 16;
    constexpr int NPREP = NT / 4;
    const int lane = TID() & 63, w = TID() >> 6;
    for (int item = blockIdx.x; item < NSCAN + NPREP; item += gridDim.x) {
        if (item < NSCAN) gla_scan(P, item);
        else mixer_prep_token(P, l, (item - NSCAN) * 4 + w, lane);
    }
}

DEV half8 vt_frag(const half_t* Vs, int ldv, int kbase, int dv0, int lane) {
    const int grp = lane >> 4, hh = lane >> 5, i = lane & 15, q = i >> 2, pp = i & 3;
    const half_t* a = Vs + (kbase + 4 * hh + q) * ldv + dv0 + 16 * (grp & 1) + 4 * pp;
    const half4 lo = tr16(a), hi = tr16(a + 8 * ldv);
    half8 r; r[0] = lo[0]; r[1] = lo[1]; r[2] = lo[2]; r[3] = lo[3]; r[4] = hi[0]; r[5] = hi[1]; r[6] = hi[2]; r[7] = hi[3]; return r;
}
DEV void softmax_pv_step(const f32x16& s, float& m, float& lsum, f32x16 (&o)[2], const half_t* Vs, int ldv, int lane) {
    float mx = s[0];
#pragma unroll
    for (int r = 1; r < 16; ++r) mx = fmaxf(mx, s[r]);
    mx = fmaxf(mx, shfl_xor_f(mx, 32));
    const float mn = fmaxf(m, mx);
    const float alpha = fexp2(m - mn);
    m = mn;
    float ps = 0.f; half8 pf[2];
#pragma unroll
    for (int r = 0; r < 16; ++r) { const float pv = fexp2(s[r] - mn); ps += pv; pf[r >> 3][r & 7] = (half_t)pv; }
    lsum = lsum * alpha + ps;
#pragma unroll
    for (int dt = 0; dt < 2; ++dt)
#pragma unroll
        for (int r = 0; r < 16; ++r) o[dt][r] *= alpha;
#pragma unroll
    for (int s2 = 0; s2 < 2; ++s2)
#pragma unroll
        for (int dt = 0; dt < 2; ++dt) o[dt] = mfma32(vt_frag(Vs, ldv, 16 * s2, 32 * dt, lane), pf[s2], o[dt]);
}
DEV void attn_store(const f32x16 (&o)[2], float lsum, half_t* yrow, int lane) {
    const float inv = 1.0f / (lsum + shfl_xor_f(lsum, 32));
    const int hh = lane >> 5;
#pragma unroll
    for (int dt = 0; dt < 2; ++dt)
#pragma unroll
        for (int rq = 0; rq < 4; ++rq) {
            half4 v;
#pragma unroll
            for (int e = 0; e < 4; ++e) v[e] = (half_t)(o[dt][4 * rq + e] * inv);
            *(half4*)(yrow + 32 * dt + 8 * rq + 4 * hh) = v;
        }
}
DEV int attn_qtoken(int b, int qpos) { return qpos < SEQ ? b * SEQ + qpos : NLAT + b * CTX + (qpos - SEQ); }

constexpr int MK_LD = 104, MV_LD = 72;
DEV void mla_attn_item(CP& P, int b, int h, int qt, unsigned char* smem) {
    half_t* Ks = (half_t*)smem; half_t* Vs = Ks + 64 * MK_LD;
    const int tid = TID(), lane = tid & 63, w = tid >> 6, hh = lane >> 5, ql = lane & 31;
    const size_t bh = (size_t)(b * 4 + h) * KEYS;
    const int q0 = qt * 128 + 32 * w;
    const bool ctxq = q0 >= SEQ;
    const int kbeg = ctxq ? SEQ : 0, nkt = (ctxq ? CTX : KEYS) / 64;
    half8 qf[6];
#pragma unroll
    for (int ks = 0; ks < 6; ++ks) qf[ks] = *(const half8*)(P.mq + (bh + q0 + ql) * 96 + 16 * ks + 8 * hh);
    f32x16 o[2]; float m = -1e30f, lsum = 0.f;
#pragma unroll
    for (int dt = 0; dt < 2; ++dt)
#pragma unroll
        for (int r = 0; r < 16; ++r) o[dt][r] = 0.f;
    half8 pk[3], pv[2];
    const half_t* kg = P.mk + (bh + kbeg) * 96; const half_t* vg = P.mv + (bh + kbeg) * 64;
#pragma unroll
    for (int i = 0; i < 3; ++i) { const int c = tid + 256 * i; pk[i] = *(const half8*)(kg + (size_t)(c / 12) * 96 + (c % 12) * 8); }
#pragma unroll
    for (int i = 0; i < 2; ++i) { const int c = tid + 256 * i; pv[i] = *(const half8*)(vg + (size_t)(c >> 3) * 64 + (c & 7) * 8); }
    for (int kt = 0; kt < nkt; ++kt) {
        SYNC();
#pragma unroll
        for (int i = 0; i < 3; ++i) { const int c = tid + 256 * i; *(half8*)(Ks + (c / 12) * MK_LD + (c % 12) * 8) = pk[i]; }
#pragma unroll
        for (int i = 0; i < 2; ++i) { const int c = tid + 256 * i; *(half8*)(Vs + (c >> 3) * MV_LD + (c & 7) * 8) = pv[i]; }
        SYNC();
        if (kt + 1 < nkt) {
            const half_t* kg2 = kg + (size_t)(kt + 1) * 64 * 96; const half_t* vg2 = vg + (size_t)(kt + 1) * 64 * 64;
#pragma unroll
            for (int i = 0; i < 3; ++i) { const int c = tid + 256 * i; pk[i] = *(const half8*)(kg2 + (size_t)(c / 12) * 96 + (c % 12) * 8); }
#pragma unroll
            for (int i = 0; i < 2; ++i) { const int c = tid + 256 * i; pv[i] = *(const half8*)(vg2 + (size_t)(c >> 3) * 64 + (c & 7) * 8); }
        }
#pragma unroll
        for (int kt2 = 0; kt2 < 2; ++kt2) {
            f32x16 s;
#pragma unroll
            for (int r = 0; r < 16; ++r) s[r] = 0.f;
#pragma unroll
            for (int ks = 0; ks < 6; ++ks) s = mfma32(*(const half8*)(Ks + (32 * kt2 + ql) * MK_LD + 16 * ks + 8 * hh), qf[ks], s);
            softmax_pv_step(s, m, lsum, o, Vs + 32 * kt2 * MV_LD, MV_LD, lane);
        }
    }
    attn_store(o, lsum, P.y + (size_t)attn_qtoken(b, q0 + ql) * D + 0 + h * 64, lane);
}

constexpr int NV_LD = 72;
DEV void na_attn_unit(CP& P, int l, int unit, half_t* Vw, int lane) {
    constexpr int NLATU = B_ * 4 * ROWS * 2;
    const int hh = lane >> 5, ql = lane & 31;
    int b, h, q0, ntile, R0 = 0, r = 0, hf = 0; bool lat;
    if (unit < NLATU) { lat = true; hf = unit & 1; r = (unit >> 1) % ROWS; const int bh = unit / (2 * ROWS); h = bh & 3; b = bh >> 2; q0 = r * 64 + 32 * hf; ntile = 16 + CTX / 32;
        R0 = r - 4 < 0 ? 0 : (r - 4 > ROWS - 8 ? ROWS - 8 : r - 4); }
    else { lat = false; const int u = unit - NLATU; const int cb = u % (CTX / 32); const int bh = u / (CTX / 32); h = bh & 3; b = bh >> 2; q0 = SEQ + 32 * cb; ntile = CTX / 32; }
    const size_t bhk = (size_t)(b * 4 + h) * KEYS;
    half8 qf[4];
#pragma unroll
    for (int ks = 0; ks < 4; ++ks) qf[ks] = *(const half8*)(P.nq + (bhk + q0 + ql) * 64 + 16 * ks + 8 * hh);
    f32x16 o[2]; float m = -1e30f, lsum = 0.f;
#pragma unroll
    for (int dt = 0; dt < 2; ++dt)
#pragma unroll
        for (int rr = 0; rr < 16; ++rr) o[dt][rr] = 0.f;
    const int wq = 32 * hf + ql;
    const int cs = wq - 8 < 0 ? 0 : (wq - 8 > 48 ? 48 : wq - 8);
    for (int tile = 0; tile < ntile; ++tile) {
        const bool win = lat && tile < 16;
        const int krow = R0 + (tile >> 1), kh2 = tile & 1;
        const int kpos0 = win ? krow * 64 + 32 * kh2 : SEQ + 32 * (lat ? tile - 16 : tile);
        f32x16 s;
#pragma unroll
        for (int rr = 0; rr < 16; ++rr) s[rr] = 0.f;
#pragma unroll
        for (int ks = 0; ks < 4; ++ks) s = mfma32(*(const half8*)(P.nk + (bhk + kpos0 + ql) * 64 + 16 * ks + 8 * hh), qf[ks], s);
        if (win) {
            const float* bias = P.na_rpb + ((size_t)(l * 4 + h) * 15 + (krow - r + 7)) * 31;
#pragma unroll
            for (int rr = 0; rr < 16; ++rr) {
                const int wk = 32 * kh2 + (rr & 3) + 8 * (rr >> 2) + 4 * hh;
                const bool valid = wk >= cs && wk < cs + 16;
                const int dc = valid ? wk - wq + 15 : 15;
                s[rr] = valid ? s[rr] + bias[dc] * LOG2E : -INFINITY;
            }
        }
        WAVE_BARRIER();
#pragma unroll
        for (int i = 0; i < 4; ++i) { const int c = lane + 64 * i; *(half8*)(Vw + (c >> 3) * NV_LD + (c & 7) * 8) = *(const half8*)(P.nv + (bhk + kpos0 + (c >> 3)) * 64 + (c & 7) * 8); }
        WAVE_BARRIER();
        softmax_pv_step(s, m, lsum, o, Vw, NV_LD, lane);
    }
    attn_store(o, lsum, P.y + (size_t)attn_qtoken(b, q0 + ql) * D + 256 + h * 64, lane);
}

DEV void phase_mixers(CP& P, int l, unsigned char* smem) {
    const bool last = l == NL - 1;
    const int QT = (last ? SEQ : KEYS) / 128;
    const int NMLA = B_ * 4 * QT;
    const int NNAU = B_ * 4 * ROWS * 2 + (last ? 0 : B_ * 4 * (CTX / 32));
    const int NNA = NNAU / 4;
    const int NGRP = last ? LG : NCH;
    const int NGC = 2 * B_ * 4 * NGRP;
    const int lane = TID() & 63, w = TID() >> 6;
    for (int item = blockIdx.x; item < NMLA + NNA + NGC; item += gridDim.x) {
        if (item < NMLA) {
            const int qt = item % QT, bh = item / QT;
            mla_attn_item(P, bh >> 2, bh & 3, qt, smem);
        } else if (item < NMLA + NNA) {
            SYNC();
            na_attn_unit(P, l, (item - NMLA) * 4 + w, (half_t*)smem + w * 32 * NV_LD, lane);
        } else {
            int it = item - NMLA - NNA;
            const int gi = it % NGRP; it /= NGRP; const int h = it & 3; it >>= 2; const int b = it % B_; const int mix = it / B_;
            const int gidx = last ? gi + CG : gi;
            SYNC();
            if (mix == 0) gla_step_c<0>(P, l, b, h, gidx, smem); else gla_step_c<1>(P, l, b, h, gidx, smem);
        }
    }
}

DEV void phase_outproj(CP& P, int l, unsigned char* smem) {
    const bool last = l == NL - 1;
    const int NTM = (last ? NLAT : NT) / 128;
    for (int item = blockIdx.x; item < NTM * 8; item += gridDim.x) {
        const int tm = item / 8, tn = item % 8, t0 = tm * 128;
        ARowLin ar{P.y + (size_t)t0 * D, D};
        BSrcH bs{P.wout16 + (size_t)l * D * D + tn * 128, D};
        EpiResid epi{xrow_ptr(P, t0) + tn * 128, P.mod + ((size_t)l * (B_ + 1) + tok_brow(t0)) * MODW + 2 * D + tn * 128};
        gemm128(ar, bs, D, epi, smem);
    }
}

DEV void phase_router(CP& P, int l, unsigned char* smem) {
    const bool last = l == NL - 1;
    const int NU = (last ? NLAT : NT) / 16;
    const int lane = TID() & 63, w = TID() >> 6, g = lane >> 4, li = lane & 15;
    float* lg = (float*)smem + w * 16 * 48;
    const float* wr = P.wr + (size_t)l * D * 48;
    for (int unit = blockIdx.x * 4 + w; unit < NU; unit += gridDim.x * 4) {
        const int tok0 = unit * 16, br = tok_brow(tok0);
        const float* xr = xrow_ptr(P, tok0 + li);
        const float* md = P.mod + ((size_t)l * (B_ + 1) + br) * MODW;
        const float* sh = md + 3 * D; const float* sc = md + 4 * D;
        f32x4 acc[3];
#pragma unroll
        for (int nt = 0; nt < 3; ++nt) acc[nt] = (f32x4){0.f, 0.f, 0.f, 0.f};
        float ssq = 0.f;
        for (int kk = 0; kk < 64; ++kk) {
            const f32x4 xv = *(const f32x4*)(xr + 16 * kk + 4 * g), sv = *(const f32x4*)(sc + 16 * kk + 4 * g);
            ssq += xv[0] * xv[0] + xv[1] * xv[1] + xv[2] * xv[2] + xv[3] * xv[3];
#pragma unroll
            for (int c = 0; c < 4; ++c) {
                const float a = xv[c] * (1.0f + sv[c]);
                const float* wrow = wr + (size_t)(16 * kk + 4 * g + c) * 48 + li;
#pragma unroll
                for (int nt = 0; nt < 3; ++nt) acc[nt] = mfmaf(a, wrow[16 * nt], acc[nt]);
            }
        }
        ssq += shfl_xor_f(ssq, 16); ssq += shfl_xor_f(ssq, 32);
        const float rstd = frsqrt(ssq * (1.0f / D) + EPS);
        const float* csh = P.cshift + ((size_t)l * (B_ + 1) + br) * 48;
        WAVE_BARRIER();
#pragma unroll
        for (int r = 0; r < 4; ++r) {
            const float rs = shfl_f(rstd, 4 * g + r);
#pragma unroll
            for (int nt = 0; nt < 3; ++nt) lg[(4 * g + r) * 48 + 16 * nt + li] = acc[nt][r] * rs + csh[16 * nt + li];
        }
        WAVE_BARRIER();
        if (lane < 16) {
            const float* lt = lg + lane * 48;
            int gi = 0; float gm = lt[0];
            for (int j = 1; j < 4; ++j) if (lt[j] > gm) { gm = lt[j]; gi = j; }
            float gden = 0.f; for (int j = 0; j < 4; ++j) gden += fexp(lt[j] - gm);
            const float pg = 1.0f / gden;
            const float* ft = lt + 4 + gi * 8;
            int e0 = 0; float f0 = ft[0];
            for (int j = 1; j < 8; ++j) if (ft[j] > f0) { f0 = ft[j]; e0 = j; }
            int e1 = -1; float f1 = -3.0e38f;
            for (int j = 0; j < 8; ++j) if (j != e0 && ft[j] > f1) { f1 = ft[j]; e1 = j; }
            const float p1 = fexp(f1 - f0);
            const float g0 = pg / (1.0f + p1), g1 = pg * p1 / (1.0f + p1);
            const int t = tok0 + lane, x0 = gi * 8 + e0, x1 = gi * 8 + e1;
            const int s0 = atomic_add_i(P.cnt + l * NEXP + x0, 1), s1 = atomic_add_i(P.cnt + l * NEXP + x1, 1);
            P.list_tok[(size_t)x0 * NT + s0] = t; P.list_gate[(size_t)x0 * NT + s0] = g0;
            P.list_tok[(size_t)x1 * NT + s1] = t; P.list_gate[(size_t)x1 * NT + s1] = g1;
            P.tokslot[2 * t] = (x0 << 20) | s0; P.tokslot[2 * t + 1] = (x1 << 20) | s1;
        }
        WAVE_BARRIER();
        half_t* hr = P.h + (size_t)(tok0 + li) * D;
        for (int kk = 0; kk < 64; ++kk) {
            const int col = 16 * kk + 4 * g;
            const f32x4 xv = *(const f32x4*)(xr + col), sv = *(const f32x4*)(sc + col), hv = *(const f32x4*)(sh + col);
            f32x4 o;
#pragma unroll
            for (int c = 0; c < 4; ++c) o[c] = xv[c] * rstd * (1.0f + sv[c]) + hv[c];
            *(half4*)(hr + col) = to_half4(o);
        }
    }
}

DEV void moe_tables(CP& P, int l, int* ab, int* tb) {
    if (TID() == 0) {
        int a = 0, t = 0;
        for (int e = 0; e < NEXP; ++e) { const int c = P.cnt[l * NEXP + e], nt = (c + 127) >> 7; ab[e] = a; tb[e] = t; a += nt * 128; t += nt; }
        ab[NEXP] = a; tb[NEXP] = t;
    }
    SYNC();
}
DEV int moe_find(const int* tb, int tile) { int e = 0; while (e < NEXP - 1 && tile >= tb[e + 1]) ++e; return e; }

DEV void phase_moe1(CP& P, int l, unsigned char* smem) {
    int* ab = (int*)(smem + SMEM_BYTES - 512); int* tb = ab + 40;
    moe_tables(P, l, ab, tb);
    const int ntiles = tb[NEXP];
    for (int item = blockIdx.x; item < ntiles * 8; item += gridDim.x) {
        const int tile = item >> 3, tn = item & 7, e = moe_find(tb, tile), mt = tile - tb[e];
        const int cnt = P.cnt[l * NEXP + e], nvalid = cnt - mt * 128 < 128 ? cnt - mt * 128 : 128;
        ARowGather ar{P.h, D, P.list_tok + (size_t)e * NT + mt * 128, nvalid};
        const size_t wo = ((size_t)l * NEXP + e) * D * 512 + tn * 64;
        BSrcF2 bs{P.moe_w1 + wo, P.moe_w3 + wo, 512};
        EpiGlu epi{P.act + (size_t)(ab[e] + mt * 128) * 512 + tn * 64, 512};
        gemm128(ar, bs, D, epi, smem);
    }
}
DEV void phase_moe2(CP& P, int l, unsigned char* smem) {
    int* ab = (int*)(smem + SMEM_BYTES - 512); int* tb = ab + 40;
    moe_tables(P, l, ab, tb);
    const int ntiles = tb[NEXP];
    for (int item = blockIdx.x; item < ntiles * 8; item += gridDim.x) {
        const int tile = item >> 3, tn = item & 7, e = moe_find(tb, tile), mt = tile - tb[e];
        const int cnt = P.cnt[l * NEXP + e], nvalid = cnt - mt * 128 < 128 ? cnt - mt * 128 : 128;
        const size_t r0 = (size_t)ab[e] + mt * 128;
        ARowLin ar{P.act + r0 * 512, 512};
        BSrcF bs{P.moe_w2 + ((size_t)l * NEXP + e) * 512 * D + tn * 128, D};
        EpiRowsGate epi{P.yrows + r0 * D + tn * 128, P.list_gate + (size_t)e * NT + mt * 128, nvalid};
        gemm128(ar, bs, 512, epi, smem);
    }
}
DEV void phase_combine(CP& P, int l, unsigned char* smem) {
    int* ab = (int*)(smem + SMEM_BYTES - 512); int* tb = ab + 40;
    moe_tables(P, l, ab, tb);
    const bool last = l == NL - 1;
    const int NTK = last ? NLAT : NT;
    const int lane = TID() & 63, gw = blockIdx.x * 4 + (TID() >> 6), nw = gridDim.x * 4;
    for (int t = gw; t < NTK; t += nw) {
        const int ts0 = P.tokslot[2 * t], ts1 = P.tokslot[2 * t + 1];
        const half_t* y0 = P.yrows + (size_t)(ab[ts0 >> 20] + (ts0 & 0xFFFFF)) * D;
        const half_t* y1 = P.yrows + (size_t)(ab[ts1 >> 20] + (ts1 & 0xFFFFF)) * D;
        float* xr = xrow_ptr(P, t);
        const float* md = P.mod + ((size_t)l * (B_ + 1) + tok_brow(t)) * MODW;
        f32x4 v[4];
#pragma unroll
        for (int j = 0; j < 4; ++j) {
            const int col = 256 * j + 4 * lane;
            const f32x4 xv = *(const f32x4*)(xr + col), gt = *(const f32x4*)(md + 5 * D + col);
            const half4 a = *(const half4*)(y0 + col), b2 = *(const half4*)(y1 + col);
#pragma unroll
            for (int e = 0; e < 4; ++e) v[j][e] = xv[e] + gt[e] * ((float)a[e] + (float)b2[e]);
            *(f32x4*)(xr + col) = v[j];
        }
        if (!last) { const float* mn = md + (size_t)(B_ + 1) * MODW; row_modulate_store(v, mn + 0, mn + D, P.h + (size_t)t * D, lane); }
    }
}

template <int PH> DEV void run_phase(CP& P, int l, unsigned char* smem) {
    if (PH == 0) phase_prologue_a(P, smem);
    if (PH == 1) phase_prologue_b(P);
    if (PH == 2) phase_inproj(P, l, smem);
    if (PH == 3) phase_up_glaa(P, l, smem);
    if (PH == 4) phase_prep_scan(P, l);
    if (PH == 5) phase_mixers(P, l, smem);
    if (PH == 6) phase_outproj(P, l, smem);
    if (PH == 7) phase_router(P, l, smem);
    if (PH == 8) phase_moe1(P, l, smem);
    if (PH == 9) phase_moe2(P, l, smem);
    if (PH == 10) phase_combine(P, l, smem);
}

#ifndef CPU_EMU
#define XB_TMO      128
#define XB_XCNT(j)  (256  + 64 * (j))
#define XB_XSUB(j)  (1280 + 64 * (j))
#define XB_XGEN(j)  (2304 + 64 * (j))
#define XB_TOP      3328
#define XB_TOPGEN   3392
#define XCD_BAR_WORDS 3456
#define XB_SPIN_CAP (1u << 24)
__device__ __forceinline__ unsigned xb_ld(unsigned* p)              { return __hip_atomic_load(p, __ATOMIC_RELAXED, __HIP_MEMORY_SCOPE_AGENT); }
__device__ __forceinline__ unsigned xb_add(unsigned* p, unsigned v) { return __hip_atomic_fetch_add(p, v, __ATOMIC_RELAXED, __HIP_MEMORY_SCOPE_AGENT); }
__device__ __forceinline__ unsigned xb_xcc_id() { return (unsigned)__builtin_amdgcn_s_getreg((3 << 11) | 20) & 0xFu; }
#define XB_SPIN(cond, bar) do { unsigned _sp = 0; while (cond) { __builtin_amdgcn_s_sleep(1); \
    if ((++_sp & 255u) == 0u) { if (xb_ld(&(bar)[XB_TMO])) break; if (_sp > XB_SPIN_CAP) { atomicAdd(&(bar)[XB_TMO], 1u); break; } } } } while (0)
struct XcdBarrier { unsigned* bar; unsigned x; volatile LDSP unsigned* st; };
__device__ __forceinline__ XcdBarrier xcd_barrier_post(unsigned* bar, volatile LDSP unsigned* st) {
    XcdBarrier b; b.bar = bar; b.x = xb_xcc_id(); b.st = st;
    if (threadIdx.x == 0) (void)xb_add(&bar[XB_XCNT(b.x)], 1u);
    return b;
}
__device__ __forceinline__ void xcd_barrier_complete(unsigned* bar, unsigned x, unsigned& nloc, unsigned& nx) {
    const unsigned G = gridDim.x * gridDim.y * gridDim.z;
    unsigned sum, cnt, mine, sp = 0u;
    for (;;) {
        sum = 0u; cnt = 0u; mine = 0u;
#pragma unroll
        for (unsigned j = 0; j < 16; ++j) { const unsigned c = xb_ld(&bar[XB_XCNT(j)]); sum += c; cnt += (c > 0u) ? 1u : 0u; mine = (j == x) ? c : mine; }
        if (sum == G) break;
        __builtin_amdgcn_s_sleep(1);
        if ((++sp & 255u) == 0u) { if (xb_ld(&bar[XB_TMO])) break; if (sp > XB_SPIN_CAP) { atomicAdd(&bar[XB_TMO], 1u); break; } }
    }
    nloc = mine > 0u ? mine : 1u; nx = cnt > 0u ? cnt : 1u;
}
__device__ __forceinline__ void xcd_barrier(const XcdBarrier& b) {
    asm volatile("s_waitcnt vmcnt(0)" ::: "memory");
    __syncthreads();
    if (threadIdx.x == 0) {
        unsigned* bar = b.bar;
        __builtin_amdgcn_s_waitcnt(0);
        unsigned nloc = b.st[0], nx = b.st[1];
        if (nloc == 0u) { xcd_barrier_complete(bar, b.x, nloc, nx); b.st[0] = nloc; b.st[1] = nx; }
        const unsigned old = xb_add(&bar[XB_XSUB(b.x)], 1u);
        const unsigned gen = old / nloc;
        if (old + 1u == (gen + 1u) * nloc) {
            __builtin_amdgcn_fence(__ATOMIC_RELEASE, "agent");
            asm volatile("s_waitcnt vmcnt(0)" ::: "memory");
            const unsigned og = xb_add(&bar[XB_TOP], 1u);
            const unsigned tg = og / nx;
            if (og + 1u == (tg + 1u) * nx) xb_add(&bar[XB_TOPGEN], 1u);
            else XB_SPIN(xb_ld(&bar[XB_TOPGEN]) == tg, bar);
            __builtin_amdgcn_fence(__ATOMIC_ACQUIRE, "agent");
            xb_add(&bar[XB_XGEN(b.x)], 1u);
            asm volatile("s_waitcnt vmcnt(0)" ::: "memory");
        } else {
            XB_SPIN(xb_ld(&bar[XB_XGEN(b.x)]) == gen, bar);
            __builtin_amdgcn_fence(__ATOMIC_ACQUIRE, "agent");
            asm volatile("s_waitcnt vmcnt(0)" ::: "memory");
        }
    }
    __syncthreads();
}

#ifndef MK_MULTI
#define MK_MULTI 0
#endif
#if MK_MULTI
template <int PH> __global__ void __launch_bounds__(NTHREADS, 2) k_phase(Params Pv, int l) {
    extern __shared__ __attribute__((aligned(16))) unsigned char smem[];
    CP& P = *(CP*)__builtin_amdgcn_kernarg_segment_ptr();
    run_phase<PH>(P, l, smem);
}
#else
template <int PH> static __device__ __forceinline__ void phase_ni(int l) {
    extern __shared__ __attribute__((aligned(16))) unsigned char smem[];
    CP& P = *(CP*)__builtin_amdgcn_kernarg_segment_ptr();
    run_phase<PH>(P, l, smem);
}
__global__ void __launch_bounds__(NTHREADS, 2) k_mega(Params Pv) {
    extern __shared__ __attribute__((aligned(16))) unsigned char smem[];
    CP& P = *(CP*)__builtin_amdgcn_kernarg_segment_ptr();
    volatile LDSP unsigned* xbw = (volatile LDSP unsigned*)(smem + SMEM_BYTES);
    if (threadIdx.x == 0) { xbw[0] = 0u; xbw[1] = 0u; xbw[2] = 0u; xbw[3] = 0u; }
    __syncthreads();
    XcdBarrier bar = xcd_barrier_post(P.bar, xbw);
    phase_ni<0>(0); xcd_barrier(bar);
    phase_ni<1>(0); xcd_barrier(bar);
#pragma clang loop unroll(disable)
    for (int l = 0; l < NL; ++l) {
        phase_ni<2>(l); xcd_barrier(bar);
        phase_ni<3>(l); xcd_barrier(bar);
        phase_ni<4>(l); xcd_barrier(bar);
        phase_ni<5>(l); xcd_barrier(bar);
        phase_ni<6>(l); xcd_barrier(bar);
        phase_ni<7>(l); xcd_barrier(bar);
        phase_ni<8>(l); xcd_barrier(bar);
        phase_ni<9>(l); xcd_barrier(bar);
        phase_ni<10>(l); if (l + 1 < NL) xcd_barrier(bar);
    }
}
#endif
#endif

struct Carver { unsigned char* base; size_t off; template <class T> T* take(size_t n) { off = (off + 255) & ~(size_t)255; T* p = (T*)(base + off); off += n * sizeof(T); return p; } };
static inline size_t carve_ws(Params& P, void* d_ws) {
    Carver c{(unsigned char*)d_ws, 0};
    P.bar = c.take<unsigned>(4096);
    P.xc = c.take<float>((size_t)NCTX * D);
    P.mod = c.take<float>((size_t)NL * (B_ + 1) * MODW);
    P.hglb = c.take<float>(NL * 256);
    P.wr = c.take<float>((size_t)NL * D * 48);
    P.cshift = c.take<float>(NL * (B_ + 1) * 48);
    P.cnt = c.take<int>(NL * NEXP);
    P.list_tok = c.take<int>((size_t)NEXP * NT);
    P.list_gate = c.take<float>((size_t)NEXP * NT);
    P.tokslot = c.take<int>((size_t)NT * 2);
    P.gst = c.take<float>((size_t)2 * B_ * 4 * 2 * NCH * 4096);
    P.gdec = c.take<float>((size_t)2 * B_ * 4 * 2 * NCH * 64);
    P.win16 = c.take<half_t>((size_t)NL * D * PPAD);
    P.wout16 = c.take<half_t>((size_t)NL * D * D);
    P.wuq16 = c.take<half_t>((size_t)NL * 192 * 384);
    P.wukv16 = c.take<half_t>((size_t)NL * 128 * 512);
    P.h = c.take<half_t>((size_t)NT * D);
    P.p = c.take<half_t>((size_t)NT * PPAD);
    P.yrows = P.p;
    P.y = c.take<half_t>((size_t)NT * D);
    P.qraw = c.take<half_t>((size_t)NT * 384);
    P.kvraw = c.take<half_t>((size_t)NT * 512);
    P.mq = c.take<half_t>((size_t)B_ * 4 * KEYS * 96);
    P.mk = c.take<half_t>((size_t)B_ * 4 * KEYS * 96);
    P.mv = c.take<half_t>((size_t)B_ * 4 * KEYS * 64);
    P.nq = c.take<half_t>((size_t)B_ * 4 * KEYS * 64);
    P.nk = c.take<half_t>((size_t)B_ * 4 * KEYS * 64);
    P.nv = c.take<half_t>((size_t)B_ * 4 * KEYS * 64);
    P.act = c.take<half_t>((size_t)ACT_ROWS * 512);
    return c.off;
}
static inline void fill_inputs(Params& P, void* const* d_in, void* d_out) {
    const float* const* in = (const float* const*)d_in;
    P.x = in[0]; P.c = in[1]; P.ctx = in[2]; P.c_ctx = in[3]; P.w_ada = in[4]; P.b_ada = in[5]; P.w_in = in[6]; P.w_out = in[7];
    P.mla_g_cq = in[8]; P.mla_g_ckv = in[9]; P.mla_w_uq = in[10]; P.mla_w_ukv = in[11]; P.mla_g_qn = in[12]; P.mla_g_qr = in[13];
    P.mla_g_kn = in[14]; P.mla_g_kr = in[15]; P.na_g_q = in[16]; P.na_g_k = in[17]; P.na_rpb = in[18]; P.ret_g_out = in[19];
    P.hg_lb_raw = in[20]; P.hg_g_out = in[21]; P.moe_w_rg = in[22]; P.moe_b_rg = in[23]; P.moe_w_re = in[24]; P.moe_b_re = in[25];
    P.moe_w1 = in[26]; P.moe_w3 = in[27]; P.moe_w2 = in[28];
    P.out = (float*)d_out;
}

#ifndef CPU_EMU
extern "C" void kernel_launch(void* const* d_in, const int* in_sizes, int n_in, void* d_out, int out_size, void* d_ws, size_t ws_size, hipStream_t stream) {
    Params P{};
    fill_inputs(P, d_in, d_out);
    carve_ws(P, d_ws);
    constexpr size_t kDynLds = SMEM_BYTES + 16;
    static int grid = 0;
    if (!grid) {
        int dev = 0, cus = 0, per_cu = 0;
        (void)hipGetDevice(&dev);
        (void)hipDeviceGetAttribute(&cus, hipDeviceAttributeMultiprocessorCount, dev);
        #if MK_MULTI
        (void)hipOccupancyMaxActiveBlocksPerMultiprocessor(&per_cu, k_phase<5>, NTHREADS, kDynLds);
#else
        (void)hipOccupancyMaxActiveBlocksPerMultiprocessor(&per_cu, k_mega, NTHREADS, kDynLds);
#endif
        if (per_cu < 1) per_cu = 1;
        grid = cus * (per_cu < 2 ? per_cu : 2);
    }
#if MK_MULTI
    k_phase<0><<<grid, NTHREADS, kDynLds, stream>>>(P, 0);
    k_phase<1><<<grid, NTHREADS, kDynLds, stream>>>(P, 0);
    for (int l = 0; l < NL; ++l) {
        k_phase<2><<<grid, NTHREADS, kDynLds, stream>>>(P, l);
        k_phase<3><<<grid, NTHREADS, kDynLds, stream>>>(P, l);
        k_phase<4><<<grid, NTHREADS, kDynLds, stream>>>(P, l);
        k_phase<5><<<grid, NTHREADS, kDynLds, stream>>>(P, l);
        k_phase<6><<<grid, NTHREADS, kDynLds, stream>>>(P, l);
        k_phase<7><<<grid, NTHREADS, kDynLds, stream>>>(P, l);
        k_phase<8><<<grid, NTHREADS, kDynLds, stream>>>(P, l);
        k_phase<9><<<grid, NTHREADS, kDynLds, stream>>>(P, l);
        k_phase<10><<<grid, NTHREADS, kDynLds, stream>>>(P, l);
    }
#else
    (void)hipMemsetAsync(P.bar, 0, XCD_BAR_WORDS * sizeof(unsigned), stream);
    k_mega<<<grid, NTHREADS, kDynLds, stream>>>(P);
#endif
}
#endif
```

```cpp
#ifndef CPU_EMU
#include <hip/hip_runtime.h>
#endif
#include <stdint.h>
#include <stddef.h>

#ifndef PROBE
#define PROBE 0
#endif
#ifndef WPROBE
#define WPROBE 0
#endif
#ifndef CFG_B
#define CFG_B 8
#define CFG_SEQ 4096
#define CFG_L 4
#define CFG_CTX 256
#endif

typedef _Float16 half_t;
typedef _Float16 half8 __attribute__((ext_vector_type(8)));
typedef _Float16 half4 __attribute__((ext_vector_type(4)));
typedef short s16x4 __attribute__((ext_vector_type(4)));
typedef float f32x4 __attribute__((ext_vector_type(4)));
typedef float f32x16 __attribute__((ext_vector_type(16)));

#ifdef CPU_EMU
#define DEV inline
#define SYNC() emu::block_sync()
#define WAVE_BARRIER() emu::wave_sync()
#define SCHED_FENCE() do {} while (0)
DEV f32x4 mfma16(half8 a, half8 b, f32x4 c) { return emu::mfma_16x16x32<half8, f32x4>(a, b, c); }
DEV f32x16 mfma32(half8 a, half8 b, f32x16 c) { return emu::mfma_32x32x16<half8, f32x16>(a, b, c); }
DEV f32x4 mfmaf(float a, float b, f32x4 c) { return emu::mfma_16x16x4_f32<f32x4>(a, b, c); }
DEV half4 tr16(const half_t* p) { return emu::ds_read_tr16<half4>((const void*)p); }
DEV float shfl_xor_f(float v, int m) { return emu::shfl_xor<float>(v, m); }
DEV float shfl_f(float v, int src) { return emu::shfl<float>(v, src); }
DEV int atomic_add_i(int* p, int v) { return __atomic_fetch_add(p, v, __ATOMIC_RELAXED); }
DEV bool wave_any(bool p) { float f = p ? 1.f : 0.f; for (int m = 1; m < 64; m <<= 1) f = fmaxf(f, emu::shfl_xor<float>(f, m)); return f > 0.f; }
DEV float fexp2(float x) { return exp2f(x); }
DEV float fexp(float x) { return expf(x); }
DEV float flog(float x) { return logf(x); }
DEV float frsqrt(float x) { return 1.0f / sqrtf(x); }
DEV float frcp(float x) { return 1.0f / x; }
#else
#define DEV __device__ __forceinline__
#define SYNC() __syncthreads()
#define WAVE_BARRIER() __builtin_amdgcn_wave_barrier()
#define SCHED_FENCE() __builtin_amdgcn_sched_barrier(0)
#define LDSP __attribute__((address_space(3)))
DEV f32x4 mfma16(half8 a, half8 b, f32x4 c) { return __builtin_amdgcn_mfma_f32_16x16x32_f16(a, b, c, 0, 0, 0); }
DEV f32x16 mfma32(half8 a, half8 b, f32x16 c) { return __builtin_amdgcn_mfma_f32_32x32x16_f16(a, b, c, 0, 0, 0); }
DEV f32x4 mfmaf(float a, float b, f32x4 c) { return __builtin_amdgcn_mfma_f32_16x16x4f32(a, b, c, 0, 0, 0); }
DEV half4 tr16(const half_t* p) { s16x4 t = __builtin_amdgcn_ds_read_tr16_b64_v4i16((LDSP s16x4*)p); return __builtin_bit_cast(half4, t); }
DEV float shfl_xor_f(float v, int m) { return __shfl_xor(v, m, 64); }
DEV float shfl_f(float v, int src) { return __shfl(v, src, 64); }
DEV int atomic_add_i(int* p, int v) { return atomicAdd(p, v); }
DEV bool wave_any(bool p) { return __any(p) != 0; }
DEV float fexp2(float x) { return __builtin_amdgcn_exp2f(x); }
DEV float fexp(float x) { return __expf(x); }
DEV float flog(float x) { return __logf(x); }
DEV float frsqrt(float x) { return __builtin_amdgcn_rsqf(x); }
DEV float frcp(float x) { return __builtin_amdgcn_rcpf(x); }
#endif

#ifdef CPU_EMU
DEV float opaque0() { return 0.f; }
DEV int TID() { return (int)threadIdx.x; }
#else
DEV int TID() { int t = (int)threadIdx.x; asm volatile("" : "+v"(t)); return t; }
DEV float opaque0() { float z = 0.f; asm volatile("" : "+v"(z)); return z; }
#endif
constexpr int B_ = CFG_B, SEQ = CFG_SEQ, NL = CFG_L, CTX = CFG_CTX, D = 1024;
constexpr int NLAT = B_ * SEQ, NCTX = B_ * CTX, NT = NLAT + NCTX;
constexpr int ROWS = SEQ / 64;
constexpr int KEYS = SEQ + CTX;
constexpr int PTOT = 3424, PPAD = 3456;
constexpr int O_CQ = 0, O_CKV = 192, O_KR = 320, O_NAQ = 352, O_NAK = 608, O_NAV = 864, O_RQ = 1120, O_RK = 1376, O_RV = 1632, O_RG = 1888,
              O_HQ = 2144, O_HF = 2400, O_HB = 2656, O_HI = 2912, O_HG = 3168;
constexpr int NCH = KEYS / 64, CG = CTX / 64, LG = SEQ / 64;
constexpr int NEXP = 32, ACT_ROWS = 2 * NT + NEXP * 256;
constexpr float EPS = 1e-6f;
constexpr float LOG2E = 1.4426950408889634f;
constexpr int MODW = 6 * D;
constexpr int NTHREADS = 256;
constexpr int SMEM_BYTES = 59392;

struct Params {
    const float *x, *c, *ctx, *c_ctx, *w_ada, *b_ada, *w_in, *w_out, *mla_g_cq, *mla_g_ckv, *mla_w_uq, *mla_w_ukv, *mla_g_qn, *mla_g_qr, *mla_g_kn,
        *mla_g_kr, *na_g_q, *na_g_k, *na_rpb, *ret_g_out, *hg_lb_raw, *hg_g_out, *moe_w_rg, *moe_b_rg, *moe_w_re, *moe_b_re, *moe_w1, *moe_w3, *moe_w2;
    float* out;
    unsigned* bar;
    float *xc, *mod, *hglb, *wr, *cshift, *list_gate, *gst, *gdec, *rope;
    int *cnt, *list_tok, *tokslot, *sched;
    half_t *win16, *wout16, *wuq16, *wukv16, *h, *p, *y, *qraw, *kvraw, *mq, *mk, *mv, *nq, *nk, *nv, *act, *yrows;
};

#ifdef CPU_EMU
typedef const Params CP;
#else
typedef const __attribute__((address_space(4))) Params CP;
#endif
DEV int tok_brow(int t) { return t < NLAT ? t / SEQ : B_; }
DEV float* xrow_ptr(CP& P, int t) { return t < NLAT ? P.out + (size_t)t * D : P.xc + (size_t)(t - NLAT) * D; }
DEV float silu_f(float x) { return x * frcp(1.0f + fexp(-x)); }
DEV float sigmoid_f(float x) { return frcp(1.0f + fexp(-x)); }
DEV float wave_sum(float v) {
    v += shfl_xor_f(v, 1); v += shfl_xor_f(v, 2); v += shfl_xor_f(v, 4); v += shfl_xor_f(v, 8); v += shfl_xor_f(v, 16); v += shfl_xor_f(v, 32);
    return v;
}
DEV half4 to_half4(f32x4 v) { half4 r; r[0] = (half_t)v[0]; r[1] = (half_t)v[1]; r[2] = (half_t)v[2]; r[3] = (half_t)v[3]; return r; }

constexpr int LDB_S = 136, G_BBUF = 32 * LDB_S;
struct BSrcH {
    const half_t* base; int ld;
    typedef half8 Raw;
    DEV Raw load(int k, int n) const { return *(const half8*)(base + (size_t)k * ld + n); }
    DEV half8 cvt(const Raw& r) const { return r; }
};
struct RawF { f32x4 a, b; };
DEV half8 cvt_rawf(const RawF& r) {
    half8 h; h[0] = (half_t)r.a[0]; h[1] = (half_t)r.a[1]; h[2] = (half_t)r.a[2]; h[3] = (half_t)r.a[3];
    h[4] = (half_t)r.b[0]; h[5] = (half_t)r.b[1]; h[6] = (half_t)r.b[2]; h[7] = (half_t)r.b[3]; return h;
}
struct BSrcF {
    const float* base; int ld;
    typedef RawF Raw;
    DEV Raw load(int k, int n) const { const float* s = base + (size_t)k * ld + n; RawF r; r.a = *(const f32x4*)s; r.b = *(const f32x4*)(s + 4); return r; }
    DEV half8 cvt(const Raw& r) const { return cvt_rawf(r); }
};
struct BSrcF2 {
    const float* b0; ptrdiff_t d10; int ld;
    typedef RawF Raw;
    DEV Raw load(int k, int n) const { const float* s = b0 + (ptrdiff_t)(n >> 6) * d10 + (n & 63) + (size_t)k * ld; RawF r; r.a = *(const f32x4*)s; r.b = *(const f32x4*)(s + 4); return r; }
    DEV half8 cvt(const Raw& r) const { return cvt_rawf(r); }
};
DEV int swzB(int k, int ch) { return k * LDB_S + (ch << 3); }
template <class ARow, class BS, class Epi>
DEV void gemm256(const ARow& arow, const BS& bs, int K, Epi& epi, unsigned char* smem) {
    half_t* Bs = (half_t*)smem;
    const int tid = TID(), lane = tid & 63, w = tid >> 6, g = lane >> 4, li = lane & 15;
    const int bk = tid >> 4, bch = tid & 15;
    const int q = li >> 2, pp = li & 3;
    const half_t* ap[4];
#pragma unroll
    for (int mt = 0; mt < 4; ++mt) ap[mt] = arow(64 * w + 16 * mt + li) + 8 * g;
    half8 ac[4], an[4]; typename BS::Raw bn[2];
#pragma unroll
    for (int mt = 0; mt < 4; ++mt) ac[mt] = *(const half8*)(ap[mt]);
#pragma unroll
    for (int i = 0; i < 2; ++i) bn[i] = bs.load(bk + 16 * i, bch * 8);
    f32x4 acc[4][8];
#pragma unroll
    for (int mt = 0; mt < 4; ++mt)
#pragma unroll
        for (int nt = 0; nt < 8; ++nt) acc[mt][nt] = (f32x4){0.f, 0.f, 0.f, 0.f};
    SYNC();
#pragma unroll
    for (int i = 0; i < 2; ++i) *(half8*)(Bs + swzB(bk + 16 * i, bch)) = bs.cvt(bn[i]);
    SYNC();
    const int nk = K >> 5;
    for (int it = 0; it < nk; ++it) {
        const half_t* Bc = Bs + (it & 1) * G_BBUF;
        if (it + 1 < nk) {
#pragma unroll
            for (int mt = 0; mt < 4; ++mt) an[mt] = *(const half8*)(ap[mt] + (it + 1) * 32);
#pragma unroll
            for (int i = 0; i < 2; ++i) bn[i] = bs.load((it + 1) * 32 + bk + 16 * i, bch * 8);
        }
        SCHED_FENCE();
#pragma unroll
        for (int nh = 0; nh < 2; ++nh) {
            half8 bf[4];
#pragma unroll
            for (int n4 = 0; n4 < 4; ++n4) {
                const int k0 = 8 * g + q, ch = 2 * (4 * nh + n4) + (pp >> 1);
                const half4 lo = tr16(Bc + swzB(k0, ch) + 4 * (pp & 1)), hi = tr16(Bc + swzB(k0 + 4, ch) + 4 * (pp & 1));
                bf[n4][0] = lo[0]; bf[n4][1] = lo[1]; bf[n4][2] = lo[2]; bf[n4][3] = lo[3]; bf[n4][4] = hi[0]; bf[n4][5] = hi[1]; bf[n4][6] = hi[2]; bf[n4][7] = hi[3];
            }
            SCHED_FENCE();
#pragma unroll
            for (int n4 = 0; n4 < 4; ++n4)
#pragma unroll
                for (int mt = 0; mt < 4; ++mt) acc[mt][4 * nh + n4] = mfma16(bf[n4], ac[mt], acc[mt][4 * nh + n4]);
        }
        if (it + 1 < nk) {
            half_t* Bn = Bs + ((it + 1) & 1) * G_BBUF;
#pragma unroll
            for (int i = 0; i < 2; ++i) *(half8*)(Bn + swzB(bk + 16 * i, bch)) = bs.cvt(bn[i]);
#pragma unroll
            for (int mt = 0; mt < 4; ++mt) ac[mt] = an[mt];
        }
        SYNC();
    }
    epi.run(acc, w, g, li);
}
struct ARowLin { const half_t* base; int ld; DEV const half_t* operator()(int r) const { return base + (size_t)r * ld; } };
struct ARowGather { const half_t* base; int ld; const int* idx; int nvalid; DEV const half_t* operator()(int r) const { const int t = r < nvalid ? idx[r] : 0; return base + (size_t)t * ld; } };

struct EpiStoreH {
    half_t* out; int ld;
    DEV void run(const f32x4 (&acc)[4][8], int w, int g, int li) const {
#pragma unroll
        for (int mt = 0; mt < 4; ++mt)
#pragma unroll
            for (int nt = 0; nt < 8; ++nt) *(half4*)(out + (size_t)(64 * w + 16 * mt + li) * ld + 16 * nt + 4 * g) = to_half4(acc[mt][nt]);
    }
};
struct EpiResid {
    float* x; const float* gate;
    DEV void run(const f32x4 (&acc)[4][8], int w, int g, int li) const {
        f32x4 gt[8];
#pragma unroll
        for (int nt = 0; nt < 8; ++nt) gt[nt] = *(const f32x4*)(gate + 16 * nt + 4 * g);
#pragma unroll
        for (int mt = 0; mt < 4; ++mt) {
            f32x4 xv[8];
            float* xr = x + (size_t)(64 * w + 16 * mt + li) * D + 4 * g;
#pragma unroll
            for (int nt = 0; nt < 8; ++nt) xv[nt] = *(const f32x4*)(xr + 16 * nt);
            SCHED_FENCE();
#pragma unroll
            for (int nt = 0; nt < 8; ++nt) *(f32x4*)(xr + 16 * nt) = xv[nt] + gt[nt] * acc[mt][nt];
        }
    }
};
struct EpiGlu {
    half_t* out; int ld;
    DEV void run(const f32x4 (&acc)[4][8], int w, int g, int li) const {
#pragma unroll
        for (int mt = 0; mt < 4; ++mt)
#pragma unroll
            for (int nt = 0; nt < 4; ++nt) {
                f32x4 o;
#pragma unroll
                for (int r = 0; r < 4; ++r) o[r] = silu_f(acc[mt][nt][r]) * acc[mt][nt + 4][r];
                *(half4*)(out + (size_t)(64 * w + 16 * mt + li) * ld + 16 * nt + 4 * g) = to_half4(o);
            }
    }
};
struct EpiRowsGate {
    half_t* out; const float* gate; int nvalid;
    DEV void run(const f32x4 (&acc)[4][8], int w, int g, int li) const {
#pragma unroll
        for (int mt = 0; mt < 4; ++mt) {
            const int row = 64 * w + 16 * mt + li;
            if (row < nvalid) {
                const float gt = gate[row];
#pragma unroll
                for (int nt = 0; nt < 8; ++nt) *(half4*)(out + (size_t)row * D + 16 * nt + 4 * g) = to_half4(acc[mt][nt] * gt);
            }
        }
    }
};

DEV void phase_prologue_a(CP& P, unsigned char* smem) {
    const int tid = TID(), gtid = blockIdx.x * NTHREADS + tid, gsz = gridDim.x * NTHREADS;
    for (size_t i = gtid; i < (size_t)NL * D * (PPAD / 8); i += gsz) {
        const int cc = (int)(i % (PPAD / 8)) * 8; const size_t rk = i / (PPAD / 8);
        half8 h;
#pragma unroll
        for (int j = 0; j < 8; ++j) h[j] = (cc + j < PTOT) ? (half_t)P.w_in[rk * PTOT + cc + j] : (half_t)0.f;
        *(half8*)(P.win16 + rk * PPAD + cc) = h;
    }
    for (size_t i = gtid; i < (size_t)NL * D * D / 8; i += gsz) {
        const f32x4 a = *(const f32x4*)(P.w_out + i * 8), b = *(const f32x4*)(P.w_out + i * 8 + 4);
        RawF r; r.a = a; r.b = b; *(half8*)(P.wout16 + i * 8) = cvt_rawf(r);
    }
    for (int i = gtid; i < NL * 192 * 384; i += gsz) { const int l = i / (192 * 384), k = (i / 384) % 192; P.wuq16[i] = (half_t)(P.mla_g_cq[l * 192 + k] * P.mla_w_uq[i]); }
    for (int i = gtid; i < NL * 128 * 512; i += gsz) { const int l = i / (128 * 512), k = (i / 512) % 128; P.wukv16[i] = (half_t)(P.mla_g_ckv[l * 128 + k] * P.mla_w_ukv[i]); }
    for (int i = gtid; i < 256; i += gsz) {
        float mx = -1e30f; for (int l = 0; l < NL; ++l) mx = fmaxf(mx, P.hg_lb_raw[l * 256 + i]);
        float den = 0.f; for (int l = 0; l < NL; ++l) den += fexp(P.hg_lb_raw[l * 256 + i] - mx);
        float cum = 0.f;
        for (int l = 0; l < NL; ++l) { const float wv = fexp(P.hg_lb_raw[l * 256 + i] - mx) / den; if (l > 0) cum += wv; P.hglb[l * 256 + i] = cum; }
    }
    for (int i = gtid; i < NL * D * 48; i += gsz) {
        const int n = i % 48, lk = i / 48;
        P.wr[i] = n < 4 ? P.moe_w_rg[lk * 4 + n] : (n < 36 ? P.moe_w_re[lk * 32 + (n - 4)] : 0.f);
    }
    for (int i = gtid; i < NL * NEXP; i += gsz) P.cnt[i] = 0;
    for (int i = gtid; i < NL * 16; i += gsz) P.sched[i] = 0;
    for (int i = gtid; i < SEQ * 16; i += gsz) {
        const int n = i >> 4, j = i & 15, ax = j >> 3, fi = j & 7;
        const float ang = (float)(ax == 0 ? n / 64 : n % 64) * fexp(-9.210340371976184f * (float)fi * 0.125f);
        P.rope[n * 32 + j] = cosf(ang); P.rope[n * 32 + 16 + j] = sinf(ang);
    }
    float* sc = (float*)smem;
    SYNC();
    for (int i = tid; i < (B_ + 1) * D; i += NTHREADS) { const int r = i / D, k = i % D; const float v = r < B_ ? P.c[r * D + k] : P.c_ctx[k]; sc[i] = silu_f(v); }
    SYNC();
    for (int item = blockIdx.x; item < NL * (MODW / 256); item += gridDim.x) {
        const int l = item / (MODW / 256), n = (item % (MODW / 256)) * 256 + tid;
        float acc[B_ + 1];
#pragma unroll
        for (int r = 0; r <= B_; ++r) acc[r] = 0.f;
        const float* wp = P.w_ada + (size_t)l * D * MODW + n;
        for (int k = 0; k < D; ++k) {
            const float wv = wp[(size_t)k * MODW];
#pragma unroll
            for (int r = 0; r <= B_; ++r) acc[r] += sc[r * D + k] * wv;
        }
        const float bv = P.b_ada[l * MODW + n];
#pragma unroll
        for (int r = 0; r <= B_; ++r) P.mod[((size_t)l * (B_ + 1) + r) * MODW + n] = acc[r] + bv;
    }
}

DEV void row_modulate_store(const f32x4 (&v)[4], const float* sh, const float* sc, half_t* hrow, int lane) {
    f32x4 s4[4], h4[4];
#pragma unroll
    for (int j = 0; j < 4; ++j) { s4[j] = *(const f32x4*)(sc + 256 * j + 4 * lane); h4[j] = *(const f32x4*)(sh + 256 * j + 4 * lane); }
    float ss = 0.f;
#pragma unroll
    for (int j = 0; j < 4; ++j) ss += v[j][0] * v[j][0] + v[j][1] * v[j][1] + v[j][2] * v[j][2] + v[j][3] * v[j][3];
    ss = wave_sum(ss);
    const float rstd = frsqrt(ss * (1.0f / D) + EPS);
#pragma unroll
    for (int j = 0; j < 4; ++j) {
        f32x4 o;
#pragma unroll
        for (int e = 0; e < 4; ++e) o[e] = v[j][e] * rstd * (1.0f + s4[j][e]) + h4[j][e];
        *(half4*)(hrow + 256 * j + 4 * lane) = to_half4(o);
    }
}
DEV void phase_prologue_b(CP& P) {
    const int lane = TID() & 63, gw = blockIdx.x * 4 + (TID() >> 6), nw = gridDim.x * 4;
    for (int t = gw; t < NT; t += nw) {
        const float* src = t < NLAT ? P.x + (size_t)t * D : P.ctx + (size_t)(t - NLAT) * D;
        float* dst = xrow_ptr(P, t);
        f32x4 v[4];
#pragma unroll
        for (int j = 0; j < 4; ++j) { v[j] = *(const f32x4*)(src + 256 * j + 4 * lane); *(f32x4*)(dst + 256 * j + 4 * lane) = v[j]; }
        const float* md = P.mod + (size_t)tok_brow(t) * MODW;
        row_modulate_store(v, md + 0, md + D, P.h + (size_t)t * D, lane);
    }
    for (int it = gw; it < NL * (B_ + 1) * 36; it += nw) {
        const int n = it % 36, lr = it / 36, l = lr / (B_ + 1);
        const float* sh = P.mod + (size_t)lr * MODW + 3 * D;
        float s = 0.f;
        for (int k = lane; k < D; k += 64) s += sh[k] * P.wr[((size_t)l * D + k) * 48 + n];
        s = wave_sum(s);
        if (lane == 0) P.cshift[lr * 48 + n] = s + (n < 4 ? P.moe_b_rg[l * 4 + n] : P.moe_b_re[l * 32 + n - 4]);
    }
}

DEV bool gemm_tile_order(int round, int ntm, int ntn, int& tm, int& tn) {
    const int per = gridDim.x >> 3;
    const int idx = ((round << 3) + (blockIdx.x & 7)) * per + (blockIdx.x >> 3);
    if (idx >= ntm * ntn) return false;
    const int nig = 8 * ntn, gid = idx / nig, fm = gid * 8, gsz = (ntm - fm) < 8 ? (ntm - fm) : 8, rem = idx - gid * nig;
    tm = fm + rem % gsz; tn = rem / gsz; return true;
}
DEV void phase_inproj(CP& P, int l, unsigned char* smem) {
    constexpr int NTN = PPAD / 128, NTM = NT / 256;
    const int rounds = (NTM * NTN + gridDim.x - 1) / gridDim.x;
    for (int rep = 0; rep < ((PROBE & 1) ? 2 : 1); ++rep)
    for (int round = 0; round < rounds; ++round) {
        int tm, tn;
        if (!gemm_tile_order(round, NTM, NTN, tm, tn)) continue;
        ARowLin ar{P.h + (size_t)tm * 256 * D, D};
        BSrcH bs{P.win16 + (size_t)l * D * PPAD + tn * 128, PPAD};
        EpiStoreH epi{P.p + (size_t)tm * 256 * PPAD + tn * 128, PPAD};
        gemm256(ar, bs, D, epi, smem);
    }
}

constexpr int GQ_LD = 68, GH_LD = 72, GS_LD = 24;
constexpr int G_QF = 0, G_KF = 17408, G_KH = 34816, G_VH = 44032, G_SC = 53248, G_DK = 56320, G_RED = 57344;
DEV float ret_loggamma(int h, int dir) { return log1pf(-exp2f(-5.0f - (float)(2 * h + dir))); }
template <int MIX, bool OUT, int dir>
DEV void gla_stage(CP& P, int l, int h, int tok0, float lgam, float& totsum, unsigned char* smem) {
    float* Qf = (float*)(smem + G_QF); float* Kf = (float*)(smem + G_KF); half_t* Kh = (half_t*)(smem + G_KH); half_t* Vh = (half_t*)(smem + G_VH);
    float* dk = (float*)(smem + G_DK);
    const int tid = TID(), d = tid & 63, I = tid >> 6;
    const half_t* pr = P.p + (size_t)(tok0 + 16 * I) * PPAD + h * 64 + d;
    float lf[16], kk[16], qq[16];
    half_t vv[16], rq[16], rk[16];
    float lb = 0.f;
    if (MIX == 1) lb = P.hglb[l * 256 + h * 64 + d];
#pragma unroll
    for (int i = 0; i < 16; ++i) {
        const half_t* pi = pr + (size_t)i * PPAD;
        if (MIX == 0) { rq[i] = OUT ? pi[O_RQ] : (half_t)0.f; rk[i] = pi[O_RK]; vv[i] = pi[O_RV]; }
        else { rq[i] = OUT ? pi[O_HQ] : (half_t)0.f; rk[i] = pi[dir ? O_HB : O_HF]; vv[i] = pi[O_HI]; }
    }
    SCHED_FENCE();
    float tot = 0.f;
#pragma unroll
    for (int i = 0; i < 16; ++i) {
        if (MIX == 0) {
            qq[i] = (float)rq[i]; kk[i] = (float)rk[i] * 0.125f; lf[i] = lgam;
        } else {
            qq[i] = OUT ? silu_f((float)rq[i]) : 0.f;
            const float sg = sigmoid_f((float)rk[i]), f = lb + (1.0f - lb) * sg;
            lf[i] = flog(fmaxf(f, 1e-20f)); kk[i] = (1.0f - lb) * (1.0f - sg);
        }
        tot += lf[i];
    }
    float bc = 0.f;
#pragma unroll
    for (int ii = 0; ii < 16; ++ii) {
        const int i = dir == 0 ? ii : 15 - ii;
        bc += lf[i];
        const int o = (I * 16 + i);
        if (OUT) { Qf[o * GQ_LD + d] = qq[i] * fexp(bc); Kf[o * GQ_LD + d] = kk[i] * fexp(fminf(-bc, 80.0f)); }
        Kh[o * GH_LD + d] = (half_t)(kk[i] * fexp(tot - bc));
        Vh[o * GH_LD + d] = vv[i];
    }
    dk[I * 64 + d] = fexp(tot);
    totsum += tot;
}
DEV half8 tok_frag(const half_t* img, int col0, int lane) {
    const int g = lane >> 4, li = lane & 15, q = li >> 2, p = li & 3;
    const half_t* a = img + (8 * (g & 1) + q) * GH_LD + col0 + 4 * p;
    const half4 lo = tr16(a), hi = tr16(a + 4 * GH_LD);
    half8 r;
    const bool z = g >= 2;
    r[0] = z ? (half_t)0.f : lo[0]; r[1] = z ? (half_t)0.f : lo[1]; r[2] = z ? (half_t)0.f : lo[2]; r[3] = z ? (half_t)0.f : lo[3];
    r[4] = z ? (half_t)0.f : hi[0]; r[5] = z ? (half_t)0.f : hi[1]; r[6] = z ? (half_t)0.f : hi[2]; r[7] = z ? (half_t)0.f : hi[3];
    return r;
}
DEV void gla_scores(int dir, unsigned char* smem) {
    const float* Qf = (const float*)(smem + G_QF); const float* Kf = (const float*)(smem + G_KF); half_t* sc = (half_t*)(smem + G_SC);
    const int tid = TID(), lane = tid & 63, w = tid >> 6, g = lane >> 4, li = lane & 15;
    f32x4 s0 = {0.f, 0.f, 0.f, 0.f}, s1 = {0.f, 0.f, 0.f, 0.f};
    const float* kp = Kf + (w * 16 + li) * GQ_LD + g; const float* qp = Qf + (w * 16 + li) * GQ_LD + g;
#pragma unroll
    for (int kk = 0; kk < 16; kk += 2) { s0 = mfmaf(kp[4 * kk], qp[4 * kk], s0); s1 = mfmaf(kp[4 * kk + 4], qp[4 * kk + 4], s1); }
    half4 o;
#pragma unroll
    for (int r = 0; r < 4; ++r) { const int sj = 4 * g + r; const bool keep = dir == 0 ? (sj <= li) : (sj >= li); o[r] = keep ? (half_t)(s0[r] + s1[r]) : (half_t)0.f; }
    *(half4*)(sc + (w * 16 + li) * GS_LD + 4 * g) = o;
}
template <bool OUT>
DEV void gla_main_sub(int I, f32x4 (&st)[4], f32x4& oacc, unsigned char* smem) {
    const float* Qf = (const float*)(smem + G_QF); const half_t* Kh = (const half_t*)(smem + G_KH); const half_t* Vh = (const half_t*)(smem + G_VH);
    const half_t* sc = (const half_t*)(smem + G_SC); const float* dk = (const float*)(smem + G_DK);
    const int tid = TID(), lane = tid & 63, w = tid >> 6, g = lane >> 4, li = lane & 15;
    const half8 vfr = tok_frag(Vh + I * 16 * GH_LD, 16 * w, lane);
    if (OUT) {
        const half8 sf = *(const half8*)(sc + (I * 16 + li) * GS_LD + 8 * (g & 1));
        oacc = mfma16(vfr, sf, oacc);
#pragma unroll
        for (int ks = 0; ks < 2; ++ks) {
            half8 sa, qb;
            const f32x4 q0 = *(const f32x4*)(Qf + (I * 16 + li) * GQ_LD + 32 * ks + 4 * g), q1 = *(const f32x4*)(Qf + (I * 16 + li) * GQ_LD + 32 * ks + 16 + 4 * g);
#pragma unroll
            for (int j = 0; j < 4; ++j) { sa[j] = (half_t)st[2 * ks][j]; sa[4 + j] = (half_t)st[2 * ks + 1][j]; qb[j] = (half_t)q0[j]; qb[4 + j] = (half_t)q1[j]; }
            oacc = mfma16(sa, qb, oacc);
        }
    }
#pragma unroll
    for (int dt = 0; dt < 4; ++dt) {
        const f32x4 dv = *(const f32x4*)(dk + I * 64 + 16 * dt + 4 * g);
#pragma unroll
        for (int r = 0; r < 4; ++r) st[dt][r] *= dv[r];
        st[dt] = mfma16(tok_frag(Kh + I * 16 * GH_LD, 16 * dt, lane), vfr, st[dt]);
    }
}
DEV int gla_tok0(int b, int gidx) { return gidx < CG ? NLAT + b * CTX + 64 * gidx : b * SEQ + 64 * (gidx - CG); }
DEV int gla_chainpos(int gidx, int dir) { return dir == 0 ? gidx : (gidx < CG ? CG - 1 - gidx : CG + (LG - 1 - (gidx - CG))); }
DEV size_t gla_chain(int mix, int b, int h, int dir) { return (((size_t)mix * B_ + b) * 4 + h) * 2 + dir; }
template <int MIX>
DEV void gla_step_a(CP& P, int l, int b, int h, int dir, int gidx, unsigned char* smem) {
    const int tid = TID(), lane = tid & 63, w = tid >> 6, g = lane >> 4, li = lane & 15;
    f32x4 st[4]; f32x4 od = {0.f, 0.f, 0.f, 0.f};
#pragma unroll
    for (int dt = 0; dt < 4; ++dt) st[dt] = (f32x4){0.f, 0.f, 0.f, 0.f};
    float totsum = 0.f;
    const float lgam = MIX == 0 ? ret_loggamma(h, dir) : 0.f;
    if (dir == 0) gla_stage<MIX, false, 0>(P, l, h, gla_tok0(b, gidx), lgam, totsum, smem); else gla_stage<MIX, false, 1>(P, l, h, gla_tok0(b, gidx), lgam, totsum, smem);
    SYNC();
#pragma unroll
    for (int ii = 0; ii < 4; ++ii) gla_main_sub<false>(dir == 0 ? ii : 3 - ii, st, od, smem);
    const size_t slot = gla_chain(MIX, b, h, dir) * NCH + gla_chainpos(gidx, dir);
    float* dst = P.gst + slot * 4096;
#pragma unroll
    for (int dt = 0; dt < 4; ++dt)
#pragma unroll
        for (int r = 0; r < 4; ++r) dst[(16 * dt + 4 * g + r) * 64 + 16 * w + li] = st[dt][r];
    if (tid < 64) { const float* dk = (const float*)(smem + G_DK); P.gdec[slot * 64 + tid] = dk[tid] * dk[64 + tid] * dk[128 + tid] * dk[192 + tid]; }
    SYNC();
}
template <int MIX>
DEV void gla_step_c(CP& P, int l, int b, int h, int gidx, unsigned char* smem) {
    const int tid = TID(), lane = tid & 63, w = tid >> 6, g = lane >> 4, li = lane & 15;
    f32x4 oacc[4];
#pragma unroll
    for (int I = 0; I < 4; ++I) oacc[I] = (f32x4){0.f, 0.f, 0.f, 0.f};
    const int tok0 = gla_tok0(b, gidx);
    float totsum = 0.f;
#pragma unroll
    for (int dir = 0; dir < 2; ++dir) {
        const size_t slot = gla_chain(MIX, b, h, dir) * NCH + gla_chainpos(gidx, dir);
        const float* src = P.gst + slot * 4096;
        f32x4 st[4];
#pragma unroll
        for (int dt = 0; dt < 4; ++dt)
#pragma unroll
            for (int r = 0; r < 4; ++r) st[dt][r] = src[(16 * dt + 4 * g + r) * 64 + 16 * w + li];
        const float lgam = MIX == 0 ? ret_loggamma(h, dir) : 0.f;
        if (dir == 1) SYNC();
        if (dir == 0) gla_stage<MIX, true, 0>(P, l, h, tok0, lgam, totsum, smem); else gla_stage<MIX, true, 1>(P, l, h, tok0, lgam, totsum, smem);
        SYNC();
        gla_scores(dir, smem);
        SYNC();
#pragma unroll
        for (int ii = 0; ii < 4; ++ii) { const int I = dir == 0 ? ii : 3 - ii; gla_main_sub<true>(I, st, oacc[I], smem); }
    }
    float* red = (float*)(smem + G_RED);
#pragma unroll
    for (int I = 0; I < 4; ++I) {
        float ss = oacc[I][0] * oacc[I][0] + oacc[I][1] * oacc[I][1] + oacc[I][2] * oacc[I][2] + oacc[I][3] * oacc[I][3];
        ss += shfl_xor_f(ss, 16); ss += shfl_xor_f(ss, 32);
        if (g == 0) red[w * 64 + 16 * I + li] = ss;
    }
    SYNC();
    const float* gain = (MIX == 0 ? P.ret_g_out : P.hg_g_out) + l * 64;
    const int ycol = (MIX == 0 ? 512 : 768) + h * 64 + 16 * w + 4 * g, gcol = (MIX == 0 ? O_RG : O_HG) + h * 64 + 16 * w + 4 * g;
#pragma unroll
    for (int I = 0; I < 4; ++I) {
        const int ti = 16 * I + li, t = tok0 + ti;
        const float tot = red[ti] + red[64 + ti] + red[128 + ti] + red[192 + ti];
        const float rstd = frsqrt(tot * (1.0f / 64.0f) + EPS);
        const half4 gt = *(const half4*)(P.p + (size_t)t * PPAD + gcol);
        f32x4 o;
#pragma unroll
        for (int r = 0; r < 4; ++r) o[r] = oacc[I][r] * rstd * gain[16 * w + 4 * g + r] * silu_f((float)gt[r]);
        *(half4*)(P.y + (size_t)t * D + ycol) = to_half4(o);
    }
    SYNC();
}
DEV void gla_scan(CP& P, int item, float* gst, int chain_off) {
    const int chain = item >> 2, e4 = ((item & 3) << 8) + TID(), d = e4 >> 4;
    float* base = gst + (size_t)(chain - chain_off) * NCH * 4096 + 4 * e4;
    const float* dec = P.gdec + (size_t)chain * NCH * 64 + d;
    const float z0 = opaque0();
    f32x4 s = {z0, z0, z0, z0};
    static_assert(NCH % 17 == 0 || NCH % 4 == 0, "scan batch");
    constexpr int BT = (NCH % 17 == 0) ? 17 : 4;
    for (int pos = 0; pos < NCH; pos += BT) {
        f32x4 ds[BT]; float dc[BT];
#pragma unroll
        for (int j = 0; j < BT; ++j) { ds[j] = *(const f32x4*)(base + (size_t)(pos + j) * 4096); dc[j] = dec[(pos + j) * 64]; }
#pragma unroll
        for (int j = 0; j < BT; ++j) { *(f32x4*)(base + (size_t)(pos + j) * 4096) = s; s = s * dc[j] + ds[j]; }
    }
}

DEV void up_glaa_item(CP& P, int l, int item, unsigned char* smem) {
    constexpr int NTM = NT / 256, NQ = NTM * 3, NKV = NTM * 4;
    if (item < NQ) {
        const int tm = item / 3, tn = item % 3;
        ARowLin ar{P.p + (size_t)tm * 256 * PPAD + O_CQ, PPAD};
        BSrcH bs{P.wuq16 + (size_t)l * 192 * 384 + tn * 128, 384};
        EpiStoreH epi{P.qraw + (size_t)tm * 256 * 384 + tn * 128, 384};
        gemm256(ar, bs, 192, epi, smem);
    } else if (item < NQ + NKV) {
        const int it = item - NQ, tm = it / 4, tn = it % 4;
        ARowLin ar{P.p + (size_t)tm * 256 * PPAD + O_CKV, PPAD};
        BSrcH bs{P.wukv16 + (size_t)l * 128 * 512 + tn * 128, 512};
        EpiStoreH epi{P.kvraw + (size_t)tm * 256 * 512 + tn * 128, 512};
        gemm256(ar, bs, 128, epi, smem);
    } else {
        int it = item - NQ - NKV;
        const int gidx = it % NCH; it /= NCH; const int dir = it & 1; it >>= 1; const int h = it & 3; it >>= 2; const int b = it % B_; const int mix = it / B_;
        SYNC();
        if (mix == 0) gla_step_a<0>(P, l, b, h, dir, gidx, smem); else gla_step_a<1>(P, l, b, h, dir, gidx, smem);
    }
}
DEV void phase_up_glaa(CP& P, int l, unsigned char* smem) {
    constexpr int NTM = NT / 256, NQ = NTM * 3, NKV = NTM * 4, NGA = 2 * B_ * 4 * 2 * NCH;
    for (int item = blockIdx.x; item < NQ + NKV + NGA; item += gridDim.x) up_glaa_item(P, l, item, smem);
    if (PROBE & 2) for (int item = blockIdx.x; item < NQ + NKV; item += gridDim.x) up_glaa_item(P, l, item, smem);
    if (PROBE & 4) for (int item = blockIdx.x; item < NGA; item += gridDim.x) up_glaa_item(P, l, NQ + NKV + item, smem);
}

DEV float sumsq8(half8 v) { float s = 0.f;
#pragma unroll
    for (int j = 0; j < 8; ++j) s += (float)v[j] * (float)v[j];
    return s; }
DEV void rope32(const half8 (&in)[4], float pre, const float* gain, const float* cs_tab, bool rot, float post, half8 (&out)[4]) {
    float v[32]; float ss = 0.f;
#pragma unroll
    for (int j = 0; j < 32; ++j) { v[j] = (float)in[j >> 3][j & 7] * pre; ss += v[j] * v[j]; }
    const float r = frsqrt(ss * (1.0f / 32.0f) + EPS);
#pragma unroll
    for (int j = 0; j < 32; ++j) v[j] = v[j] * r * gain[j];
#pragma unroll
    for (int ax = 0; ax < 2; ++ax)
#pragma unroll
        for (int i = 0; i < 8; ++i) {
            const float c = rot ? cs_tab[ax * 8 + i] : 1.f, sn = rot ? cs_tab[16 + ax * 8 + i] : 0.f;
            const float z1 = v[16 * ax + i], z2 = v[16 * ax + 8 + i];
            v[16 * ax + i] = z1 * c - z2 * sn; v[16 * ax + 8 + i] = z2 * c + z1 * sn;
        }
#pragma unroll
    for (int j = 0; j < 32; ++j) out[j >> 3][j & 7] = (half_t)(v[j] * post);
}
DEV void norm64_store(const half8 (&in)[8], float pre, const float* gain, float post, half_t* dst) {
    float ss = 0.f;
#pragma unroll
    for (int c = 0; c < 8; ++c) ss += sumsq8(in[c]);
    const float r = frsqrt(ss * pre * pre * (1.0f / 64.0f) + EPS) * pre * post;
#pragma unroll
    for (int c = 0; c < 8; ++c) {
        const f32x4 g0 = *(const f32x4*)(gain + 8 * c), g1 = *(const f32x4*)(gain + 8 * c + 4);
        half8 o;
#pragma unroll
        for (int j = 0; j < 4; ++j) { o[j] = (half_t)((float)in[c][j] * r * g0[j]); o[4 + j] = (half_t)((float)in[c][4 + j] * r * g1[j]); }
        *(half8*)(dst + 8 * c) = o;
    }
}
DEV void mixer_prep_item(CP& P, int l, int item) {
    const int tid = TID(), t = item * 16 + (tid & 15), job = tid >> 4, h = job & 3;
    const int b = t < NLAT ? t / SEQ : (t - NLAT) / CTX;
    const bool lat = t < NLAT;
    const int n = lat ? t % SEQ : 0;
    const int pos = lat ? n : SEQ + (t - NLAT) % CTX;
    const half_t* pr = P.p + (size_t)t * PPAD;
    const size_t row = (size_t)(b * 4 + h) * KEYS + pos;
    const float* cst = P.rope + (size_t)n * 32;
    if (job < 4) {
        const half_t* qr = P.qraw + (size_t)t * 384 + h * 96;
        half8 cq[24], qn[8], qro[4], qo[4];
#pragma unroll
        for (int c = 0; c < 24; ++c) cq[c] = *(const half8*)(pr + O_CQ + 8 * c);
#pragma unroll
        for (int c = 0; c < 8; ++c) qn[c] = *(const half8*)(qr + 8 * c);
#pragma unroll
        for (int c = 0; c < 4; ++c) qro[c] = *(const half8*)(qr + 64 + 8 * c);
        SCHED_FENCE();
        float s1 = 0.f;
#pragma unroll
        for (int c = 0; c < 24; ++c) s1 += sumsq8(cq[c]);
        const float rq = frsqrt(s1 * (1.0f / 192.0f) + EPS);
        const float qs = 0.10206207261596575f * LOG2E;
        norm64_store(qn, rq, P.mla_g_qn + l * 64, qs, P.mq + row * 96);
        rope32(qro, rq, P.mla_g_qr + l * 32, cst, lat, qs, qo);
#pragma unroll
        for (int c = 0; c < 4; ++c) *(half8*)(P.mq + row * 96 + 64 + 8 * c) = qo[c];
    } else if (job < 8) {
        const half_t* kr = P.kvraw + (size_t)t * 512 + h * 128;
        half8 ckv[16], kn[8], kvv[8], kri[4], kro[4];
#pragma unroll
        for (int c = 0; c < 16; ++c) ckv[c] = *(const half8*)(pr + O_CKV + 8 * c);
#pragma unroll
        for (int c = 0; c < 8; ++c) { kn[c] = *(const half8*)(kr + 8 * c); kvv[c] = *(const half8*)(kr + 64 + 8 * c); }
#pragma unroll
        for (int c = 0; c < 4; ++c) kri[c] = *(const half8*)(pr + O_KR + 8 * c);
        SCHED_FENCE();
        float s2 = 0.f;
#pragma unroll
        for (int c = 0; c < 16; ++c) s2 += sumsq8(ckv[c]);
        const float rkv = frsqrt(s2 * (1.0f / 128.0f) + EPS);
        norm64_store(kn, rkv, P.mla_g_kn + l * 64, 1.0f, P.mk + row * 96);
        rope32(kri, 1.0f, P.mla_g_kr + l * 32, cst, lat, 1.0f, kro);
#pragma unroll
        for (int c = 0; c < 4; ++c) *(half8*)(P.mk + row * 96 + 64 + 8 * c) = kro[c];
#pragma unroll
        for (int c = 0; c < 8; ++c) {
            const half8 v = kvv[c]; half8 o;
#pragma unroll
            for (int j = 0; j < 8; ++j) o[j] = (half_t)((float)v[j] * rkv);
            *(half8*)(P.mv + row * 64 + 8 * c) = o;
        }
    } else if (job < 12) {
        half8 a[8], a2[8];
#pragma unroll
        for (int c = 0; c < 8; ++c) { a[c] = *(const half8*)(pr + O_NAQ + h * 64 + 8 * c); a2[c] = *(const half8*)(pr + O_NAK + h * 64 + 8 * c); }
        SCHED_FENCE();
        norm64_store(a, 1.0f, P.na_g_q + l * 64, 0.125f * LOG2E, P.nq + row * 64);
        norm64_store(a2, 1.0f, P.na_g_k + l * 64, 1.0f, P.nk + row * 64);
    } else {
        half8 a[8];
#pragma unroll
        for (int c = 0; c < 8; ++c) a[c] = *(const half8*)(pr + O_NAV + h * 64 + 8 * c);
        SCHED_FENCE();
#pragma unroll
        for (int c = 0; c < 8; ++c) *(half8*)(P.nv + row * 64 + 8 * c) = a[c];
    }
}
DEV void phase_prep_scan(CP& P, int l, int rep) {
    constexpr int NSCAN = 2 * B_ * 4 * 2 * 4;
    constexpr int NPREP = NT / 16;
    for (int item = blockIdx.x; item < NSCAN + NPREP; item += gridDim.x) {
        if (item < NSCAN) {
            if (!rep) gla_scan(P, item, P.gst, 0);
            else if (item < NSCAN / 2) gla_scan(P, item, (float*)P.y, 0);
            else gla_scan(P, item, (float*)P.h, NSCAN / 8);
        }
        else mixer_prep_item(P, l, item - NSCAN);
    }
    if (PROBE & 8) for (int item = blockIdx.x; item < NPREP; item += gridDim.x) mixer_prep_item(P, l, item);
}

DEV half8 vt_frag(const half_t* Vs, int ldv, int kbase, int dv0, int lane) {
    const int grp = lane >> 4, hh = lane >> 5, i = lane & 15, q = i >> 2, pp = i & 3;
    const half_t* a = Vs + (kbase + 4 * hh + q) * ldv + dv0 + 16 * (grp & 1) + 4 * pp;
    const half4 lo = tr16(a), hi = tr16(a + 8 * ldv);
    half8 r; r[0] = lo[0]; r[1] = lo[1]; r[2] = lo[2]; r[3] = lo[3]; r[4] = hi[0]; r[5] = hi[1]; r[6] = hi[2]; r[7] = hi[3]; return r;
}
DEV void softmax_pv_step(const f32x16& s, float& m, float& lsum, f32x16 (&o)[2], const half_t* Vs, int ldv, int lane) {
    float mx = s[0];
#pragma unroll
    for (int r = 1; r < 16; ++r) mx = fmaxf(mx, s[r]);
    mx = fmaxf(mx, shfl_xor_f(mx, 32));
    const float mn = fmaxf(m, mx);
    const float alpha = fexp2(m - mn);
    m = mn;
    float ps = 0.f; half8 pf[2];
#pragma unroll
    for (int r = 0; r < 16; ++r) { const float pv = fexp2(s[r] - mn); ps += pv; pf[r >> 3][r & 7] = (half_t)pv; }
    lsum = lsum * alpha + ps;
#pragma unroll
    for (int dt = 0; dt < 2; ++dt)
#pragma unroll
        for (int r = 0; r < 16; ++r) o[dt][r] *= alpha;
#pragma unroll
    for (int s2 = 0; s2 < 2; ++s2)
#pragma unroll
        for (int dt = 0; dt < 2; ++dt) o[dt] = mfma32(vt_frag(Vs, ldv, 16 * s2, 32 * dt, lane), pf[s2], o[dt]);
}
DEV void softmax_pv_step2(const f32x16& s0, const f32x16& s1, float& m, float& lsum, f32x16 (&o)[2], const half_t* Vs, int ldv, int lane) {
    float mx = fmaxf(s0[0], s1[0]);
#pragma unroll
    for (int r = 1; r < 16; ++r) mx = fmaxf(mx, fmaxf(s0[r], s1[r]));
    mx = fmaxf(mx, shfl_xor_f(mx, 32));
    const float mn = fmaxf(m, mx);
    if (wave_any(mn != m)) {
        const float alpha = fexp2(m - mn);
        lsum *= alpha;
#pragma unroll
        for (int dt = 0; dt < 2; ++dt)
#pragma unroll
            for (int r = 0; r < 16; ++r) o[dt][r] *= alpha;
        m = mn;
    }
    float ps = 0.f; half8 pf[4];
#pragma unroll
    for (int r = 0; r < 16; ++r) { const float pa = fexp2(s0[r] - m), pb = fexp2(s1[r] - m); ps += pa + pb; pf[r >> 3][r & 7] = (half_t)pa; pf[2 + (r >> 3)][r & 7] = (half_t)pb; }
    lsum += ps;
#pragma unroll
    for (int kt2 = 0; kt2 < 2; ++kt2)
#pragma unroll
        for (int s2 = 0; s2 < 2; ++s2)
#pragma unroll
            for (int dt = 0; dt < 2; ++dt) o[dt] = mfma32(vt_frag(Vs + 32 * kt2 * ldv, ldv, 16 * s2, 32 * dt, lane), pf[2 * kt2 + s2], o[dt]);
}
DEV void attn_store(const f32x16 (&o)[2], float lsum, half_t* yrow, int lane) {
    const float inv = 1.0f / (lsum + shfl_xor_f(lsum, 32));
    const int hh = lane >> 5;
#pragma unroll
    for (int dt = 0; dt < 2; ++dt)
#pragma unroll
        for (int rq = 0; rq < 4; ++rq) {
            half4 v;
#pragma unroll
            for (int e = 0; e < 4; ++e) v[e] = (half_t)(o[dt][4 * rq + e] * inv);
            *(half4*)(yrow + 32 * dt + 8 * rq + 4 * hh) = v;
        }
}
DEV int attn_qtoken(int b, int qpos) { return qpos < SEQ ? b * SEQ + qpos : NLAT + b * CTX + (qpos - SEQ); }

constexpr int MK_LD = 104, MV_LD = 72;
DEV void mla_attn_item(CP& P, int b, int h, int qt, unsigned char* smem) {
    half_t* Ks = (half_t*)smem; half_t* Vs = Ks + 64 * MK_LD;
    const int tid = TID(), lane = tid & 63, w = tid >> 6, hh = lane >> 5, ql = lane & 31;
    const size_t bh = (size_t)(b * 4 + h) * KEYS;
    const int q0 = qt * 128 + 32 * w;
    const bool ctxq = q0 >= SEQ;
    const int kbeg = ctxq ? SEQ : 0, nkt = (ctxq ? CTX : KEYS) / 64;
    half8 qf[6];
#pragma unroll
    for (int ks = 0; ks < 6; ++ks) qf[ks] = *(const half8*)(P.mq + (bh + q0 + ql) * 96 + 16 * ks + 8 * hh);
    f32x16 o[2]; float m = -1e30f, lsum = 0.f;
#pragma unroll
    for (int dt = 0; dt < 2; ++dt)
#pragma unroll
        for (int r = 0; r < 16; ++r) o[dt][r] = 0.f;
    half8 pk[3], pv[2];
    const half_t* kg = P.mk + (bh + kbeg) * 96; const half_t* vg = P.mv + (bh + kbeg) * 64;
#pragma unroll
    for (int i = 0; i < 3; ++i) { const int c = tid + 256 * i; pk[i] = *(const half8*)(kg + (size_t)(c / 12) * 96 + (c % 12) * 8); }
#pragma unroll
    for (int i = 0; i < 2; ++i) { const int c = tid + 256 * i; pv[i] = *(const half8*)(vg + (size_t)(c >> 3) * 64 + (c & 7) * 8); }
    for (int kt = 0; kt < nkt; ++kt) {
        SYNC();
#pragma unroll
        for (int i = 0; i < 3; ++i) { const int c = tid + 256 * i; *(half8*)(Ks + (c / 12) * MK_LD + (c % 12) * 8) = pk[i]; }
#pragma unroll
        for (int i = 0; i < 2; ++i) { const int c = tid + 256 * i; *(half8*)(Vs + (c >> 3) * MV_LD + (c & 7) * 8) = pv[i]; }
        SYNC();
        if (kt + 1 < nkt) {
            const half_t* kg2 = kg + (size_t)(kt + 1) * 64 * 96; const half_t* vg2 = vg + (size_t)(kt + 1) * 64 * 64;
#pragma unroll
            for (int i = 0; i < 3; ++i) { const int c = tid + 256 * i; pk[i] = *(const half8*)(kg2 + (size_t)(c / 12) * 96 + (c % 12) * 8); }
#pragma unroll
            for (int i = 0; i < 2; ++i) { const int c = tid + 256 * i; pv[i] = *(const half8*)(vg2 + (size_t)(c >> 3) * 64 + (c & 7) * 8); }
        }
        SCHED_FENCE();
        f32x16 s0, s1;
#pragma unroll
        for (int r = 0; r < 16; ++r) { s0[r] = 0.f; s1[r] = 0.f; }
#pragma unroll
        for (int ks = 0; ks < 6; ++ks) {
            s0 = mfma32(*(const half8*)(Ks + ql * MK_LD + 16 * ks + 8 * hh), qf[ks], s0);
            s1 = mfma32(*(const half8*)(Ks + (32 + ql) * MK_LD + 16 * ks + 8 * hh), qf[ks], s1);
        }
        softmax_pv_step2(s0, s1, m, lsum, o, Vs, MV_LD, lane);
    }
    attn_store(o, lsum, P.y + (size_t)attn_qtoken(b, q0 + ql) * D + 0 + h * 64, lane);
}

constexpr int NV_LD = 72, NA_WAVE_LDS = 32 * NV_LD * 2 + 15 * 32 * 4;
DEV void na_attn_unit(CP& P, int l, int unit, unsigned char* wlds, int lane) {
    constexpr int NLATU = B_ * 4 * ROWS * 2;
    half_t* Vw = (half_t*)wlds; float* bt = (float*)(wlds + 32 * NV_LD * 2);
    const int hh = lane >> 5, ql = lane & 31;
    int b, h, q0, ntile, R0 = 0, r = 0, hf = 0; bool lat;
    if (unit < NLATU) { lat = true; hf = unit & 1; r = (unit >> 1) % ROWS; const int bh = unit / (2 * ROWS); h = bh & 3; b = bh >> 2; q0 = r * 64 + 32 * hf; ntile = 16 + CTX / 32;
        R0 = r - 4 < 0 ? 0 : (r - 4 > ROWS - 8 ? ROWS - 8 : r - 4); }
    else { lat = false; const int u = unit - NLATU; const int cb = u % (CTX / 32); const int bh = u / (CTX / 32); h = bh & 3; b = bh >> 2; q0 = SEQ + 32 * cb; ntile = CTX / 32; }
    const size_t bhk = (size_t)(b * 4 + h) * KEYS;
    WAVE_BARRIER();
    if (lat) {
        const float* rp = P.na_rpb + (size_t)(l * 4 + h) * 15 * 31;
        for (int i = lane; i < 15 * 32; i += 64) { const int dr = i >> 5, dc = i & 31; bt[i] = dc < 31 ? rp[dr * 31 + dc] * LOG2E : 0.f; }
    }
    half8 qf[4];
#pragma unroll
    for (int ks = 0; ks < 4; ++ks) qf[ks] = *(const half8*)(P.nq + (bhk + q0 + ql) * 64 + 16 * ks + 8 * hh);
    f32x16 o[2]; float m = -1e30f, lsum = 0.f;
#pragma unroll
    for (int dt = 0; dt < 2; ++dt)
#pragma unroll
        for (int rr = 0; rr < 16; ++rr) o[dt][rr] = 0.f;
    const int wq = 32 * hf + ql;
    const int cs = wq - 8 < 0 ? 0 : (wq - 8 > 48 ? 48 : wq - 8);
    auto tile_kpos = [&](int tile) { return (lat && tile < 16) ? (R0 + (tile >> 1)) * 64 + 32 * (tile & 1) : SEQ + 32 * (lat ? tile - 16 : tile); };
    half8 kf[4], vf[4];
    {
        const int kp = tile_kpos(0);
#pragma unroll
        for (int ks = 0; ks < 4; ++ks) kf[ks] = *(const half8*)(P.nk + (bhk + kp + ql) * 64 + 16 * ks + 8 * hh);
#pragma unroll
        for (int i = 0; i < 4; ++i) { const int c = lane + 64 * i; vf[i] = *(const half8*)(P.nv + (bhk + kp + (c >> 3)) * 64 + (c & 7) * 8); }
    }
    for (int tile = 0; tile < ntile; ++tile) {
        const bool win = lat && tile < 16;
        const int krow = R0 + (tile >> 1), kh2 = tile & 1;
        f32x16 s;
#pragma unroll
        for (int rr = 0; rr < 16; ++rr) s[rr] = 0.f;
#pragma unroll
        for (int ks = 0; ks < 4; ++ks) s = mfma32(kf[ks], qf[ks], s);
        WAVE_BARRIER();
#pragma unroll
        for (int i = 0; i < 4; ++i) { const int c = lane + 64 * i; *(half8*)(Vw + (c >> 3) * NV_LD + (c & 7) * 8) = vf[i]; }
        if (tile + 1 < ntile) {
            const int kp = tile_kpos(tile + 1);
#pragma unroll
            for (int ks = 0; ks < 4; ++ks) kf[ks] = *(const half8*)(P.nk + (bhk + kp + ql) * 64 + 16 * ks + 8 * hh);
#pragma unroll
            for (int i = 0; i < 4; ++i) { const int c = lane + 64 * i; vf[i] = *(const half8*)(P.nv + (bhk + kp + (c >> 3)) * 64 + (c & 7) * 8); }
        }
        SCHED_FENCE();
        if (win) {
            const float* brow = bt + (krow - r + 7) * 32;
            float bv[16];
#pragma unroll
            for (int rr = 0; rr < 16; ++rr) {
                const int wk = 32 * kh2 + (rr & 3) + 8 * (rr >> 2) + 4 * hh;
                int dc = wk - wq + 15; dc = dc < 0 ? 0 : (dc > 30 ? 30 : dc);
                bv[rr] = brow[dc];
            }
#pragma unroll
            for (int rr = 0; rr < 16; ++rr) {
                const int wk = 32 * kh2 + (rr & 3) + 8 * (rr >> 2) + 4 * hh;
                const bool valid = wk >= cs && wk < cs + 16;
                s[rr] = valid ? s[rr] + bv[rr] : -INFINITY;
            }
        }
        WAVE_BARRIER();
        softmax_pv_step(s, m, lsum, o, Vw, NV_LD, lane);
    }
    attn_store(o, lsum, P.y + (size_t)attn_qtoken(b, q0 + ql) * D + 256 + h * 64, lane);
}

DEV void mixers_item(CP& P, int l, int item, unsigned char* smem) {
    const bool last = l == NL - 1;
    const int QT = (last ? SEQ : KEYS) / 128;
    const int NMLA = B_ * 4 * QT;
    const int NNA = (B_ * 4 * ROWS * 2 + (last ? 0 : B_ * 4 * (CTX / 32))) / 4;
    const int NGRP = last ? LG : NCH;
    const int lane = TID() & 63, w = TID() >> 6;
    if (item < NMLA) {
        const int qt = item % QT, bh = item / QT;
        mla_attn_item(P, bh >> 2, bh & 3, qt, smem);
    } else if (item < NMLA + NNA) {
        SYNC();
        na_attn_unit(P, l, (item - NMLA) * 4 + w, smem + w * NA_WAVE_LDS, lane);
    } else {
        int it = item - NMLA - NNA;
        const int gi = it % NGRP; it /= NGRP; const int h = it & 3; it >>= 2; const int b = it % B_; const int mix = it / B_;
        const int gidx = last ? gi + CG : gi;
        SYNC();
        if (mix == 0) gla_step_c<0>(P, l, b, h, gidx, smem); else gla_step_c<1>(P, l, b, h, gidx, smem);
    }
}
DEV int sched_next(int* ctr, unsigned char* smem) {
    int* slot = (int*)(smem + SMEM_BYTES - 16);
    SYNC();
    if (TID() == 0) *slot = atomic_add_i(ctr, 1);
    SYNC();
    return *slot;
}
DEV void phase_mixers(CP& P, int l, unsigned char* smem, int rep) {
    const bool last = l == NL - 1;
    const int QT = (last ? SEQ : KEYS) / 128;
    const int NMLA = B_ * 4 * QT;
    const int NNA = (B_ * 4 * ROWS * 2 + (last ? 0 : B_ * 4 * (CTX / 32))) / 4;
    const int NGC = 2 * B_ * 4 * (last ? LG : NCH);
    const int NU = NMLA + NNA + NGC / 4;
    int* ctr = P.sched + l * 16 + rep;
    for (int u = sched_next(ctr, smem); u < NU; u = sched_next(ctr, smem)) {
        if (u < NMLA + NNA) mixers_item(P, l, u, smem);
        else { const int g0 = NMLA + NNA + (u - NMLA - NNA) * 4; for (int j = 0; j < 4; ++j) mixers_item(P, l, g0 + j, smem); }
    }
    if (PROBE & 16) for (int item = blockIdx.x; item < NMLA; item += gridDim.x) mixers_item(P, l, item, smem);
    if (PROBE & 32) for (int item = blockIdx.x; item < NNA; item += gridDim.x) mixers_item(P, l, NMLA + item, smem);
    if (PROBE & 64) for (int item = blockIdx.x; item < NGC; item += gridDim.x) mixers_item(P, l, NMLA + NNA + item, smem);
}

DEV void phase_outproj(CP& P, int l, unsigned char* smem, int rep0) {
    const bool last = l == NL - 1;
    const int NTM = (last ? NLAT : NT) / 256;
    const int rounds = (NTM * 8 + gridDim.x - 1) / gridDim.x;
    for (int rep = rep0; rep < ((PROBE & 512) ? 2 : rep0 + 1); ++rep)
    for (int round = 0; round < rounds; ++round) {
        int tm, tn;
        if (!gemm_tile_order(round, NTM, 8, tm, tn)) continue;
        const int t0 = tm * 256;
        ARowLin ar{P.y + (size_t)t0 * D, D};
        BSrcH bs{P.wout16 + (size_t)l * D * D + tn * 128, D};
        EpiResid epi{(rep ? P.gst + (size_t)t0 * D : xrow_ptr(P, t0)) + tn * 128, P.mod + ((size_t)l * (B_ + 1) + tok_brow(t0)) * MODW + 2 * D + tn * 128};
        gemm256(ar, bs, D, epi, smem);
    }
}

template <bool DRY> DEV void phase_router_t(CP& P, int l, unsigned char* smem) {
    const bool last = l == NL - 1;
    const int NI = (last ? NLAT : NT) / 64;
    const int tid = TID(), lane = tid & 63, w = tid >> 6, g = lane >> 4, li = lane & 15;
    float* wrs = (float*)smem;
    float* lg = (float*)(smem + 64 * 52 * 4) + w * 16 * 48;
    const float* wr = P.wr + (size_t)l * D * 48;
    int wrow[3], wc4[3];
#pragma unroll
    for (int i = 0; i < 3; ++i) { const int idx = tid + 256 * i; wrow[i] = idx / 12; wc4[i] = (idx % 12) * 4; }
    for (int item = blockIdx.x; item < NI; item += gridDim.x) {
        const int tok0 = item * 64 + 16 * w, br = tok_brow(item * 64);
        const float* xr = xrow_ptr(P, tok0 + li);
        const float* md = P.mod + ((size_t)l * (B_ + 1) + br) * MODW;
        const float* sh = md + 3 * D; const float* sc = md + 4 * D;
        f32x4 acc[3];
#pragma unroll
        for (int nt = 0; nt < 3; ++nt) acc[nt] = (f32x4){0.f, 0.f, 0.f, 0.f};
        float ssq = 0.f;
        f32x4 wv[3], xv[4], sv[4];
#pragma unroll
        for (int i = 0; i < 3; ++i) wv[i] = *(const f32x4*)(wr + (size_t)wrow[i] * 48 + wc4[i]);
#pragma unroll
        for (int j = 0; j < 4; ++j) { xv[j] = *(const f32x4*)(xr + 16 * j + 4 * g); sv[j] = *(const f32x4*)(sc + 16 * j + 4 * g); }
        for (int ch = 0; ch < 16; ++ch) {
            SYNC();
#pragma unroll
            for (int i = 0; i < 3; ++i) *(f32x4*)(wrs + wrow[i] * 52 + wc4[i]) = wv[i];
            SYNC();
            f32x4 xc[4], sk[4];
#pragma unroll
            for (int j = 0; j < 4; ++j) { xc[j] = xv[j]; sk[j] = sv[j]; }
            if (ch + 1 < 16) {
#pragma unroll
                for (int i = 0; i < 3; ++i) wv[i] = *(const f32x4*)(wr + (size_t)(64 * (ch + 1) + wrow[i]) * 48 + wc4[i]);
#pragma unroll
                for (int j = 0; j < 4; ++j) { xv[j] = *(const f32x4*)(xr + 64 * (ch + 1) + 16 * j + 4 * g); sv[j] = *(const f32x4*)(sc + 64 * (ch + 1) + 16 * j + 4 * g); }
            }
            SCHED_FENCE();
#pragma unroll
            for (int j = 0; j < 4; ++j) {
                ssq += xc[j][0] * xc[j][0] + xc[j][1] * xc[j][1] + xc[j][2] * xc[j][2] + xc[j][3] * xc[j][3];
#pragma unroll
                for (int c = 0; c < 4; ++c) {
                    const float a = xc[j][c] * (1.0f + sk[j][c]);
                    const float* wrow_l = wrs + (16 * j + 4 * g + c) * 52 + li;
#pragma unroll
                    for (int nt = 0; nt < 3; ++nt) acc[nt] = mfmaf(a, wrow_l[16 * nt], acc[nt]);
                }
            }
        }
        ssq += shfl_xor_f(ssq, 16); ssq += shfl_xor_f(ssq, 32);
        const float rstd = frsqrt(ssq * (1.0f / D) + EPS);
        const float* csh = P.cshift + ((size_t)l * (B_ + 1) + br) * 48;
        WAVE_BARRIER();
#pragma unroll
        for (int r = 0; r < 4; ++r) {
            const float rs = shfl_f(rstd, 4 * g + r);
#pragma unroll
            for (int nt = 0; nt < 3; ++nt) lg[(4 * g + r) * 48 + 16 * nt + li] = acc[nt][r] * rs + csh[16 * nt + li];
        }
        WAVE_BARRIER();
        if (lane < 16) {
            const float* lt = lg + lane * 48;
            int gi = 0; float gm = lt[0];
            for (int j = 1; j < 4; ++j) if (lt[j] > gm) { gm = lt[j]; gi = j; }
            float gden = 0.f; for (int j = 0; j < 4; ++j) gden += fexp(lt[j] - gm);
            const float pg = 1.0f / gden;
            const float* ft = lt + 4 + gi * 8;
            int e0 = 0; float f0 = ft[0];
            for (int j = 1; j < 8; ++j) if (ft[j] > f0) { f0 = ft[j]; e0 = j; }
            int e1 = -1; float f1 = -3.0e38f;
            for (int j = 0; j < 8; ++j) if (j != e0 && ft[j] > f1) { f1 = ft[j]; e1 = j; }
            const float p1 = fexp(f1 - f0);
            const float g0 = pg / (1.0f + p1), g1 = pg * p1 / (1.0f + p1);
            const int t = tok0 + lane, x0 = gi * 8 + e0, x1 = gi * 8 + e1;
            if (DRY) { float* dd = (float*)P.act + (size_t)t * 4; dd[0] = g0; dd[1] = g1; dd[2] = (float)x0; dd[3] = (float)x1; }
            else {
            const int s0 = atomic_add_i(P.cnt + l * NEXP + x0, 1), s1 = atomic_add_i(P.cnt + l * NEXP + x1, 1);
            P.list_tok[(size_t)x0 * NT + s0] = t; P.list_gate[(size_t)x0 * NT + s0] = g0;
            P.list_tok[(size_t)x1 * NT + s1] = t; P.list_gate[(size_t)x1 * NT + s1] = g1;
            P.tokslot[2 * t] = (x0 << 20) | s0; P.tokslot[2 * t + 1] = (x1 << 20) | s1;
            }
        }
        WAVE_BARRIER();
        half_t* hr = (DRY ? P.y : P.h) + (size_t)(tok0 + li) * D;
        for (int k8 = 0; k8 < 64; k8 += 8) {
            f32x4 xq[8], sq[8], hq[8];
#pragma unroll
            for (int j = 0; j < 8; ++j) { const int col = 16 * (k8 + j) + 4 * g; xq[j] = *(const f32x4*)(xr + col); sq[j] = *(const f32x4*)(sc + col); hq[j] = *(const f32x4*)(sh + col); }
            SCHED_FENCE();
#pragma unroll
            for (int j = 0; j < 8; ++j) {
                f32x4 o;
#pragma unroll
                for (int c = 0; c < 4; ++c) o[c] = xq[j][c] * rstd * (1.0f + sq[j][c]) + hq[j][c];
                *(half4*)(hr + 16 * (k8 + j) + 4 * g) = to_half4(o);
            }
        }
    }
}

DEV void phase_router(CP& P, int l, unsigned char* smem, int rep) {
    if (rep) { phase_router_t<true>(P, l, smem); return; }
    phase_router_t<false>(P, l, smem);
    if (PROBE & 1024) phase_router_t<true>(P, l, smem);
}
DEV void moe_tables(CP& P, int l, int* ab, int* tb) {
    if (TID() == 0) {
        int a = 0, t = 0;
        for (int e = 0; e < NEXP; ++e) { const int c = P.cnt[l * NEXP + e], nt = (c + 255) >> 8; ab[e] = a; tb[e] = t; a += nt * 256; t += nt; }
        ab[NEXP] = a; tb[NEXP] = t;
    }
    SYNC();
}
DEV int moe_find(const int* tb, int tile) { int e = 0; while (e < NEXP - 1 && tile >= tb[e + 1]) ++e; return e; }
DEV bool moe_item(const int* tb, int idx, int& e, int& mt, int& tn) {
    const int x = blockIdx.x & 7;
#pragma unroll
    for (int eg = 0; eg < 4; ++eg) {
        e = x + 8 * eg; const int n = (tb[e + 1] - tb[e]) * 8;
        if (idx < n) { mt = idx >> 3; tn = idx & 7; return true; }
        idx -= n;
    }
    return false;
}

DEV void phase_moe1(CP& P, int l, unsigned char* smem) {
    int* ab = (int*)(smem + SMEM_BYTES - 512); int* tb = ab + 40;
    moe_tables(P, l, ab, tb);
    for (int rep = 0; rep < ((PROBE & 128) ? 2 : 1); ++rep)
    for (int idx = blockIdx.x >> 3;; idx += gridDim.x >> 3) {
        int e, mt, tn; if (!moe_item(tb, idx, e, mt, tn)) break;
        const int cnt = P.cnt[l * NEXP + e], nvalid = cnt - mt * 256 < 256 ? cnt - mt * 256 : 256;
        ARowGather ar{P.h, D, P.list_tok + (size_t)e * NT + mt * 256, nvalid};
        const size_t wo = ((size_t)l * NEXP + e) * D * 512 + tn * 64;
        BSrcF2 bs{P.moe_w1 + wo, (ptrdiff_t)(P.moe_w3 - P.moe_w1), 512};
        EpiGlu epi{P.act + (size_t)(ab[e] + mt * 256) * 512 + tn * 64, 512};
        gemm256(ar, bs, D, epi, smem);
    }
}
DEV void phase_moe2(CP& P, int l, unsigned char* smem) {
    int* ab = (int*)(smem + SMEM_BYTES - 512); int* tb = ab + 40;
    moe_tables(P, l, ab, tb);
    for (int rep = 0; rep < ((PROBE & 256) ? 2 : 1); ++rep)
    for (int idx = blockIdx.x >> 3;; idx += gridDim.x >> 3) {
        int e, mt, tn; if (!moe_item(tb, idx, e, mt, tn)) break;
        const int cnt = P.cnt[l * NEXP + e], nvalid = cnt - mt * 256 < 256 ? cnt - mt * 256 : 256;
        const size_t r0 = (size_t)ab[e] + mt * 256;
        ARowLin ar{P.act + r0 * 512, 512};
        BSrcF bs{P.moe_w2 + ((size_t)l * NEXP + e) * 512 * D + tn * 128, D};
        EpiRowsGate epi{P.yrows + r0 * D + tn * 128, P.list_gate + (size_t)e * NT + mt * 256, nvalid};
        gemm256(ar, bs, 512, epi, smem);
    }
}
template <bool DRY> DEV void phase_combine_t(CP& P, int l, unsigned char* smem) {
    int* ab = (int*)(smem + SMEM_BYTES - 512); int* tb = ab + 40;
    moe_tables(P, l, ab, tb);
    const bool last = l == NL - 1;
    const int NTK = last ? NLAT : NT;
    const int lane = TID() & 63, gw = blockIdx.x * 4 + (TID() >> 6), nw = gridDim.x * 4;
    for (int t = gw; t < NTK; t += nw) {
        const int ts0 = P.tokslot[2 * t], ts1 = P.tokslot[2 * t + 1];
        const half_t* y0 = P.yrows + (size_t)(ab[ts0 >> 20] + (ts0 & 0xFFFFF)) * D;
        const half_t* y1 = P.yrows + (size_t)(ab[ts1 >> 20] + (ts1 & 0xFFFFF)) * D;
        float* xr = xrow_ptr(P, t);
        float* xw = DRY ? P.gst + (size_t)t * D : xr;
        const float* md = P.mod + ((size_t)l * (B_ + 1) + tok_brow(t)) * MODW;
        f32x4 v[4], xv[4], gt[4]; half4 ya[4], yb[4];
#pragma unroll
        for (int j = 0; j < 4; ++j) {
            const int col = 256 * j + 4 * lane;
            xv[j] = *(const f32x4*)(xr + col); gt[j] = *(const f32x4*)(md + 5 * D + col); ya[j] = *(const half4*)(y0 + col); yb[j] = *(const half4*)(y1 + col);
        }
        SCHED_FENCE();
#pragma unroll
        for (int j = 0; j < 4; ++j) {
            const int col = 256 * j + 4 * lane;
#pragma unroll
            for (int e = 0; e < 4; ++e) v[j][e] = xv[j][e] + gt[j][e] * ((float)ya[j][e] + (float)yb[j][e]);
            *(f32x4*)(xw + col) = v[j];
        }
        if (!last) { const float* mn = md + (size_t)(B_ + 1) * MODW; row_modulate_store(v, mn + 0, mn + D, (DRY ? P.y : P.h) + (size_t)t * D, lane); }
    }
}

DEV void phase_combine(CP& P, int l, unsigned char* smem, int rep) {
    if (rep) { phase_combine_t<true>(P, l, smem); return; }
    if (PROBE & 2048) phase_combine_t<true>(P, l, smem);
    phase_combine_t<false>(P, l, smem);
}
template <int PH> DEV void run_phase(CP& P, int l, unsigned char* smem, int rep = 0) {
    if (PH == 0) { phase_prologue_a(P, smem); if (PROBE & 4096) { SYNC(); phase_prologue_a(P, smem); } }
    if (PH == 1) { phase_prologue_b(P); if (PROBE & 4096) phase_prologue_b(P); }
    if (PH == 2) phase_inproj(P, l, smem);
    if (PH == 3) phase_up_glaa(P, l, smem);
    if (PH == 4) phase_prep_scan(P, l, rep);
    if (PH == 5) phase_mixers(P, l, smem, rep);
    if (PH == 6) phase_outproj(P, l, smem, rep);
    if (PH == 7) phase_router(P, l, smem, rep);
    if (PH == 8) phase_moe1(P, l, smem);
    if (PH == 9) phase_moe2(P, l, smem);
    if (PH == 10) phase_combine(P, l, smem, rep);
}

#ifndef CPU_EMU
#define XB_TMO      128
#define XB_XCNT(j)  (256  + 64 * (j))
#define XB_XSUB(j)  (1280 + 64 * (j))
#define XB_XGEN(j)  (2304 + 64 * (j))
#define XB_TOP      3328
#define XB_TOPGEN   3392
#define XCD_BAR_WORDS 3456
#define XB_SPIN_CAP (1u << 24)
__device__ __forceinline__ unsigned xb_ld(unsigned* p)              { return __hip_atomic_load(p, __ATOMIC_RELAXED, __HIP_MEMORY_SCOPE_AGENT); }
__device__ __forceinline__ unsigned xb_add(unsigned* p, unsigned v) { return __hip_atomic_fetch_add(p, v, __ATOMIC_RELAXED, __HIP_MEMORY_SCOPE_AGENT); }
__device__ __forceinline__ unsigned xb_xcc_id() { return (unsigned)__builtin_amdgcn_s_getreg((3 << 11) | 20) & 0xFu; }
#define XB_SPIN(cond, bar) do { unsigned _sp = 0; while (cond) { __builtin_amdgcn_s_sleep(1); \
    if ((++_sp & 255u) == 0u) { if (xb_ld(&(bar)[XB_TMO])) break; if (_sp > XB_SPIN_CAP) { atomicAdd(&(bar)[XB_TMO], 1u); break; } } } } while (0)
struct XcdBarrier { unsigned* bar; unsigned x; volatile LDSP unsigned* st; };
__device__ __forceinline__ XcdBarrier xcd_barrier_post(unsigned* bar, volatile LDSP unsigned* st) {
    XcdBarrier b; b.bar = bar; b.x = xb_xcc_id(); b.st = st;
    if (threadIdx.x == 0) (void)xb_add(&bar[XB_XCNT(b.x)], 1u);
    return b;
}
__device__ __forceinline__ void xcd_barrier_complete(unsigned* bar, unsigned x, unsigned& nloc, unsigned& nx) {
    const unsigned G = gridDim.x * gridDim.y * gridDim.z;
    unsigned sum, cnt, mine, sp = 0u;
    for (;;) {
        sum = 0u; cnt = 0u; mine = 0u;
#pragma unroll
        for (unsigned j = 0; j < 16; ++j) { const unsigned c = xb_ld(&bar[XB_XCNT(j)]); sum += c; cnt += (c > 0u) ? 1u : 0u; mine = (j == x) ? c : mine; }
        if (sum == G) break;
        __builtin_amdgcn_s_sleep(1);
        if ((++sp & 255u) == 0u) { if (xb_ld(&bar[XB_TMO])) break; if (sp > XB_SPIN_CAP) { atomicAdd(&bar[XB_TMO], 1u); break; } }
    }
    nloc = mine > 0u ? mine : 1u; nx = cnt > 0u ? cnt : 1u;
}
__device__ __forceinline__ void xcd_barrier1(const XcdBarrier& b) {
    asm volatile("s_waitcnt vmcnt(0)" ::: "memory");
    __syncthreads();
    if (threadIdx.x == 0) {
        unsigned* bar = b.bar;
        __builtin_amdgcn_s_waitcnt(0);
        unsigned nloc = b.st[0], nx = b.st[1];
        if (nloc == 0u) { xcd_barrier_complete(bar, b.x, nloc, nx); b.st[0] = nloc; b.st[1] = nx; }
        const unsigned old = xb_add(&bar[XB_XSUB(b.x)], 1u);
        const unsigned gen = old / nloc;
        if (old + 1u == (gen + 1u) * nloc) {
            __builtin_amdgcn_fence(__ATOMIC_RELEASE, "agent");
            asm volatile("s_waitcnt vmcnt(0)" ::: "memory");
            const unsigned og = xb_add(&bar[XB_TOP], 1u);
            const unsigned tg = og / nx;
            if (og + 1u == (tg + 1u) * nx) xb_add(&bar[XB_TOPGEN], 1u);
            else XB_SPIN(xb_ld(&bar[XB_TOPGEN]) == tg, bar);
            __builtin_amdgcn_fence(__ATOMIC_ACQUIRE, "agent");
            xb_add(&bar[XB_XGEN(b.x)], 1u);
            asm volatile("s_waitcnt vmcnt(0)" ::: "memory");
        } else {
            XB_SPIN(xb_ld(&bar[XB_XGEN(b.x)]) == gen, bar);
            __builtin_amdgcn_fence(__ATOMIC_ACQUIRE, "agent");
            asm volatile("s_waitcnt vmcnt(0)" ::: "memory");
        }
    }
    __syncthreads();
}

#ifndef MK_MULTI
#define MK_MULTI 0
#endif
__device__ __forceinline__ void xcd_barrier(const XcdBarrier& b) { xcd_barrier1(b); if (PROBE & 8192) xcd_barrier1(b); }
#if MK_MULTI
template <int PH> __global__ void __launch_bounds__(NTHREADS, 2) k_phase(Params Pv, int l) {
    extern __shared__ __attribute__((aligned(16))) unsigned char smem[];
    CP& P = *(CP*)__builtin_amdgcn_kernarg_segment_ptr();
    run_phase<PH>(P, l, smem);
}
#else
template <int PH> static __device__ __forceinline__ void phase_ni(int l, int rep = 0) {
    extern __shared__ __attribute__((aligned(16))) unsigned char smem[];
    CP& P = *(CP*)__builtin_amdgcn_kernarg_segment_ptr();
    run_phase<PH>(P, l, smem, rep);
}
__global__ void __launch_bounds__(NTHREADS, 2) k_mega(Params Pv) {
    extern __shared__ __attribute__((aligned(16))) unsigned char smem[];
    CP& P = *(CP*)__builtin_amdgcn_kernarg_segment_ptr();
    volatile LDSP unsigned* xbw = (volatile LDSP unsigned*)(smem + SMEM_BYTES);
    if (threadIdx.x == 0) { xbw[0] = 0u; xbw[1] = 0u; xbw[2] = 0u; xbw[3] = 0u; }
    __syncthreads();
    XcdBarrier bar = xcd_barrier_post(P.bar, xbw);
    phase_ni<0>(0); xcd_barrier(bar);
    phase_ni<1>(0); xcd_barrier(bar);
#pragma clang loop unroll(disable)
    for (int l = 0; l < NL; ++l) {
        phase_ni<2>(l); xcd_barrier(bar); if (WPROBE == 2) { phase_ni<2>(l, 1); xcd_barrier(bar); }
        phase_ni<3>(l); xcd_barrier(bar); if (WPROBE == 3) { phase_ni<3>(l, 1); xcd_barrier(bar); }
        phase_ni<4>(l); xcd_barrier(bar); if (WPROBE == 4) { phase_ni<4>(l, 1); xcd_barrier(bar); }
        phase_ni<5>(l); xcd_barrier(bar); if (WPROBE == 5) { phase_ni<5>(l, 1); xcd_barrier(bar); }
        phase_ni<6>(l); xcd_barrier(bar); if (WPROBE == 6) { phase_ni<6>(l, 1); xcd_barrier(bar); }
        phase_ni<7>(l); xcd_barrier(bar); if (WPROBE == 7) { phase_ni<7>(l, 1); xcd_barrier(bar); }
        phase_ni<8>(l); xcd_barrier(bar); if (WPROBE == 8) { phase_ni<8>(l, 1); xcd_barrier(bar); }
        phase_ni<9>(l); xcd_barrier(bar); if (WPROBE == 9) { phase_ni<9>(l, 1); xcd_barrier(bar); }
        phase_ni<10>(l); if (WPROBE == 10) { xcd_barrier(bar); phase_ni<10>(l, 1); } if (l + 1 < NL) xcd_barrier(bar);
    }
}
#endif
#endif

struct Carver { unsigned char* base; size_t off; template <class T> T* take(size_t n) { off = (off + 255) & ~(size_t)255; T* p = (T*)(base + off); off += n * sizeof(T); return p; } };
static inline size_t carve_ws(Params& P, void* d_ws) {
    Carver c{(unsigned char*)d_ws, 0};
    P.bar = c.take<unsigned>(4096);
    P.xc = c.take<float>((size_t)NCTX * D);
    P.mod = c.take<float>((size_t)NL * (B_ + 1) * MODW);
    P.hglb = c.take<float>(NL * 256);
    P.rope = c.take<float>((size_t)SEQ * 32);
    P.wr = c.take<float>((size_t)NL * D * 48);
    P.cshift = c.take<float>(NL * (B_ + 1) * 48);
    P.cnt = c.take<int>(NL * NEXP);
    P.sched = c.take<int>(NL * 16);
    P.list_tok = c.take<int>((size_t)NEXP * NT);
    P.list_gate = c.take<float>((size_t)NEXP * NT);
    P.tokslot = c.take<int>((size_t)NT * 2);
    P.gst = c.take<float>((size_t)2 * B_ * 4 * 2 * NCH * 4096);
    P.gdec = c.take<float>((size_t)2 * B_ * 4 * 2 * NCH * 64);
    P.win16 = c.take<half_t>((size_t)NL * D * PPAD);
    P.wout16 = c.take<half_t>((size_t)NL * D * D);
    P.wuq16 = c.take<half_t>((size_t)NL * 192 * 384);
    P.wukv16 = c.take<half_t>((size_t)NL * 128 * 512);
    P.h = c.take<half_t>((size_t)NT * D);
    P.p = c.take<half_t>((size_t)NT * PPAD);
    P.yrows = P.p;
    P.y = c.take<half_t>((size_t)NT * D);
    P.qraw = c.take<half_t>((size_t)NT * 384);
    P.kvraw = c.take<half_t>((size_t)NT * 512);
    P.mq = c.take<half_t>((size_t)B_ * 4 * KEYS * 96);
    P.mk = c.take<half_t>((size_t)B_ * 4 * KEYS * 96);
    P.mv = c.take<half_t>((size_t)B_ * 4 * KEYS * 64);
    P.nq = c.take<half_t>((size_t)B_ * 4 * KEYS * 64);
    P.nk = c.take<half_t>((size_t)B_ * 4 * KEYS * 64);
    P.nv = c.take<half_t>((size_t)B_ * 4 * KEYS * 64);
    P.act = c.take<half_t>((size_t)ACT_ROWS * 512);
    return c.off;
}
static inline void fill_inputs(Params& P, void* const* d_in, void* d_out) {
    const float* const* in = (const float* const*)d_in;
    P.x = in[0]; P.c = in[1]; P.ctx = in[2]; P.c_ctx = in[3]; P.w_ada = in[4]; P.b_ada = in[5]; P.w_in = in[6]; P.w_out = in[7];
    P.mla_g_cq = in[8]; P.mla_g_ckv = in[9]; P.mla_w_uq = in[10]; P.mla_w_ukv = in[11]; P.mla_g_qn = in[12]; P.mla_g_qr = in[13];
    P.mla_g_kn = in[14]; P.mla_g_kr = in[15]; P.na_g_q = in[16]; P.na_g_k = in[17]; P.na_rpb = in[18]; P.ret_g_out = in[19];
    P.hg_lb_raw = in[20]; P.hg_g_out = in[21]; P.moe_w_rg = in[22]; P.moe_b_rg = in[23]; P.moe_w_re = in[24]; P.moe_b_re = in[25];
    P.moe_w1 = in[26]; P.moe_w3 = in[27]; P.moe_w2 = in[28];
    P.out = (float*)d_out;
}

#ifndef CPU_EMU
extern "C" void kernel_launch(void* const* d_in, const int* in_sizes, int n_in, void* d_out, int out_size, void* d_ws, size_t ws_size, hipStream_t stream) {
    Params P{};
    fill_inputs(P, d_in, d_out);
    carve_ws(P, d_ws);
    constexpr size_t kDynLds = SMEM_BYTES + 16;
    static int grid = 0;
    if (!grid) {
        int dev = 0, cus = 0, per_cu = 0;
        (void)hipGetDevice(&dev);
        (void)hipDeviceGetAttribute(&cus, hipDeviceAttributeMultiprocessorCount, dev);
        #if MK_MULTI
        (void)hipOccupancyMaxActiveBlocksPerMultiprocessor(&per_cu, k_phase<5>, NTHREADS, kDynLds);
#else
        (void)hipFuncSetAttribute((const void*)k_mega, hipFuncAttributeMaxDynamicSharedMemorySize, (int)kDynLds);
        (void)hipOccupancyMaxActiveBlocksPerMultiprocessor(&per_cu, k_mega, NTHREADS, kDynLds);
#endif
        if (per_cu < 1) per_cu = 1;
        grid = cus * (per_cu < 2 ? per_cu : 2);
    }
#if MK_MULTI
    k_phase<0><<<grid, NTHREADS, kDynLds, stream>>>(P, 0);
    k_phase<1><<<grid, NTHREADS, kDynLds, stream>>>(P, 0);
    for (int l = 0; l < NL; ++l) {
        k_phase<2><<<grid, NTHREADS, kDynLds, stream>>>(P, l);
        k_phase<3><<<grid, NTHREADS, kDynLds, stream>>>(P, l);
        k_phase<4><<<grid, NTHREADS, kDynLds, stream>>>(P, l);
        k_phase<5><<<grid, NTHREADS, kDynLds, stream>>>(P, l);
        k_phase<6><<<grid, NTHREADS, kDynLds, stream>>>(P, l);
        k_phase<7><<<grid, NTHREADS, kDynLds, stream>>>(P, l);
        k_phase<8><<<grid, NTHREADS, kDynLds, stream>>>(P, l);
        k_phase<9><<<grid, NTHREADS, kDynLds, stream>>>(P, l);
        k_phase<10><<<grid, NTHREADS, kDynLds, stream>>>(P, l);
    }
#else
    (void)hipMemsetAsync(P.bar, 0, XCD_BAR_WORDS * sizeof(unsigned), stream);
    k_mega<<<grid, NTHREADS, kDynLds, stream>>>(P);
#endif
}
#endif
```

```cpp
#ifndef CPU_EMU
#include <hip/hip_runtime.h>
#endif
#include <stdint.h>
#include <stddef.h>

#ifndef PROBE
#define PROBE 0
#endif
#ifndef WPROBE
#define WPROBE 0
#endif
#ifndef CFG_B
#define CFG_B 8
#define CFG_SEQ 4096
#define CFG_L 4
#define CFG_CTX 256
#endif

typedef _Float16 half_t;
typedef _Float16 half8 __attribute__((ext_vector_type(8)));
typedef _Float16 half4 __attribute__((ext_vector_type(4)));
typedef short s16x4 __attribute__((ext_vector_type(4)));
typedef float f32x4 __attribute__((ext_vector_type(4)));
typedef float f32x16 __attribute__((ext_vector_type(16)));

#ifdef CPU_EMU
#define DEV inline
#define SYNC() emu::block_sync()
#define WAVE_BARRIER() emu::wave_sync()
#define SCHED_FENCE() do {} while (0)
#define WAIT_VM(n) do {} while (0)
#define RAW_BARRIER() emu::block_sync()
inline void glds16(const void* g, void* lds_wave_base) { memcpy((unsigned char*)lds_wave_base + (threadIdx.x & 63) * 16, g, 16); }
inline int WID(int tid) { return tid >> 6; }
DEV f32x4 mfma16(half8 a, half8 b, f32x4 c) { return emu::mfma_16x16x32<half8, f32x4>(a, b, c); }
DEV f32x16 mfma32(half8 a, half8 b, f32x16 c) { return emu::mfma_32x32x16<half8, f32x16>(a, b, c); }
DEV f32x4 mfmaf(float a, float b, f32x4 c) { return emu::mfma_16x16x4_f32<f32x4>(a, b, c); }
DEV half4 tr16(const half_t* p) { return emu::ds_read_tr16<half4>((const void*)p); }
template <int OFF> DEV half4 tr16_nowait(const half_t* p) { return emu::ds_read_tr16<half4>((const void*)((const unsigned char*)p + OFF)); }
#define TR_WAIT() do {} while (0)
DEV float shfl_xor_f(float v, int m) { return emu::shfl_xor<float>(v, m); }
DEV float shfl_f(float v, int src) { return emu::shfl<float>(v, src); }
DEV int atomic_add_i(int* p, int v) { return __atomic_fetch_add(p, v, __ATOMIC_RELAXED); }
DEV bool wave_any(bool p) { float f = p ? 1.f : 0.f; for (int m = 1; m < 64; m <<= 1) f = fmaxf(f, emu::shfl_xor<float>(f, m)); return f > 0.f; }
DEV float fexp2(float x) { return exp2f(x); }
DEV float fexp(float x) { return expf(x); }
DEV float flog(float x) { return logf(x); }
DEV float frsqrt(float x) { return 1.0f / sqrtf(x); }
DEV float frcp(float x) { return 1.0f / x; }
#else
#define DEV __device__ __forceinline__
#define SYNC() __syncthreads()
#define WAVE_BARRIER() __builtin_amdgcn_wave_barrier()
#define SCHED_FENCE() __builtin_amdgcn_sched_barrier(0)
#define WAIT_VM(n) asm volatile("s_waitcnt vmcnt(" #n ")" ::: "memory")
#define RAW_BARRIER() __builtin_amdgcn_s_barrier()
__device__ __forceinline__ void glds16(const void* g, void* lds_wave_base) {
    __builtin_amdgcn_global_load_lds((const __attribute__((address_space(1))) void*)g, (__attribute__((address_space(3))) void*)lds_wave_base, 16, 0, 0);
}
__device__ __forceinline__ int WID(int tid) { return __builtin_amdgcn_readfirstlane(tid >> 6); }
#define LDSP __attribute__((address_space(3)))
DEV f32x4 mfma16(half8 a, half8 b, f32x4 c) { return __builtin_amdgcn_mfma_f32_16x16x32_f16(a, b, c, 0, 0, 0); }
DEV f32x16 mfma32(half8 a, half8 b, f32x16 c) { return __builtin_amdgcn_mfma_f32_32x32x16_f16(a, b, c, 0, 0, 0); }
DEV f32x4 mfmaf(float a, float b, f32x4 c) { return __builtin_amdgcn_mfma_f32_16x16x4f32(a, b, c, 0, 0, 0); }
DEV half4 tr16(const half_t* p) { s16x4 t = __builtin_amdgcn_ds_read_tr16_b64_v4i16((LDSP s16x4*)p); return __builtin_bit_cast(half4, t); }
template <int OFF> DEV half4 tr16_nowait(const half_t* p) { s16x4 t; const unsigned a = (unsigned)(size_t)(LDSP const half_t*)p; asm volatile("ds_read_b64_tr_b16 %0, %1 offset:%2" : "=v"(t) : "v"(a), "i"(OFF) : "memory"); return __builtin_bit_cast(half4, t); }
#define TR_WAIT() do { asm volatile("s_waitcnt lgkmcnt(0)" ::: "memory"); __builtin_amdgcn_sched_barrier(0); } while (0)
DEV float shfl_xor_f(float v, int m) { return __shfl_xor(v, m, 64); }
DEV float shfl_f(float v, int src) { return __shfl(v, src, 64); }
DEV int atomic_add_i(int* p, int v) { return atomicAdd(p, v); }
DEV bool wave_any(bool p) { return __any(p) != 0; }
DEV float fexp2(float x) { return __builtin_amdgcn_exp2f(x); }
DEV float fexp(float x) { return __expf(x); }
DEV float flog(float x) { return __logf(x); }
DEV float frsqrt(float x) { return __builtin_amdgcn_rsqf(x); }
DEV float frcp(float x) { return __builtin_amdgcn_rcpf(x); }
#endif

#ifdef CPU_EMU
DEV float opaque0() { return 0.f; }
DEV int TID() { return (int)threadIdx.x; }
#else
DEV int TID() { int t = (int)threadIdx.x; asm volatile("" : "+v"(t)); return t; }
DEV float opaque0() { float z = 0.f; asm volatile("" : "+v"(z)); return z; }
#endif
constexpr int B_ = CFG_B, SEQ = CFG_SEQ, NL = CFG_L, CTX = CFG_CTX, D = 1024;
constexpr int NLAT = B_ * SEQ, NCTX = B_ * CTX, NT = NLAT + NCTX;
constexpr int ROWS = SEQ / 64;
constexpr int KEYS = SEQ + CTX;
constexpr int PTOT = 3424, PPAD = 3456;
constexpr int O_CQ = 0, O_CKV = 192, O_KR = 320, O_NAQ = 352, O_NAK = 608, O_NAV = 864, O_RQ = 1120, O_RK = 1376, O_RV = 1632, O_RG = 1888,
              O_HQ = 2144, O_HF = 2400, O_HB = 2656, O_HI = 2912, O_HG = 3168;
constexpr int NCH = KEYS / 64, CG = CTX / 64, LG = SEQ / 64;
constexpr int NEXP = 32, ACT_ROWS = 2 * NT + NEXP * 256;
constexpr float EPS = 1e-6f;
constexpr float LOG2E = 1.4426950408889634f;
constexpr int MODW = 6 * D;
constexpr int NTHREADS = 256;
constexpr int SMEM_BYTES = 74240;

struct Params {
    const float *x, *c, *ctx, *c_ctx, *w_ada, *b_ada, *w_in, *w_out, *mla_g_cq, *mla_g_ckv, *mla_w_uq, *mla_w_ukv, *mla_g_qn, *mla_g_qr, *mla_g_kn,
        *mla_g_kr, *na_g_q, *na_g_k, *na_rpb, *ret_g_out, *hg_lb_raw, *hg_g_out, *moe_w_rg, *moe_b_rg, *moe_w_re, *moe_b_re, *moe_w1, *moe_w3, *moe_w2;
    float* out;
    unsigned* bar;
    float *xc, *mod, *hglb, *wr, *cshift, *list_gate, *gst, *gdec, *rope;
    int *cnt, *list_tok, *tokslot, *sched;
    half_t *win16, *wout16, *wuq16, *wukv16, *h, *p, *y, *qraw, *kvraw, *mq, *mk, *mv, *nq, *nk, *nv, *act, *yrows, *w13h, *w2h;
};

#ifdef CPU_EMU
typedef const Params CP;
#else
typedef const __attribute__((address_space(4))) Params CP;
#endif
DEV int tok_brow(int t) { return t < NLAT ? t / SEQ : B_; }
DEV float* xrow_ptr(CP& P, int t) { return t < NLAT ? P.out + (size_t)t * D : P.xc + (size_t)(t - NLAT) * D; }
DEV float silu_f(float x) { return x * frcp(1.0f + fexp(-x)); }
DEV float sigmoid_f(float x) { return frcp(1.0f + fexp(-x)); }
DEV float wave_sum(float v) {
    v += shfl_xor_f(v, 1); v += shfl_xor_f(v, 2); v += shfl_xor_f(v, 4); v += shfl_xor_f(v, 8); v += shfl_xor_f(v, 16); v += shfl_xor_f(v, 32);
    return v;
}
DEV half4 to_half4(f32x4 v) { half4 r; r[0] = (half_t)v[0]; r[1] = (half_t)v[1]; r[2] = (half_t)v[2]; r[3] = (half_t)v[3]; return r; }

constexpr int LDB_S = 136, G_BBUF = 32 * LDB_S;
struct BSrcH {
    const half_t* base; int ld;
    typedef half8 Raw;
    DEV Raw load(int k, int n) const { return *(const half8*)(base + (size_t)k * ld + n); }
    DEV half8 cvt(const Raw& r) const { return r; }
};
struct RawF { f32x4 a, b; };
DEV half8 cvt_rawf(const RawF& r) {
    half8 h; h[0] = (half_t)r.a[0]; h[1] = (half_t)r.a[1]; h[2] = (half_t)r.a[2]; h[3] = (half_t)r.a[3];
    h[4] = (half_t)r.b[0]; h[5] = (half_t)r.b[1]; h[6] = (half_t)r.b[2]; h[7] = (half_t)r.b[3]; return h;
}
struct BSrcF {
    const float* base; int ld;
    typedef RawF Raw;
    DEV Raw load(int k, int n) const { const float* s = base + (size_t)k * ld + n; RawF r; r.a = *(const f32x4*)s; r.b = *(const f32x4*)(s + 4); return r; }
    DEV half8 cvt(const Raw& r) const { return cvt_rawf(r); }
};
struct BSrcF2 {
    const float* b0; ptrdiff_t d10; int ld;
    typedef RawF Raw;
    DEV Raw load(int k, int n) const { const float* s = b0 + (ptrdiff_t)(n >> 6) * d10 + (n & 63) + (size_t)k * ld; RawF r; r.a = *(const f32x4*)s; r.b = *(const f32x4*)(s + 4); return r; }
    DEV half8 cvt(const Raw& r) const { return cvt_rawf(r); }
};
DEV int swzB(int k, int ch) { return k * LDB_S + (ch << 3); }
constexpr int GS_A = 256 * 32, GS_B = 32 * 128, GS_STAGE = GS_A + GS_B;
DEV int fswzB(int k) { return 2 * ((k & 3) | (((k >> 3) & 1) << 2)); }
#define GEMM_ISSUE(ST, KT)                                                                                                   \
    {                                                                                                                        \
        half_t* sa_ = ring + (ST) * GS_STAGE + (64 * w) * 32;                                                                 \
        half_t* sb_ = ring + (ST) * GS_STAGE + GS_A + (8 * w) * 128;                                                          \
        _Pragma("unroll") for (int j = 0; j < 4; ++j) glds16(asrc[j] + (KT) * 32, sa_ + 16 * j * 32);                        \
        _Pragma("unroll") for (int j = 0; j < 2; ++j) glds16(bsrc[j] + (size_t)(KT) * 32 * ldb, sb_ + 4 * j * 128);          \
    }
#define GEMM_COMPUTE(ST)                                                                                                     \
    {                                                                                                                        \
        const half_t* sa_ = ring + (ST) * GS_STAGE; const half_t* sb_ = sa_ + GS_A;                                          \
        half8 af[4];                                                                                                         \
        _Pragma("unroll") for (int mt = 0; mt < 4; ++mt) af[mt] = *(const half8*)(sa_ + aoff + mt * 16 * 32);                \
        _Pragma("unroll") for (int nh = 0; nh < 2; ++nh) {                                                                   \
            half8 bf[4];                                                                                                     \
            _Pragma("unroll") for (int n4 = 0; n4 < 4; ++n4) {                                                               \
                const half_t* ba = sb_ + bk0 * 128 + (((2 * (4 * nh + n4) + (pp >> 1)) ^ bfz) << 3) + 4 * (pp & 1);          \
                const half4 lo = tr16_nowait<0>(ba), hi = tr16_nowait<1024>(ba);                                             \
                bf[n4][0] = lo[0]; bf[n4][1] = lo[1]; bf[n4][2] = lo[2]; bf[n4][3] = lo[3]; bf[n4][4] = hi[0]; bf[n4][5] = hi[1]; bf[n4][6] = hi[2]; bf[n4][7] = hi[3]; \
            }                                                                                                                \
            TR_WAIT();                                                                                                       \
            _Pragma("unroll") for (int n4 = 0; n4 < 4; ++n4)                                                                 \
                _Pragma("unroll") for (int mt = 0; mt < 4; ++mt) acc[mt][4 * nh + n4] = mfma16(bf[n4], af[mt], acc[mt][4 * nh + n4]); \
        }                                                                                                                    \
    }
#define GEMM_STEP(ST, ST2, itv)                                                                                              \
    {                                                                                                                        \
        const int it_ = (itv);                                                                                               \
        if (it_ + 1 < nk) { WAIT_VM(6); } else { WAIT_VM(0); }                                                               \
        RAW_BARRIER();                                                                                                       \
        if (it_ + 2 < nk) GEMM_ISSUE(ST2, it_ + 2)                                                                           \
        GEMM_COMPUTE(ST)                                                                                                     \
    }
template <class ARow, class BS, class Epi>
DEV void gemm256(const ARow& arow, const BS& bs, int K, Epi& epi, unsigned char* smem) {
    half_t* ring = (half_t*)smem;
    const int tid = TID(), lane = tid & 63, w = WID(tid), g = lane >> 4, li = lane & 15;
    const int q = li >> 2, pp = li & 3;
    const int nk = K >> 5;
    const int ldb = bs.ld;
    const half_t* asrc[4];
#pragma unroll
    for (int j = 0; j < 4; ++j) asrc[j] = arow(64 * w + 16 * j + (lane >> 2)) + 8 * ((lane & 3) ^ (lane >> 4));
    const half_t* bsrc[2];
#pragma unroll
    for (int j = 0; j < 2; ++j) { const int k = 8 * w + 4 * j + (lane >> 4); bsrc[j] = bs.base + (size_t)k * ldb + 8 * ((lane & 15) ^ fswzB(k)); }
    const int aoff = (64 * w + li) * 32 + ((g ^ (li >> 2)) << 3);
    const int bk0 = 8 * g + q, bfz = fswzB(bk0);
    f32x4 acc[4][8];
#pragma unroll
    for (int mt = 0; mt < 4; ++mt)
#pragma unroll
        for (int nt = 0; nt < 8; ++nt) acc[mt][nt] = (f32x4){0.f, 0.f, 0.f, 0.f};
    SYNC();
    GEMM_ISSUE(0, 0)
    GEMM_ISSUE(1, 1)
#pragma clang loop unroll(disable)
    for (int it = 0; it < nk; it += 3) {
        GEMM_STEP(0, 2, it)
        if (it + 1 < nk) GEMM_STEP(1, 0, it + 1)
        if (it + 2 < nk) GEMM_STEP(2, 1, it + 2)
    }
    epi.run(acc, w, g, li);
}
struct ARowLin { const half_t* base; int ld; DEV const half_t* operator()(int r) const { return base + (size_t)r * ld; } };
struct ARowGather { const half_t* base; int ld; const int* idx; int nvalid; DEV const half_t* operator()(int r) const { const int t = r < nvalid ? idx[r] : 0; return base + (size_t)t * ld; } };

struct EpiStoreH {
    half_t* out; int ld;
    DEV void run(const f32x4 (&acc)[4][8], int w, int g, int li) const {
#pragma unroll
        for (int mt = 0; mt < 4; ++mt)
#pragma unroll
            for (int nt = 0; nt < 8; ++nt) *(half4*)(out + (size_t)(64 * w + 16 * mt + li) * ld + 16 * nt + 4 * g) = to_half4(acc[mt][nt]);
    }
};
struct EpiResid {
    float* x; const float* gate;
    DEV void run(const f32x4 (&acc)[4][8], int w, int g, int li) const {
#pragma unroll
        for (int nh = 0; nh < 2; ++nh) {
            f32x4 gt[4];
#pragma unroll
            for (int n4 = 0; n4 < 4; ++n4) gt[n4] = *(const f32x4*)(gate + 16 * (4 * nh + n4) + 4 * g);
#pragma unroll
            for (int mt = 0; mt < 4; ++mt) {
                f32x4 xv[4];
                float* xr = x + (size_t)(64 * w + 16 * mt + li) * D + 64 * nh + 4 * g;
#pragma unroll
                for (int n4 = 0; n4 < 4; ++n4) xv[n4] = *(const f32x4*)(xr + 16 * n4);
                SCHED_FENCE();
#pragma unroll
                for (int n4 = 0; n4 < 4; ++n4) *(f32x4*)(xr + 16 * n4) = xv[n4] + gt[n4] * acc[mt][4 * nh + n4];
            }
        }
    }
};
struct EpiGlu {
    half_t* out; int ld;
    DEV void run(const f32x4 (&acc)[4][8], int w, int g, int li) const {
#pragma unroll
        for (int mt = 0; mt < 4; ++mt)
#pragma unroll
            for (int nt = 0; nt < 4; ++nt) {
                f32x4 o;
#pragma unroll
                for (int r = 0; r < 4; ++r) o[r] = silu_f(acc[mt][nt][r]) * acc[mt][nt + 4][r];
                *(half4*)(out + (size_t)(64 * w + 16 * mt + li) * ld + 16 * nt + 4 * g) = to_half4(o);
            }
    }
};
struct EpiRowsGate {
    half_t* out; const float* gate; int nvalid;
    DEV void run(const f32x4 (&acc)[4][8], int w, int g, int li) const {
#pragma unroll
        for (int mt = 0; mt < 4; ++mt) {
            const int row = 64 * w + 16 * mt + li;
            if (row < nvalid) {
                const float gt = gate[row];
#pragma unroll
                for (int nt = 0; nt < 8; ++nt) *(half4*)(out + (size_t)row * D + 16 * nt + 4 * g) = to_half4(acc[mt][nt] * gt);
            }
        }
    }
};

DEV void phase_prologue_a(CP& P, unsigned char* smem) {
    const int tid = TID(), gtid = blockIdx.x * NTHREADS + tid, gsz = gridDim.x * NTHREADS;
    for (size_t i = gtid; i < (size_t)NL * D * (PPAD / 8); i += gsz) {
        const int cc = (int)(i % (PPAD / 8)) * 8; const size_t rk = i / (PPAD / 8);
        half8 h;
#pragma unroll
        for (int j = 0; j < 8; ++j) h[j] = (cc + j < PTOT) ? (half_t)P.w_in[rk * PTOT + cc + j] : (half_t)0.f;
        *(half8*)(P.win16 + rk * PPAD + cc) = h;
    }
    for (size_t i = gtid; i < (size_t)NL * D * D / 8; i += gsz) {
        const f32x4 a = *(const f32x4*)(P.w_out + i * 8), b = *(const f32x4*)(P.w_out + i * 8 + 4);
        RawF r; r.a = a; r.b = b; *(half8*)(P.wout16 + i * 8) = cvt_rawf(r);
    }
    for (int i = gtid; i < NL * 192 * 384; i += gsz) { const int l = i / (192 * 384), k = (i / 384) % 192; P.wuq16[i] = (half_t)(P.mla_g_cq[l * 192 + k] * P.mla_w_uq[i]); }
    for (int i = gtid; i < NL * 128 * 512; i += gsz) { const int l = i / (128 * 512), k = (i / 512) % 128; P.wukv16[i] = (half_t)(P.mla_g_ckv[l * 128 + k] * P.mla_w_ukv[i]); }
    for (int i = gtid; i < 256; i += gsz) {
        float mx = -1e30f; for (int l = 0; l < NL; ++l) mx = fmaxf(mx, P.hg_lb_raw[l * 256 + i]);
        float den = 0.f; for (int l = 0; l < NL; ++l) den += fexp(P.hg_lb_raw[l * 256 + i] - mx);
        float cum = 0.f;
        for (int l = 0; l < NL; ++l) { const float wv = fexp(P.hg_lb_raw[l * 256 + i] - mx) / den; if (l > 0) cum += wv; P.hglb[l * 256 + i] = cum; }
    }
    for (int i = gtid; i < NL * D * 48; i += gsz) {
        const int n = i % 48, lk = i / 48;
        P.wr[i] = n < 4 ? P.moe_w_rg[lk * 4 + n] : (n < 36 ? P.moe_w_re[lk * 32 + (n - 4)] : 0.f);
    }
    for (int i = gtid; i < NL * NEXP; i += gsz) P.cnt[i] = 0;
    for (int i = gtid; i < NL * 16; i += gsz) P.sched[i] = 0;
    for (int i = gtid; i < SEQ * 16; i += gsz) {
        const int n = i >> 4, j = i & 15, ax = j >> 3, fi = j & 7;
        const float ang = (float)(ax == 0 ? n / 64 : n % 64) * fexp(-9.210340371976184f * (float)fi * 0.125f);
        P.rope[n * 32 + j] = cosf(ang); P.rope[n * 32 + 16 + j] = sinf(ang);
    }
    float* sc = (float*)smem;
    SYNC();
    for (int i = tid; i < (B_ + 1) * D; i += NTHREADS) { const int r = i / D, k = i % D; const float v = r < B_ ? P.c[r * D + k] : P.c_ctx[k]; sc[i] = silu_f(v); }
    SYNC();
    for (int item = blockIdx.x; item < NL * (MODW / 256); item += gridDim.x) {
        const int l = item / (MODW / 256), n = (item % (MODW / 256)) * 256 + tid;
        float acc[B_ + 1];
#pragma unroll
        for (int r = 0; r <= B_; ++r) acc[r] = 0.f;
        const float* wp = P.w_ada + (size_t)l * D * MODW + n;
        for (int k = 0; k < D; ++k) {
            const float wv = wp[(size_t)k * MODW];
#pragma unroll
            for (int r = 0; r <= B_; ++r) acc[r] += sc[r * D + k] * wv;
        }
        const float bv = P.b_ada[l * MODW + n];
#pragma unroll
        for (int r = 0; r <= B_; ++r) P.mod[((size_t)l * (B_ + 1) + r) * MODW + n] = acc[r] + bv;
    }
}

DEV void row_modulate_store(const f32x4 (&v)[4], const float* sh, const float* sc, half_t* hrow, int lane) {
    f32x4 s4[4], h4[4];
#pragma unroll
    for (int j = 0; j < 4; ++j) { s4[j] = *(const f32x4*)(sc + 256 * j + 4 * lane); h4[j] = *(const f32x4*)(sh + 256 * j + 4 * lane); }
    float ss = 0.f;
#pragma unroll
    for (int j = 0; j < 4; ++j) ss += v[j][0] * v[j][0] + v[j][1] * v[j][1] + v[j][2] * v[j][2] + v[j][3] * v[j][3];
    ss = wave_sum(ss);
    const float rstd = frsqrt(ss * (1.0f / D) + EPS);
#pragma unroll
    for (int j = 0; j < 4; ++j) {
        f32x4 o;
#pragma unroll
        for (int e = 0; e < 4; ++e) o[e] = v[j][e] * rstd * (1.0f + s4[j][e]) + h4[j][e];
        *(half4*)(hrow + 256 * j + 4 * lane) = to_half4(o);
    }
}
DEV void phase_prologue_b(CP& P) {
    const int lane = TID() & 63, gw = blockIdx.x * 4 + (TID() >> 6), nw = gridDim.x * 4;
    for (int t = gw; t < NT; t += nw) {
        const float* src = t < NLAT ? P.x + (size_t)t * D : P.ctx + (size_t)(t - NLAT) * D;
        float* dst = xrow_ptr(P, t);
        f32x4 v[4];
#pragma unroll
        for (int j = 0; j < 4; ++j) { v[j] = *(const f32x4*)(src + 256 * j + 4 * lane); *(f32x4*)(dst + 256 * j + 4 * lane) = v[j]; }
        const float* md = P.mod + (size_t)tok_brow(t) * MODW;
        row_modulate_store(v, md + 0, md + D, P.h + (size_t)t * D, lane);
    }
    for (int it = gw; it < NL * (B_ + 1) * 36; it += nw) {
        const int n = it % 36, lr = it / 36, l = lr / (B_ + 1);
        const float* sh = P.mod + (size_t)lr * MODW + 3 * D;
        float s = 0.f;
        for (int k = lane; k < D; k += 64) s += sh[k] * P.wr[((size_t)l * D + k) * 48 + n];
        s = wave_sum(s);
        if (lane == 0) P.cshift[lr * 48 + n] = s + (n < 4 ? P.moe_b_rg[l * 4 + n] : P.moe_b_re[l * 32 + n - 4]);
    }
}

DEV bool gemm_tile_order(int round, int ntm, int ntn, int& tm, int& tn) {
    const int per = gridDim.x >> 3;
    const int idx = ((round << 3) + (blockIdx.x & 7)) * per + (blockIdx.x >> 3);
    if (idx >= ntm * ntn) return false;
    const int nig = 4 * ntn, gid = idx / nig, fm = gid * 4, gsz = (ntm - fm) < 4 ? (ntm - fm) : 4, rem = idx - gid * nig;
    tm = fm + rem % gsz; tn = rem / gsz; return true;
}
DEV void phase_inproj(CP& P, int l, unsigned char* smem) {
    constexpr int NTN = PPAD / 128, NTM = NT / 256;
    const int rounds = (NTM * NTN + gridDim.x - 1) / gridDim.x;
    for (int rep = 0; rep < ((PROBE & 1) ? 2 : 1); ++rep)
    for (int round = 0; round < rounds; ++round) {
        int tm, tn;
        if (!gemm_tile_order(round, NTM, NTN, tm, tn)) continue;
        ARowLin ar{P.h + (size_t)tm * 256 * D, D};
        BSrcH bs{P.win16 + (size_t)l * D * PPAD + tn * 128, PPAD};
        EpiStoreH epi{P.p + (size_t)tm * 256 * PPAD + tn * 128, PPAD};
        gemm256(ar, bs, D, epi, smem);
    }
}

constexpr int GQ_LD = 68, GH_LD = 72, GS_LD = 24;
constexpr int G_QF = 0, G_KF = 17408, G_KH = 34816, G_VH = 44032, G_SC = 53248, G_DK = 56320, G_RED = 57344;
DEV float ret_loggamma(int h, int dir) { return log1pf(-exp2f(-5.0f - (float)(2 * h + dir))); }
template <int MIX, bool OUT, int dir>
DEV void gla_stage(CP& P, int l, int h, int tok0, float lgam, float& totsum, unsigned char* smem) {
    float* Qf = (float*)(smem + G_QF); float* Kf = (float*)(smem + G_KF); half_t* Kh = (half_t*)(smem + G_KH); half_t* Vh = (half_t*)(smem + G_VH);
    float* dk = (float*)(smem + G_DK);
    const int tid = TID(), d = tid & 63, I = tid >> 6;
    const half_t* pr = P.p + (size_t)(tok0 + 16 * I) * PPAD + h * 64 + d;
    float lf[16], kk[16], qq[16];
    half_t vv[16], rq[16], rk[16];
    float lb = 0.f;
    if (MIX == 1) lb = P.hglb[l * 256 + h * 64 + d];
#pragma unroll
    for (int i = 0; i < 16; ++i) {
        const half_t* pi = pr + (size_t)i * PPAD;
        if (MIX == 0) { rq[i] = OUT ? pi[O_RQ] : (half_t)0.f; rk[i] = pi[O_RK]; vv[i] = pi[O_RV]; }
        else { rq[i] = OUT ? pi[O_HQ] : (half_t)0.f; rk[i] = pi[dir ? O_HB : O_HF]; vv[i] = pi[O_HI]; }
    }
    SCHED_FENCE();
    float tot = 0.f;
#pragma unroll
    for (int i = 0; i < 16; ++i) {
        if (MIX == 0) {
            qq[i] = (float)rq[i]; kk[i] = (float)rk[i] * 0.125f; lf[i] = lgam;
        } else {
            qq[i] = OUT ? silu_f((float)rq[i]) : 0.f;
            const float sg = sigmoid_f((float)rk[i]), f = lb + (1.0f - lb) * sg;
            lf[i] = flog(fmaxf(f, 1e-20f)); kk[i] = (1.0f - lb) * (1.0f - sg);
        }
        tot += lf[i];
    }
    float bc = 0.f;
#pragma unroll
    for (int ii = 0; ii < 16; ++ii) {
        const int i = dir == 0 ? ii : 15 - ii;
        bc += lf[i];
        const int o = (I * 16 + i);
        if (OUT) { Qf[o * GQ_LD + d] = qq[i] * fexp(bc); Kf[o * GQ_LD + d] = kk[i] * fexp(fminf(-bc, 80.0f)); }
        Kh[o * GH_LD + d] = (half_t)(kk[i] * fexp(tot - bc));
        Vh[o * GH_LD + d] = vv[i];
    }
    dk[I * 64 + d] = fexp(tot);
    totsum += tot;
}
DEV half8 tok_frag(const half_t* img, int col0, int lane) {
    const int g = lane >> 4, li = lane & 15, q = li >> 2, p = li & 3;
    const half_t* a = img + (8 * (g & 1) + q) * GH_LD + col0 + 4 * p;
    const half4 lo = tr16(a), hi = tr16(a + 4 * GH_LD);
    half8 r;
    const bool z = g >= 2;
    r[0] = z ? (half_t)0.f : lo[0]; r[1] = z ? (half_t)0.f : lo[1]; r[2] = z ? (half_t)0.f : lo[2]; r[3] = z ? (half_t)0.f : lo[3];
    r[4] = z ? (half_t)0.f : hi[0]; r[5] = z ? (half_t)0.f : hi[1]; r[6] = z ? (half_t)0.f : hi[2]; r[7] = z ? (half_t)0.f : hi[3];
    return r;
}
DEV void gla_scores(int dir, unsigned char* smem) {
    const float* Qf = (const float*)(smem + G_QF); const float* Kf = (const float*)(smem + G_KF); half_t* sc = (half_t*)(smem + G_SC);
    const int tid = TID(), lane = tid & 63, w = tid >> 6, g = lane >> 4, li = lane & 15;
    f32x4 s0 = {0.f, 0.f, 0.f, 0.f}, s1 = {0.f, 0.f, 0.f, 0.f};
    const float* kp = Kf + (w * 16 + li) * GQ_LD + g; const float* qp = Qf + (w * 16 + li) * GQ_LD + g;
#pragma unroll
    for (int kk = 0; kk < 16; kk += 2) { s0 = mfmaf(kp[4 * kk], qp[4 * kk], s0); s1 = mfmaf(kp[4 * kk + 4], qp[4 * kk + 4], s1); }
    half4 o;
#pragma unroll
    for (int r = 0; r < 4; ++r) { const int sj = 4 * g + r; const bool keep = dir == 0 ? (sj <= li) : (sj >= li); o[r] = keep ? (half_t)(s0[r] + s1[r]) : (half_t)0.f; }
    *(half4*)(sc + (w * 16 + li) * GS_LD + 4 * g) = o;
}
template <bool OUT>
DEV void gla_main_sub(int I, f32x4 (&st)[4], f32x4& oacc, unsigned char* smem) {
    const float* Qf = (const float*)(smem + G_QF); const half_t* Kh = (const half_t*)(smem + G_KH); const half_t* Vh = (const half_t*)(smem + G_VH);
    const half_t* sc = (const half_t*)(smem + G_SC); const float* dk = (const float*)(smem + G_DK);
    const int tid = TID(), lane = tid & 63, w = tid >> 6, g = lane >> 4, li = lane & 15;
    const half8 vfr = tok_frag(Vh + I * 16 * GH_LD, 16 * w, lane);
    if (OUT) {
        const half8 sf = *(const half8*)(sc + (I * 16 + li) * GS_LD + 8 * (g & 1));
        oacc = mfma16(vfr, sf, oacc);
#pragma unroll
        for (int ks = 0; ks < 2; ++ks) {
            half8 sa, qb;
            const f32x4 q0 = *(const f32x4*)(Qf + (I * 16 + li) * GQ_LD + 32 * ks + 4 * g), q1 = *(const f32x4*)(Qf + (I * 16 + li) * GQ_LD + 32 * ks + 16 + 4 * g);
#pragma unroll
            for (int j = 0; j < 4; ++j) { sa[j] = (half_t)st[2 * ks][j]; sa[4 + j] = (half_t)st[2 * ks + 1][j]; qb[j] = (half_t)q0[j]; qb[4 + j] = (half_t)q1[j]; }
            oacc = mfma16(sa, qb, oacc);
        }
    }
#pragma unroll
    for (int dt = 0; dt < 4; ++dt) {
        const f32x4 dv = *(const f32x4*)(dk + I * 64 + 16 * dt + 4 * g);
#pragma unroll
        for (int r = 0; r < 4; ++r) st[dt][r] *= dv[r];
        st[dt] = mfma16(tok_frag(Kh + I * 16 * GH_LD, 16 * dt, lane), vfr, st[dt]);
    }
}
DEV int gla_tok0(int b, int gidx) { return gidx < CG ? NLAT + b * CTX + 64 * gidx : b * SEQ + 64 * (gidx - CG); }
DEV int gla_chainpos(int gidx, int dir) { return dir == 0 ? gidx : (gidx < CG ? CG - 1 - gidx : CG + (LG - 1 - (gidx - CG))); }
DEV size_t gla_chain(int mix, int b, int h, int dir) { return (((size_t)mix * B_ + b) * 4 + h) * 2 + dir; }
template <int MIX>
DEV void gla_step_a(CP& P, int l, int b, int h, int dir, int gidx, unsigned char* smem) {
    const int tid = TID(), lane = tid & 63, w = tid >> 6, g = lane >> 4, li = lane & 15;
    f32x4 st[4]; f32x4 od = {0.f, 0.f, 0.f, 0.f};
#pragma unroll
    for (int dt = 0; dt < 4; ++dt) st[dt] = (f32x4){0.f, 0.f, 0.f, 0.f};
    float totsum = 0.f;
    const float lgam = MIX == 0 ? ret_loggamma(h, dir) : 0.f;
    if (dir == 0) gla_stage<MIX, false, 0>(P, l, h, gla_tok0(b, gidx), lgam, totsum, smem); else gla_stage<MIX, false, 1>(P, l, h, gla_tok0(b, gidx), lgam, totsum, smem);
    SYNC();
#pragma unroll
    for (int ii = 0; ii < 4; ++ii) gla_main_sub<false>(dir == 0 ? ii : 3 - ii, st, od, smem);
    const size_t slot = gla_chain(MIX, b, h, dir) * NCH + gla_chainpos(gidx, dir);
    float* dst = P.gst + slot * 4096;
#pragma unroll
    for (int dt = 0; dt < 4; ++dt)
#pragma unroll
        for (int r = 0; r < 4; ++r) dst[(16 * dt + 4 * g + r) * 64 + 16 * w + li] = st[dt][r];
    if (tid < 64) { const float* dk = (const float*)(smem + G_DK); P.gdec[slot * 64 + tid] = dk[tid] * dk[64 + tid] * dk[128 + tid] * dk[192 + tid]; }
    SYNC();
}
template <int MIX>
DEV void gla_step_c(CP& P, int l, int b, int h, int gidx, unsigned char* smem) {
    const int tid = TID(), lane = tid & 63, w = tid >> 6, g = lane >> 4, li = lane & 15;
    f32x4 oacc[4];
#pragma unroll
    for (int I = 0; I < 4; ++I) oacc[I] = (f32x4){0.f, 0.f, 0.f, 0.f};
    const int tok0 = gla_tok0(b, gidx);
    float totsum = 0.f;
#pragma unroll
    for (int dir = 0; dir < 2; ++dir) {
        const size_t slot = gla_chain(MIX, b, h, dir) * NCH + gla_chainpos(gidx, dir);
        const float* src = P.gst + slot * 4096;
        f32x4 st[4];
#pragma unroll
        for (int dt = 0; dt < 4; ++dt)
#pragma unroll
            for (int r = 0; r < 4; ++r) st[dt][r] = src[(16 * dt + 4 * g + r) * 64 + 16 * w + li];
        const float lgam = MIX == 0 ? ret_loggamma(h, dir) : 0.f;
        if (dir == 1) SYNC();
        if (dir == 0) gla_stage<MIX, true, 0>(P, l, h, tok0, lgam, totsum, smem); else gla_stage<MIX, true, 1>(P, l, h, tok0, lgam, totsum, smem);
        SYNC();
        gla_scores(dir, smem);
        SYNC();
#pragma unroll
        for (int ii = 0; ii < 4; ++ii) { const int I = dir == 0 ? ii : 3 - ii; gla_main_sub<true>(I, st, oacc[I], smem); }
    }
    float* red = (float*)(smem + G_RED);
#pragma unroll
    for (int I = 0; I < 4; ++I) {
        float ss = oacc[I][0] * oacc[I][0] + oacc[I][1] * oacc[I][1] + oacc[I][2] * oacc[I][2] + oacc[I][3] * oacc[I][3];
        ss += shfl_xor_f(ss, 16); ss += shfl_xor_f(ss, 32);
        if (g == 0) red[w * 64 + 16 * I + li] = ss;
    }
    SYNC();
    const float* gain = (MIX == 0 ? P.ret_g_out : P.hg_g_out) + l * 64;
    const int ycol = (MIX == 0 ? 512 : 768) + h * 64 + 16 * w + 4 * g, gcol = (MIX == 0 ? O_RG : O_HG) + h * 64 + 16 * w + 4 * g;
#pragma unroll
    for (int I = 0; I < 4; ++I) {
        const int ti = 16 * I + li, t = tok0 + ti;
        const float tot = red[ti] + red[64 + ti] + red[128 + ti] + red[192 + ti];
        const float rstd = frsqrt(tot * (1.0f / 64.0f) + EPS);
        const half4 gt = *(const half4*)(P.p + (size_t)t * PPAD + gcol);
        f32x4 o;
#pragma unroll
        for (int r = 0; r < 4; ++r) o[r] = oacc[I][r] * rstd * gain[16 * w + 4 * g + r] * silu_f((float)gt[r]);
        *(half4*)(P.y + (size_t)t * D + ycol) = to_half4(o);
    }
    SYNC();
}
DEV void gla_scan(CP& P, int item, float* gst, int chain_off) {
    const int chain = item >> 2, e4 = ((item & 3) << 8) + TID(), d = e4 >> 4;
    float* base = gst + (size_t)(chain - chain_off) * NCH * 4096 + 4 * e4;
    const float* dec = P.gdec + (size_t)chain * NCH * 64 + d;
    const float z0 = opaque0();
    f32x4 s = {z0, z0, z0, z0};
    static_assert(NCH % 17 == 0 || NCH % 4 == 0, "scan batch");
    constexpr int BT = (NCH % 17 == 0) ? 17 : 4;
    for (int pos = 0; pos < NCH; pos += BT) {
        f32x4 ds[BT]; float dc[BT];
#pragma unroll
        for (int j = 0; j < BT; ++j) { ds[j] = *(const f32x4*)(base + (size_t)(pos + j) * 4096); dc[j] = dec[(pos + j) * 64]; }
#pragma unroll
        for (int j = 0; j < BT; ++j) { *(f32x4*)(base + (size_t)(pos + j) * 4096) = s; s = s * dc[j] + ds[j]; }
    }
}

DEV void up_glaa_item(CP& P, int l, int item, unsigned char* smem) {
    constexpr int NTM = NT / 256, NQ = NTM * 3, NKV = NTM * 4;
    if (item < NQ + NKV) {
        const bool isq = item < NQ;
        const int it = isq ? item : item - NQ, nn = isq ? 3 : 4, tm = it / nn, tn = it % nn;
        const int ldo = isq ? 384 : 512, kk = isq ? 192 : 128;
        ARowLin ar{P.p + (size_t)tm * 256 * PPAD + (isq ? O_CQ : O_CKV), PPAD};
        BSrcH bs{(isq ? P.wuq16 + (size_t)l * 192 * 384 : P.wukv16 + (size_t)l * 128 * 512) + tn * 128, ldo};
        EpiStoreH epi{(isq ? P.qraw : P.kvraw) + (size_t)tm * 256 * ldo + tn * 128, ldo};
        gemm256(ar, bs, kk, epi, smem);
    } else {
        int it = item - NQ - NKV;
        const int gidx = it % NCH; it /= NCH; const int dir = it & 1; it >>= 1; const int h = it & 3; it >>= 2; const int b = it % B_; const int mix = it / B_;
        SYNC();
        if (mix == 0) gla_step_a<0>(P, l, b, h, dir, gidx, smem); else gla_step_a<1>(P, l, b, h, dir, gidx, smem);
    }
}
DEV void phase_up_glaa(CP& P, int l, unsigned char* smem) {
    constexpr int NTM = NT / 256, NQ = NTM * 3, NKV = NTM * 4, NGA = 2 * B_ * 4 * 2 * NCH;
    for (int item = blockIdx.x; item < NQ + NKV + NGA; item += gridDim.x) up_glaa_item(P, l, item, smem);
    if (PROBE & 2) for (int item = blockIdx.x; item < NQ + NKV; item += gridDim.x) up_glaa_item(P, l, item, smem);
    if (PROBE & 4) for (int item = blockIdx.x; item < NGA; item += gridDim.x) up_glaa_item(P, l, NQ + NKV + item, smem);
}

DEV float sumsq8(half8 v) { float s = 0.f;
#pragma unroll
    for (int j = 0; j < 8; ++j) s += (float)v[j] * (float)v[j];
    return s; }
DEV void rope32(const half8 (&in)[4], float pre, const float* gain, const float* cs_tab, bool rot, float post, half8 (&out)[4]) {
    float v[32]; float ss = 0.f;
#pragma unroll
    for (int j = 0; j < 32; ++j) { v[j] = (float)in[j >> 3][j & 7] * pre; ss += v[j] * v[j]; }
    const float r = frsqrt(ss * (1.0f / 32.0f) + EPS);
#pragma unroll
    for (int j = 0; j < 32; ++j) v[j] = v[j] * r * gain[j];
#pragma unroll
    for (int ax = 0; ax < 2; ++ax)
#pragma unroll
        for (int i = 0; i < 8; ++i) {
            const float c = rot ? cs_tab[ax * 8 + i] : 1.f, sn = rot ? cs_tab[16 + ax * 8 + i] : 0.f;
            const float z1 = v[16 * ax + i], z2 = v[16 * ax + 8 + i];
            v[16 * ax + i] = z1 * c - z2 * sn; v[16 * ax + 8 + i] = z2 * c + z1 * sn;
        }
#pragma unroll
    for (int j = 0; j < 32; ++j) out[j >> 3][j & 7] = (half_t)(v[j] * post);
}
DEV void norm64_store(const half8 (&in)[8], float pre, const float* gain, float post, half_t* dst) {
    float ss = 0.f;
#pragma unroll
    for (int c = 0; c < 8; ++c) ss += sumsq8(in[c]);
    const float r = frsqrt(ss * pre * pre * (1.0f / 64.0f) + EPS) * pre * post;
#pragma unroll
    for (int c = 0; c < 8; ++c) {
        const f32x4 g0 = *(const f32x4*)(gain + 8 * c), g1 = *(const f32x4*)(gain + 8 * c + 4);
        half8 o;
#pragma unroll
        for (int j = 0; j < 4; ++j) { o[j] = (half_t)((float)in[c][j] * r * g0[j]); o[4 + j] = (half_t)((float)in[c][4 + j] * r * g1[j]); }
        *(half8*)(dst + 8 * c) = o;
    }
}
DEV void mixer_prep_item(CP& P, int l, int item) {
    const int tid = TID(), t = item * 16 + (tid & 15), job = tid >> 4, h = job & 3;
    const int b = t < NLAT ? t / SEQ : (t - NLAT) / CTX;
    const bool lat = t < NLAT;
    const int n = lat ? t % SEQ : 0;
    const int pos = lat ? n : SEQ + (t - NLAT) % CTX;
    const half_t* pr = P.p + (size_t)t * PPAD;
    const size_t row = (size_t)(b * 4 + h) * KEYS + pos;
    const float* cst = P.rope + (size_t)n * 32;
    if (job < 4) {
        const half_t* qr = P.qraw + (size_t)t * 384 + h * 96;
        half8 cq[24], qn[8], qro[4], qo[4];
#pragma unroll
        for (int c = 0; c < 24; ++c) cq[c] = *(const half8*)(pr + O_CQ + 8 * c);
#pragma unroll
        for (int c = 0; c < 8; ++c) qn[c] = *(const half8*)(qr + 8 * c);
#pragma unroll
        for (int c = 0; c < 4; ++c) qro[c] = *(const half8*)(qr + 64 + 8 * c);
        SCHED_FENCE();
        float s1 = 0.f;
#pragma unroll
        for (int c = 0; c < 24; ++c) s1 += sumsq8(cq[c]);
        const float rq = frsqrt(s1 * (1.0f / 192.0f) + EPS);
        const float qs = 0.10206207261596575f * LOG2E;
        norm64_store(qn, rq, P.mla_g_qn + l * 64, qs, P.mq + row * 96);
        rope32(qro, rq, P.mla_g_qr + l * 32, cst, lat, qs, qo);
#pragma unroll
        for (int c = 0; c < 4; ++c) *(half8*)(P.mq + row * 96 + 64 + 8 * c) = qo[c];
    } else if (job < 8) {
        const half_t* kr = P.kvraw + (size_t)t * 512 + h * 128;
        half8 ckv[16], kn[8], kvv[8], kri[4], kro[4];
#pragma unroll
        for (int c = 0; c < 16; ++c) ckv[c] = *(const half8*)(pr + O_CKV + 8 * c);
#pragma unroll
        for (int c = 0; c < 8; ++c) { kn[c] = *(const half8*)(kr + 8 * c); kvv[c] = *(const half8*)(kr + 64 + 8 * c); }
#pragma unroll
        for (int c = 0; c < 4; ++c) kri[c] = *(const half8*)(pr + O_KR + 8 * c);
        SCHED_FENCE();
        float s2 = 0.f;
#pragma unroll
        for (int c = 0; c < 16; ++c) s2 += sumsq8(ckv[c]);
        const float rkv = frsqrt(s2 * (1.0f / 128.0f) + EPS);
        norm64_store(kn, rkv, P.mla_g_kn + l * 64, 1.0f, P.mk + row * 96);
        rope32(kri, 1.0f, P.mla_g_kr + l * 32, cst, lat, 1.0f, kro);
#pragma unroll
        for (int c = 0; c < 4; ++c) *(half8*)(P.mk + row * 96 + 64 + 8 * c) = kro[c];
#pragma unroll
        for (int c = 0; c < 8; ++c) {
            const half8 v = kvv[c]; half8 o;
#pragma unroll
            for (int j = 0; j < 8; ++j) o[j] = (half_t)((float)v[j] * rkv);
            *(half8*)(P.mv + row * 64 + 8 * c) = o;
        }
    } else if (job < 12) {
        half8 a[8], a2[8];
#pragma unroll
        for (int c = 0; c < 8; ++c) { a[c] = *(const half8*)(pr + O_NAQ + h * 64 + 8 * c); a2[c] = *(const half8*)(pr + O_NAK + h * 64 + 8 * c); }
        SCHED_FENCE();
        norm64_store(a, 1.0f, P.na_g_q + l * 64, 0.125f * LOG2E, P.nq + row * 64);
        norm64_store(a2, 1.0f, P.na_g_k + l * 64, 1.0f, P.nk + row * 64);
    } else {
        half8 a[8];
#pragma unroll
        for (int c = 0; c < 8; ++c) a[c] = *(const half8*)(pr + O_NAV + h * 64 + 8 * c);
        SCHED_FENCE();
#pragma unroll
        for (int c = 0; c < 8; ++c) *(half8*)(P.nv + row * 64 + 8 * c) = a[c];
    }
}
DEV void phase_prep_scan(CP& P, int l, int rep) {
    constexpr int NSCAN = 2 * B_ * 4 * 2 * 4;
    constexpr int NPREP = NT / 16;
    for (int item = blockIdx.x; item < NSCAN + NPREP; item += gridDim.x) {
        if (item < NSCAN) {
            if (!rep) gla_scan(P, item, P.gst, 0);
            else if (item < NSCAN / 2) gla_scan(P, item, (float*)P.y, 0);
            else gla_scan(P, item, (float*)P.h, NSCAN / 8);
        }
        else mixer_prep_item(P, l, item - NSCAN);
    }
    if (PROBE & 8) for (int item = blockIdx.x; item < NPREP; item += gridDim.x) mixer_prep_item(P, l, item);
}

DEV half8 vt_frag(const half_t* Vs, int ldv, int kbase, int dv0, int lane) {
    const int grp = lane >> 4, hh = lane >> 5, i = lane & 15, q = i >> 2, pp = i & 3;
    const half_t* a = Vs + (kbase + 4 * hh + q) * ldv + dv0 + 16 * (grp & 1) + 4 * pp;
    const half4 lo = tr16(a), hi = tr16(a + 8 * ldv);
    half8 r; r[0] = lo[0]; r[1] = lo[1]; r[2] = lo[2]; r[3] = lo[3]; r[4] = hi[0]; r[5] = hi[1]; r[6] = hi[2]; r[7] = hi[3]; return r;
}
DEV void softmax_pv_step(const f32x16& s, float& m, float& lsum, f32x16 (&o)[2], const half_t* Vs, int ldv, int lane) {
    float mx = s[0];
#pragma unroll
    for (int r = 1; r < 16; ++r) mx = fmaxf(mx, s[r]);
    mx = fmaxf(mx, shfl_xor_f(mx, 32));
    const float mn = fmaxf(m, mx);
    const float alpha = fexp2(m - mn);
    m = mn;
    float ps = 0.f; half8 pf[2];
#pragma unroll
    for (int r = 0; r < 16; ++r) { const float pv = fexp2(s[r] - mn); ps += pv; pf[r >> 3][r & 7] = (half_t)pv; }
    lsum = lsum * alpha + ps;
#pragma unroll
    for (int dt = 0; dt < 2; ++dt)
#pragma unroll
        for (int r = 0; r < 16; ++r) o[dt][r] *= alpha;
#pragma unroll
    for (int s2 = 0; s2 < 2; ++s2)
#pragma unroll
        for (int dt = 0; dt < 2; ++dt) o[dt] = mfma32(vt_frag(Vs, ldv, 16 * s2, 32 * dt, lane), pf[s2], o[dt]);
}
DEV void softmax_pv_step2(const f32x16& s0, const f32x16& s1, float& m, float& lsum, f32x16 (&o)[2], const half_t* Vs, int ldv, int lane) {
    float mx = fmaxf(s0[0], s1[0]);
#pragma unroll
    for (int r = 1; r < 16; ++r) mx = fmaxf(mx, fmaxf(s0[r], s1[r]));
    mx = fmaxf(mx, shfl_xor_f(mx, 32));
    const float mn = fmaxf(m, mx);
    if (wave_any(mn != m)) {
        const float alpha = fexp2(m - mn);
        lsum *= alpha;
#pragma unroll
        for (int dt = 0; dt < 2; ++dt)
#pragma unroll
            for (int r = 0; r < 16; ++r) o[dt][r] *= alpha;
        m = mn;
    }
    float ps = 0.f; half8 pf[4];
#pragma unroll
    for (int r = 0; r < 16; ++r) { const float pa = fexp2(s0[r] - m), pb = fexp2(s1[r] - m); ps += pa + pb; pf[r >> 3][r & 7] = (half_t)pa; pf[2 + (r >> 3)][r & 7] = (half_t)pb; }
    lsum += ps;
#pragma unroll
    for (int kt2 = 0; kt2 < 2; ++kt2)
#pragma unroll
        for (int s2 = 0; s2 < 2; ++s2)
#pragma unroll
            for (int dt = 0; dt < 2; ++dt) o[dt] = mfma32(vt_frag(Vs + 32 * kt2 * ldv, ldv, 16 * s2, 32 * dt, lane), pf[2 * kt2 + s2], o[dt]);
}
DEV void attn_store(const f32x16 (&o)[2], float lsum, half_t* yrow, int lane) {
    const float inv = 1.0f / (lsum + shfl_xor_f(lsum, 32));
    const int hh = lane >> 5;
#pragma unroll
    for (int dt = 0; dt < 2; ++dt)
#pragma unroll
        for (int rq = 0; rq < 4; ++rq) {
            half4 v;
#pragma unroll
            for (int e = 0; e < 4; ++e) v[e] = (half_t)(o[dt][4 * rq + e] * inv);
            *(half4*)(yrow + 32 * dt + 8 * rq + 4 * hh) = v;
        }
}
DEV int attn_qtoken(int b, int qpos) { return qpos < SEQ ? b * SEQ + qpos : NLAT + b * CTX + (qpos - SEQ); }

constexpr int MK_LD = 104, MV_LD = 72;
DEV void mla_attn_item(CP& P, int b, int h, int qt, unsigned char* smem) {
    half_t* Ks = (half_t*)smem; half_t* Vs = Ks + 64 * MK_LD;
    const int tid = TID(), lane = tid & 63, w = tid >> 6, hh = lane >> 5, ql = lane & 31;
    const size_t bh = (size_t)(b * 4 + h) * KEYS;
    const int q0 = qt * 128 + 32 * w;
    const bool ctxq = q0 >= SEQ;
    const int kbeg = ctxq ? SEQ : 0, nkt = (ctxq ? CTX : KEYS) / 64;
    half8 qf[6];
#pragma unroll
    for (int ks = 0; ks < 6; ++ks) qf[ks] = *(const half8*)(P.mq + (bh + q0 + ql) * 96 + 16 * ks + 8 * hh);
    f32x16 o[2]; float m = -1e30f, lsum = 0.f;
#pragma unroll
    for (int dt = 0; dt < 2; ++dt)
#pragma unroll
        for (int r = 0; r < 16; ++r) o[dt][r] = 0.f;
    half8 pk[3], pv[2];
    const half_t* kg = P.mk + (bh + kbeg) * 96; const half_t* vg = P.mv + (bh + kbeg) * 64;
#pragma unroll
    for (int i = 0; i < 3; ++i) { const int c = tid + 256 * i; pk[i] = *(const half8*)(kg + (size_t)(c / 12) * 96 + (c % 12) * 8); }
#pragma unroll
    for (int i = 0; i < 2; ++i) { const int c = tid + 256 * i; pv[i] = *(const half8*)(vg + (size_t)(c >> 3) * 64 + (c & 7) * 8); }
    for (int kt = 0; kt < nkt; ++kt) {
        SYNC();
#pragma unroll
        for (int i = 0; i < 3; ++i) { const int c = tid + 256 * i; *(half8*)(Ks + (c / 12) * MK_LD + (c % 12) * 8) = pk[i]; }
#pragma unroll
        for (int i = 0; i < 2; ++i) { const int c = tid + 256 * i; *(half8*)(Vs + (c >> 3) * MV_LD + (c & 7) * 8) = pv[i]; }
        SYNC();
        if (kt + 1 < nkt) {
            const half_t* kg2 = kg + (size_t)(kt + 1) * 64 * 96; const half_t* vg2 = vg + (size_t)(kt + 1) * 64 * 64;
#pragma unroll
            for (int i = 0; i < 3; ++i) { const int c = tid + 256 * i; pk[i] = *(const half8*)(kg2 + (size_t)(c / 12) * 96 + (c % 12) * 8); }
#pragma unroll
            for (int i = 0; i < 2; ++i) { const int c = tid + 256 * i; pv[i] = *(const half8*)(vg2 + (size_t)(c >> 3) * 64 + (c & 7) * 8); }
        }
        SCHED_FENCE();
        f32x16 s0, s1;
#pragma unroll
        for (int r = 0; r < 16; ++r) { s0[r] = 0.f; s1[r] = 0.f; }
#pragma unroll
        for (int ks = 0; ks < 6; ++ks) {
            s0 = mfma32(*(const half8*)(Ks + ql * MK_LD + 16 * ks + 8 * hh), qf[ks], s0);
            s1 = mfma32(*(const half8*)(Ks + (32 + ql) * MK_LD + 16 * ks + 8 * hh), qf[ks], s1);
        }
        softmax_pv_step2(s0, s1, m, lsum, o, Vs, MV_LD, lane);
    }
    attn_store(o, lsum, P.y + (size_t)attn_qtoken(b, q0 + ql) * D + 0 + h * 64, lane);
}

constexpr int NV_LD = 72, NA_WAVE_LDS = 32 * NV_LD * 2 + 15 * 32 * 4;
DEV void na_attn_unit(CP& P, int l, int unit, unsigned char* wlds, int lane) {
    constexpr int NLATU = B_ * 4 * ROWS * 2;
    half_t* Vw = (half_t*)wlds; float* bt = (float*)(wlds + 32 * NV_LD * 2);
    const int hh = lane >> 5, ql = lane & 31;
    int b, h, q0, ntile, R0 = 0, r = 0, hf = 0; bool lat;
    if (unit < NLATU) { lat = true; hf = unit & 1; r = (unit >> 1) % ROWS; const int bh = unit / (2 * ROWS); h = bh & 3; b = bh >> 2; q0 = r * 64 + 32 * hf; ntile = 16 + CTX / 32;
        R0 = r - 4 < 0 ? 0 : (r - 4 > ROWS - 8 ? ROWS - 8 : r - 4); }
    else { lat = false; const int u = unit - NLATU; const int cb = u % (CTX / 32); const int bh = u / (CTX / 32); h = bh & 3; b = bh >> 2; q0 = SEQ + 32 * cb; ntile = CTX / 32; }
    const size_t bhk = (size_t)(b * 4 + h) * KEYS;
    WAVE_BARRIER();
    if (lat) {
        const float* rp = P.na_rpb + (size_t)(l * 4 + h) * 15 * 31;
        for (int i = lane; i < 15 * 32; i += 64) { const int dr = i >> 5, dc = i & 31; bt[i] = dc < 31 ? rp[dr * 31 + dc] * LOG2E : 0.f; }
    }
    half8 qf[4];
#pragma unroll
    for (int ks = 0; ks < 4; ++ks) qf[ks] = *(const half8*)(P.nq + (bhk + q0 + ql) * 64 + 16 * ks + 8 * hh);
    f32x16 o[2]; float m = -1e30f, lsum = 0.f;
#pragma unroll
    for (int dt = 0; dt < 2; ++dt)
#pragma unroll
        for (int rr = 0; rr < 16; ++rr) o[dt][rr] = 0.f;
    const int wq = 32 * hf + ql;
    const int cs = wq - 8 < 0 ? 0 : (wq - 8 > 48 ? 48 : wq - 8);
    auto tile_kpos = [&](int tile) { return (lat && tile < 16) ? (R0 + (tile >> 1)) * 64 + 32 * (tile & 1) : SEQ + 32 * (lat ? tile - 16 : tile); };
    half8 kf[4], vf[4];
    {
        const int kp = tile_kpos(0);
#pragma unroll
        for (int ks = 0; ks < 4; ++ks) kf[ks] = *(const half8*)(P.nk + (bhk + kp + ql) * 64 + 16 * ks + 8 * hh);
#pragma unroll
        for (int i = 0; i < 4; ++i) { const int c = lane + 64 * i; vf[i] = *(const half8*)(P.nv + (bhk + kp + (c >> 3)) * 64 + (c & 7) * 8); }
    }
    for (int tile = 0; tile < ntile; ++tile) {
        const bool win = lat && tile < 16;
        const int krow = R0 + (tile >> 1), kh2 = tile & 1;
        f32x16 s;
#pragma unroll
        for (int rr = 0; rr < 16; ++rr) s[rr] = 0.f;
#pragma unroll
        for (int ks = 0; ks < 4; ++ks) s = mfma32(kf[ks], qf[ks], s);
        WAVE_BARRIER();
#pragma unroll
        for (int i = 0; i < 4; ++i) { const int c = lane + 64 * i; *(half8*)(Vw + (c >> 3) * NV_LD + (c & 7) * 8) = vf[i]; }
        if (tile + 1 < ntile) {
            const int kp = tile_kpos(tile + 1);
#pragma unroll
            for (int ks = 0; ks < 4; ++ks) kf[ks] = *(const half8*)(P.nk + (bhk + kp + ql) * 64 + 16 * ks + 8 * hh);
#pragma unroll
            for (int i = 0; i < 4; ++i) { const int c = lane + 64 * i; vf[i] = *(const half8*)(P.nv + (bhk + kp + (c >> 3)) * 64 + (c & 7) * 8); }
        }
        SCHED_FENCE();
        if (win) {
            const float* brow = bt + (krow - r + 7) * 32;
            float bv[16];
#pragma unroll
            for (int rr = 0; rr < 16; ++rr) {
                const int wk = 32 * kh2 + (rr & 3) + 8 * (rr >> 2) + 4 * hh;
                int dc = wk - wq + 15; dc = dc < 0 ? 0 : (dc > 30 ? 30 : dc);
                bv[rr] = brow[dc];
            }
#pragma unroll
            for (int rr = 0; rr < 16; ++rr) {
                const int wk = 32 * kh2 + (rr & 3) + 8 * (rr >> 2) + 4 * hh;
                const bool valid = wk >= cs && wk < cs + 16;
                s[rr] = valid ? s[rr] + bv[rr] : -INFINITY;
            }
        }
        WAVE_BARRIER();
        softmax_pv_step(s, m, lsum, o, Vw, NV_LD, lane);
    }
    attn_store(o, lsum, P.y + (size_t)attn_qtoken(b, q0 + ql) * D + 256 + h * 64, lane);
}

DEV void mixers_item(CP& P, int l, int item, unsigned char* smem) {
    const bool last = l == NL - 1;
    const int QT = (last ? SEQ : KEYS) / 128;
    const int NMLA = B_ * 4 * QT;
    const int NNA = (B_ * 4 * ROWS * 2 + (last ? 0 : B_ * 4 * (CTX / 32))) / 4;
    const int NGRP = last ? LG : NCH;
    const int lane = TID() & 63, w = TID() >> 6;
    if (item < NMLA) {
        const int qt = item % QT, bh = item / QT;
        mla_attn_item(P, bh >> 2, bh & 3, qt, smem);
    } else if (item < NMLA + NNA) {
        SYNC();
        na_attn_unit(P, l, (item - NMLA) * 4 + w, smem + w * NA_WAVE_LDS, lane);
    } else {
        int it = item - NMLA - NNA;
        const int gi = it % NGRP; it /= NGRP; const int h = it & 3; it >>= 2; const int b = it % B_; const int mix = it / B_;
        const int gidx = last ? gi + CG : gi;
        SYNC();
        if (mix == 0) gla_step_c<0>(P, l, b, h, gidx, smem); else gla_step_c<1>(P, l, b, h, gidx, smem);
    }
}
DEV int sched_next(int* ctr, unsigned char* smem) {
    int* slot = (int*)(smem + SMEM_BYTES - 16);
    SYNC();
    if (TID() == 0) *slot = atomic_add_i(ctr, 1);
    SYNC();
    return *slot;
}
constexpr int NCONV = 1024;
constexpr int CV_W13 = NEXP * D * 1024 / 8, CV_W2 = NEXP * 512 * D / 8;
DEV void moe_convert_unit(CP& P, int l, int u) {
    constexpr int PER = (CV_W13 + CV_W2) / NCONV;
    static_assert((CV_W13 + CV_W2) % NCONV == 0 && PER % NTHREADS == 0, "conversion split");
    const int tid = TID();
    for (int i0 = 0; i0 < PER; i0 += 4 * NTHREADS) {
        RawF r[4]; int c[4];
#pragma unroll
        for (int j = 0; j < 4; ++j) {
            c[j] = u * PER + i0 + j * NTHREADS + tid;
            const float* src;
            if (c[j] < CV_W13) {
                const int v = (c[j] & 127) * 8, k = (c[j] >> 7) & 1023, e = c[j] >> 17;
                const int tn = v >> 7, half = (v >> 6) & 1, col = 64 * tn + (v & 63);
                src = (half ? P.moe_w3 : P.moe_w1) + (((size_t)l * NEXP + e) * D + k) * 512 + col;
            } else { src = P.moe_w2 + (size_t)l * NEXP * 512 * D + (size_t)(c[j] - CV_W13) * 8; }
            r[j].a = *(const f32x4*)src; r[j].b = *(const f32x4*)(src + 4);
        }
        SCHED_FENCE();
#pragma unroll
        for (int j = 0; j < 4; ++j) {
            half_t* dst = c[j] < CV_W13 ? P.w13h + (size_t)c[j] * 8 : P.w2h + (size_t)(c[j] - CV_W13) * 8;
            *(half8*)dst = cvt_rawf(r[j]);
        }
    }
}
DEV void phase_mixers(CP& P, int l, unsigned char* smem, int rep) {
    const bool last = l == NL - 1;
    const int QT = (last ? SEQ : KEYS) / 128;
    const int NMLA = B_ * 4 * QT;
    const int NNA = (B_ * 4 * ROWS * 2 + (last ? 0 : B_ * 4 * (CTX / 32))) / 4;
    const int NGC = 2 * B_ * 4 * (last ? LG : NCH);
    const int NCV = rep ? 0 : NCONV;
    const int NIL = NMLA < NCV ? NMLA : NCV;
    const int NU = NMLA + NCV + NNA + NGC / 4;
    int* ctr = P.sched + l * 16 + rep;
    for (int u = sched_next(ctr, smem); u < NU; u = sched_next(ctr, smem)) {
        if (u < 2 * NIL) { if (u & 1) moe_convert_unit(P, l, u >> 1); else mixers_item(P, l, u >> 1, smem); }
        else if (u < NMLA + NCV) { const int v = u - 2 * NIL; if (NMLA > NCV) mixers_item(P, l, NIL + v, smem); else moe_convert_unit(P, l, NIL + v); }
        else if (u < NMLA + NCV + NNA) mixers_item(P, l, u - NCV, smem);
        else { const int g0 = NMLA + NNA + (u - NMLA - NCV - NNA) * 4; for (int j = 0; j < 4; ++j) mixers_item(P, l, g0 + j, smem); }
    }
    if (PROBE & 16) for (int item = blockIdx.x; item < NMLA; item += gridDim.x) mixers_item(P, l, item, smem);
    if (PROBE & 32) for (int item = blockIdx.x; item < NNA; item += gridDim.x) mixers_item(P, l, NMLA + item, smem);
    if (PROBE & 64) for (int item = blockIdx.x; item < NGC; item += gridDim.x) mixers_item(P, l, NMLA + NNA + item, smem);
}

DEV void phase_outproj(CP& P, int l, unsigned char* smem, int rep0) {
    const bool last = l == NL - 1;
    const int NTM = (last ? NLAT : NT) / 256;
    const int rounds = (NTM * 8 + gridDim.x - 1) / gridDim.x;
    for (int rep = rep0; rep < ((PROBE & 512) ? 2 : rep0 + 1); ++rep)
    for (int round = 0; round < rounds; ++round) {
        int tm, tn;
        if (!gemm_tile_order(round, NTM, 8, tm, tn)) continue;
        const int t0 = tm * 256;
        ARowLin ar{P.y + (size_t)t0 * D, D};
        BSrcH bs{P.wout16 + (size_t)l * D * D + tn * 128, D};
        EpiResid epi{(rep ? P.gst + (size_t)t0 * D : xrow_ptr(P, t0)) + tn * 128, P.mod + ((size_t)l * (B_ + 1) + tok_brow(t0)) * MODW + 2 * D + tn * 128};
        gemm256(ar, bs, D, epi, smem);
    }
}

template <bool DRY> DEV void phase_router_t(CP& P, int l, unsigned char* smem) {
    const bool last = l == NL - 1;
    const int NI = (last ? NLAT : NT) / 64;
    const int tid = TID(), lane = tid & 63, w = tid >> 6, g = lane >> 4, li = lane & 15;
    float* wrs = (float*)smem;
    float* lg = (float*)(smem + 64 * 52 * 4) + w * 16 * 48;
    const float* wr = P.wr + (size_t)l * D * 48;
    int wrow[3], wc4[3];
#pragma unroll
    for (int i = 0; i < 3; ++i) { const int idx = tid + 256 * i; wrow[i] = idx / 12; wc4[i] = (idx % 12) * 4; }
    for (int item = blockIdx.x; item < NI; item += gridDim.x) {
        const int tok0 = item * 64 + 16 * w, br = tok_brow(item * 64);
        const float* xr = xrow_ptr(P, tok0 + li);
        const float* md = P.mod + ((size_t)l * (B_ + 1) + br) * MODW;
        const float* sh = md + 3 * D; const float* sc = md + 4 * D;
        f32x4 acc[3];
#pragma unroll
        for (int nt = 0; nt < 3; ++nt) acc[nt] = (f32x4){0.f, 0.f, 0.f, 0.f};
        float ssq = 0.f;
        f32x4 wv[3], xv[4], sv[4];
#pragma unroll
        for (int i = 0; i < 3; ++i) wv[i] = *(const f32x4*)(wr + (size_t)wrow[i] * 48 + wc4[i]);
#pragma unroll
        for (int j = 0; j < 4; ++j) { xv[j] = *(const f32x4*)(xr + 16 * j + 4 * g); sv[j] = *(const f32x4*)(sc + 16 * j + 4 * g); }
        for (int ch = 0; ch < 16; ++ch) {
            SYNC();
#pragma unroll
            for (int i = 0; i < 3; ++i) *(f32x4*)(wrs + wrow[i] * 52 + wc4[i]) = wv[i];
            SYNC();
            f32x4 xc[4], sk[4];
#pragma unroll
            for (int j = 0; j < 4; ++j) { xc[j] = xv[j]; sk[j] = sv[j]; }
            if (ch + 1 < 16) {
#pragma unroll
                for (int i = 0; i < 3; ++i) wv[i] = *(const f32x4*)(wr + (size_t)(64 * (ch + 1) + wrow[i]) * 48 + wc4[i]);
#pragma unroll
                for (int j = 0; j < 4; ++j) { xv[j] = *(const f32x4*)(xr + 64 * (ch + 1) + 16 * j + 4 * g); sv[j] = *(const f32x4*)(sc + 64 * (ch + 1) + 16 * j + 4 * g); }
            }
            SCHED_FENCE();
#pragma unroll
            for (int j = 0; j < 4; ++j) {
                ssq += xc[j][0] * xc[j][0] + xc[j][1] * xc[j][1] + xc[j][2] * xc[j][2] + xc[j][3] * xc[j][3];
#pragma unroll
                for (int c = 0; c < 4; ++c) {
                    const float a = xc[j][c] * (1.0f + sk[j][c]);
                    const float* wrow_l = wrs + (16 * j + 4 * g + c) * 52 + li;
#pragma unroll
                    for (int nt = 0; nt < 3; ++nt) acc[nt] = mfmaf(a, wrow_l[16 * nt], acc[nt]);
                }
            }
        }
        ssq += shfl_xor_f(ssq, 16); ssq += shfl_xor_f(ssq, 32);
        const float rstd = frsqrt(ssq * (1.0f / D) + EPS);
        const float* csh = P.cshift + ((size_t)l * (B_ + 1) + br) * 48;
        WAVE_BARRIER();
#pragma unroll
        for (int r = 0; r < 4; ++r) {
            const float rs = shfl_f(rstd, 4 * g + r);
#pragma unroll
            for (int nt = 0; nt < 3; ++nt) lg[(4 * g + r) * 48 + 16 * nt + li] = acc[nt][r] * rs + csh[16 * nt + li];
        }
        WAVE_BARRIER();
        if (lane < 16) {
            const float* lt = lg + lane * 48;
            int gi = 0; float gm = lt[0];
            for (int j = 1; j < 4; ++j) if (lt[j] > gm) { gm = lt[j]; gi = j; }
            float gden = 0.f; for (int j = 0; j < 4; ++j) gden += fexp(lt[j] - gm);
            const float pg = 1.0f / gden;
            const float* ft = lt + 4 + gi * 8;
            int e0 = 0; float f0 = ft[0];
            for (int j = 1; j < 8; ++j) if (ft[j] > f0) { f0 = ft[j]; e0 = j; }
            int e1 = -1; float f1 = -3.0e38f;
            for (int j = 0; j < 8; ++j) if (j != e0 && ft[j] > f1) { f1 = ft[j]; e1 = j; }
            const float p1 = fexp(f1 - f0);
            const float g0 = pg / (1.0f + p1), g1 = pg * p1 / (1.0f + p1);
            const int t = tok0 + lane, x0 = gi * 8 + e0, x1 = gi * 8 + e1;
            if (DRY) { float* dd = (float*)P.act + (size_t)t * 4; dd[0] = g0; dd[1] = g1; dd[2] = (float)x0; dd[3] = (float)x1; }
            else {
            const int s0 = atomic_add_i(P.cnt + l * NEXP + x0, 1), s1 = atomic_add_i(P.cnt + l * NEXP + x1, 1);
            P.list_tok[(size_t)x0 * NT + s0] = t; P.list_gate[(size_t)x0 * NT + s0] = g0;
            P.list_tok[(size_t)x1 * NT + s1] = t; P.list_gate[(size_t)x1 * NT + s1] = g1;
            P.tokslot[2 * t] = (x0 << 20) | s0; P.tokslot[2 * t + 1] = (x1 << 20) | s1;
            }
        }
        WAVE_BARRIER();
        half_t* hr = (DRY ? P.y : P.h) + (size_t)(tok0 + li) * D;
        for (int k8 = 0; k8 < 64; k8 += 8) {
            f32x4 xq[8], sq[8], hq[8];
#pragma unroll
            for (int j = 0; j < 8; ++j) { const int col = 16 * (k8 + j) + 4 * g; xq[j] = *(const f32x4*)(xr + col); sq[j] = *(const f32x4*)(sc + col); hq[j] = *(const f32x4*)(sh + col); }
            SCHED_FENCE();
#pragma unroll
            for (int j = 0; j < 8; ++j) {
                f32x4 o;
#pragma unroll
                for (int c = 0; c < 4; ++c) o[c] = xq[j][c] * rstd * (1.0f + sq[j][c]) + hq[j][c];
                *(half4*)(hr + 16 * (k8 + j) + 4 * g) = to_half4(o);
            }
        }
    }
}

DEV void phase_router(CP& P, int l, unsigned char* smem, int rep) {
    if (rep) { phase_router_t<true>(P, l, smem); return; }
    phase_router_t<false>(P, l, smem);
    if (PROBE & 1024) phase_router_t<true>(P, l, smem);
}
DEV void moe_tables(CP& P, int l, int* ab, int* tb) {
    if (TID() == 0) {
        int a = 0, t = 0;
        for (int e = 0; e < NEXP; ++e) { const int c = P.cnt[l * NEXP + e], nt = (c + 255) >> 8; ab[e] = a; tb[e] = t; a += nt * 256; t += nt; }
        ab[NEXP] = a; tb[NEXP] = t;
    }
    SYNC();
}
DEV int moe_find(const int* tb, int tile) { int e = 0; while (e < NEXP - 1 && tile >= tb[e + 1]) ++e; return e; }
DEV bool moe_item(const int* tb, int idx, int& e, int& mt, int& tn) {
    const int x = blockIdx.x & 7;
#pragma unroll
    for (int eg = 0; eg < 4; ++eg) {
        e = x + 8 * eg; const int n = (tb[e + 1] - tb[e]) * 8;
        if (idx < n) { mt = idx >> 3; tn = idx & 7; return true; }
        idx -= n;
    }
    return false;
}

DEV void phase_moe1(CP& P, int l, unsigned char* smem) {
    int* ab = (int*)(smem + SMEM_BYTES - 512); int* tb = ab + 40;
    moe_tables(P, l, ab, tb);
    for (int rep = 0; rep < ((PROBE & 128) ? 2 : 1); ++rep)
    for (int idx = blockIdx.x >> 3;; idx += gridDim.x >> 3) {
        int e, mt, tn; if (!moe_item(tb, idx, e, mt, tn)) break;
        const int cnt = P.cnt[l * NEXP + e], nvalid = cnt - mt * 256 < 256 ? cnt - mt * 256 : 256;
        ARowGather ar{P.h, D, P.list_tok + (size_t)e * NT + mt * 256, nvalid};
        BSrcH bs{P.w13h + (size_t)e * D * 1024 + tn * 128, 1024};
        EpiGlu epi{P.act + (size_t)(ab[e] + mt * 256) * 512 + tn * 64, 512};
        gemm256(ar, bs, D, epi, smem);
    }
}
DEV void phase_moe2(CP& P, int l, unsigned char* smem) {
    int* ab = (int*)(smem + SMEM_BYTES - 512); int* tb = ab + 40;
    moe_tables(P, l, ab, tb);
    for (int rep = 0; rep < ((PROBE & 256) ? 2 : 1); ++rep)
    for (int idx = blockIdx.x >> 3;; idx += gridDim.x >> 3) {
        int e, mt, tn; if (!moe_item(tb, idx, e, mt, tn)) break;
        const int cnt = P.cnt[l * NEXP + e], nvalid = cnt - mt * 256 < 256 ? cnt - mt * 256 : 256;
        const size_t r0 = (size_t)ab[e] + mt * 256;
        ARowLin ar{P.act + r0 * 512, 512};
        BSrcH bs{P.w2h + (size_t)e * 512 * D + tn * 128, D};
        EpiRowsGate epi{P.yrows + r0 * D + tn * 128, P.list_gate + (size_t)e * NT + mt * 256, nvalid};
        gemm256(ar, bs, 512, epi, smem);
    }
}
template <bool DRY> DEV void phase_combine_t(CP& P, int l, unsigned char* smem) {
    int* ab = (int*)(smem + SMEM_BYTES - 512); int* tb = ab + 40;
    moe_tables(P, l, ab, tb);
    const bool last = l == NL - 1;
    const int NTK = last ? NLAT : NT;
    const int lane = TID() & 63, gw = blockIdx.x * 4 + (TID() >> 6), nw = gridDim.x * 4;
    for (int t = gw; t < NTK; t += nw) {
        const int ts0 = P.tokslot[2 * t], ts1 = P.tokslot[2 * t + 1];
        const half_t* y0 = P.yrows + (size_t)(ab[ts0 >> 20] + (ts0 & 0xFFFFF)) * D;
        const half_t* y1 = P.yrows + (size_t)(ab[ts1 >> 20] + (ts1 & 0xFFFFF)) * D;
        float* xr = xrow_ptr(P, t);
        float* xw = DRY ? P.gst + (size_t)t * D : xr;
        const float* md = P.mod + ((size_t)l * (B_ + 1) + tok_brow(t)) * MODW;
        f32x4 v[4], xv[4], gt[4]; half4 ya[4], yb[4];
#pragma unroll
        for (int j = 0; j < 4; ++j) {
            const int col = 256 * j + 4 * lane;
            xv[j] = *(const f32x4*)(xr + col); gt[j] = *(const f32x4*)(md + 5 * D + col); ya[j] = *(const half4*)(y0 + col); yb[j] = *(const half4*)(y1 + col);
        }
        SCHED_FENCE();
#pragma unroll
        for (int j = 0; j < 4; ++j) {
            const int col = 256 * j + 4 * lane;
#pragma unroll
            for (int e = 0; e < 4; ++e) v[j][e] = xv[j][e] + gt[j][e] * ((float)ya[j][e] + (float)yb[j][e]);
            *(f32x4*)(xw + col) = v[j];
        }
        if (!last) { const float* mn = md + (size_t)(B_ + 1) * MODW; row_modulate_store(v, mn + 0, mn + D, (DRY ? P.y : P.h) + (size_t)t * D, lane); }
    }
}

DEV void phase_combine(CP& P, int l, unsigned char* smem, int rep) {
    if (rep) { phase_combine_t<true>(P, l, smem); return; }
    if (PROBE & 2048) phase_combine_t<true>(P, l, smem);
    phase_combine_t<false>(P, l, smem);
}
template <int PH> DEV void run_phase(CP& P, int l, unsigned char* smem, int rep = 0) {
    if (PH == 0) { phase_prologue_a(P, smem); if (PROBE & 4096) { SYNC(); phase_prologue_a(P, smem); } }
    if (PH == 1) { phase_prologue_b(P); if (PROBE & 4096) phase_prologue_b(P); }
    if (PH == 2) phase_inproj(P, l, smem);
    if (PH == 3) phase_up_glaa(P, l, smem);
    if (PH == 4) phase_prep_scan(P, l, rep);
    if (PH == 5) phase_mixers(P, l, smem, rep);
    if (PH == 6) phase_outproj(P, l, smem, rep);
    if (PH == 7) phase_router(P, l, smem, rep);
    if (PH == 8) phase_moe1(P, l, smem);
    if (PH == 9) phase_moe2(P, l, smem);
    if (PH == 10) phase_combine(P, l, smem, rep);
}

#ifndef CPU_EMU
#define XB_TMO      128
#define XB_XCNT(j)  (256  + 64 * (j))
#define XB_XSUB(j)  (1280 + 64 * (j))
#define XB_XGEN(j)  (2304 + 64 * (j))
#define XB_TOP      3328
#define XB_TOPGEN   3392
#define XCD_BAR_WORDS 3456
#define XB_SPIN_CAP (1u << 24)
__device__ __forceinline__ unsigned xb_ld(unsigned* p)              { return __hip_atomic_load(p, __ATOMIC_RELAXED, __HIP_MEMORY_SCOPE_AGENT); }
__device__ __forceinline__ unsigned xb_add(unsigned* p, unsigned v) { return __hip_atomic_fetch_add(p, v, __ATOMIC_RELAXED, __HIP_MEMORY_SCOPE_AGENT); }
__device__ __forceinline__ unsigned xb_xcc_id() { return (unsigned)__builtin_amdgcn_s_getreg((3 << 11) | 20) & 0xFu; }
#define XB_SPIN(cond, bar) do { unsigned _sp = 0; while (cond) { __builtin_amdgcn_s_sleep(1); \
    if ((++_sp & 255u) == 0u) { if (xb_ld(&(bar)[XB_TMO])) break; if (_sp > XB_SPIN_CAP) { atomicAdd(&(bar)[XB_TMO], 1u); break; } } } } while (0)
struct XcdBarrier { unsigned* bar; unsigned x; volatile LDSP unsigned* st; };
__device__ __forceinline__ XcdBarrier xcd_barrier_post(unsigned* bar, volatile LDSP unsigned* st) {
    XcdBarrier b; b.bar = bar; b.x = xb_xcc_id(); b.st = st;
    if (threadIdx.x == 0) (void)xb_add(&bar[XB_XCNT(b.x)], 1u);
    return b;
}
__device__ __forceinline__ void xcd_barrier_complete(unsigned* bar, unsigned x, unsigned& nloc, unsigned& nx) {
    const unsigned G = gridDim.x * gridDim.y * gridDim.z;
    unsigned sum, cnt, mine, sp = 0u;
    for (;;) {
        sum = 0u; cnt = 0u; mine = 0u;
#pragma unroll
        for (unsigned j = 0; j < 16; ++j) { const unsigned c = xb_ld(&bar[XB_XCNT(j)]); sum += c; cnt += (c > 0u) ? 1u : 0u; mine = (j == x) ? c : mine; }
        if (sum == G) break;
        __builtin_amdgcn_s_sleep(1);
        if ((++sp & 255u) == 0u) { if (xb_ld(&bar[XB_TMO])) break; if (sp > XB_SPIN_CAP) { atomicAdd(&bar[XB_TMO], 1u); break; } }
    }
    nloc = mine > 0u ? mine : 1u; nx = cnt > 0u ? cnt : 1u;
}
__device__ __forceinline__ void xcd_barrier1(const XcdBarrier& b) {
    asm volatile("s_waitcnt vmcnt(0)" ::: "memory");
    __syncthreads();
    if (threadIdx.x == 0) {
        unsigned* bar = b.bar;
        __builtin_amdgcn_s_waitcnt(0);
        unsigned nloc = b.st[0], nx = b.st[1];
        if (nloc == 0u) { xcd_barrier_complete(bar, b.x, nloc, nx); b.st[0] = nloc; b.st[1] = nx; }
        const unsigned old = xb_add(&bar[XB_XSUB(b.x)], 1u);
        const unsigned gen = old / nloc;
        if (old + 1u == (gen + 1u) * nloc) {
            __builtin_amdgcn_fence(__ATOMIC_RELEASE, "agent");
            asm volatile("s_waitcnt vmcnt(0)" ::: "memory");
            const unsigned og = xb_add(&bar[XB_TOP], 1u);
            const unsigned tg = og / nx;
            if (og + 1u == (tg + 1u) * nx) xb_add(&bar[XB_TOPGEN], 1u);
            else XB_SPIN(xb_ld(&bar[XB_TOPGEN]) == tg, bar);
            __builtin_amdgcn_fence(__ATOMIC_ACQUIRE, "agent");
            xb_add(&bar[XB_XGEN(b.x)], 1u);
            asm volatile("s_waitcnt vmcnt(0)" ::: "memory");
        } else {
            XB_SPIN(xb_ld(&bar[XB_XGEN(b.x)]) == gen, bar);
            __builtin_amdgcn_fence(__ATOMIC_ACQUIRE, "agent");
            asm volatile("s_waitcnt vmcnt(0)" ::: "memory");
        }
    }
    __syncthreads();
}

#ifndef MK_MULTI
#define MK_MULTI 0
#endif
__device__ __forceinline__ void xcd_barrier(const XcdBarrier& b) { xcd_barrier1(b); if (PROBE & 8192) xcd_barrier1(b); }
#if MK_MULTI
template <int PH> __global__ void __launch_bounds__(NTHREADS, 2) k_phase(Params Pv, int l) {
    extern __shared__ __attribute__((aligned(16))) unsigned char smem[];
    CP& P = *(CP*)__builtin_amdgcn_kernarg_segment_ptr();
    run_phase<PH>(P, l, smem);
}
#else
template <int PH> static __device__ __forceinline__ void phase_ni(int l, int rep = 0) {
    extern __shared__ __attribute__((aligned(16))) unsigned char smem[];
    CP& P = *(CP*)__builtin_amdgcn_kernarg_segment_ptr();
    run_phase<PH>(P, l, smem, rep);
}
__global__ void __launch_bounds__(NTHREADS, 2) k_mega(Params Pv) {
    extern __shared__ __attribute__((aligned(16))) unsigned char smem[];
    CP& P = *(CP*)__builtin_amdgcn_kernarg_segment_ptr();
    volatile LDSP unsigned* xbw = (volatile LDSP unsigned*)(smem + SMEM_BYTES);
    if (threadIdx.x == 0) { xbw[0] = 0u; xbw[1] = 0u; xbw[2] = 0u; xbw[3] = 0u; }
    __syncthreads();
    XcdBarrier bar = xcd_barrier_post(P.bar, xbw);
    phase_ni<0>(0); xcd_barrier(bar);
    phase_ni<1>(0); xcd_barrier(bar);
#pragma clang loop unroll(disable)
    for (int l = 0; l < NL; ++l) {
        phase_ni<2>(l); xcd_barrier(bar); if (WPROBE == 2) { phase_ni<2>(l, 1); xcd_barrier(bar); }
        phase_ni<3>(l); xcd_barrier(bar); if (WPROBE == 3) { phase_ni<3>(l, 1); xcd_barrier(bar); }
        phase_ni<4>(l); xcd_barrier(bar); if (WPROBE == 4) { phase_ni<4>(l, 1); xcd_barrier(bar); }
        phase_ni<5>(l); xcd_barrier(bar); if (WPROBE == 5) { phase_ni<5>(l, 1); xcd_barrier(bar); }
        phase_ni<6>(l); xcd_barrier(bar); if (WPROBE == 6) { phase_ni<6>(l, 1); xcd_barrier(bar); }
        phase_ni<7>(l); xcd_barrier(bar); if (WPROBE == 7) { phase_ni<7>(l, 1); xcd_barrier(bar); }
        phase_ni<8>(l); xcd_barrier(bar); if (WPROBE == 8) { phase_ni<8>(l, 1); xcd_barrier(bar); }
        phase_ni<9>(l); xcd_barrier(bar); if (WPROBE == 9) { phase_ni<9>(l, 1); xcd_barrier(bar); }
        phase_ni<10>(l); if (WPROBE == 10) { xcd_barrier(bar); phase_ni<10>(l, 1); } if (l + 1 < NL) xcd_barrier(bar);
    }
}
#endif
#endif

struct Carver { unsigned char* base; size_t off; template <class T> T* take(size_t n) { off = (off + 255) & ~(size_t)255; T* p = (T*)(base + off); off += n * sizeof(T); return p; } };
static inline size_t carve_ws(Params& P, void* d_ws) {
    Carver c{(unsigned char*)d_ws, 0};
    P.bar = c.take<unsigned>(4096);
    P.xc = c.take<float>((size_t)NCTX * D);
    P.mod = c.take<float>((size_t)NL * (B_ + 1) * MODW);
    P.hglb = c.take<float>(NL * 256);
    P.rope = c.take<float>((size_t)SEQ * 32);
    P.wr = c.take<float>((size_t)NL * D * 48);
    P.cshift = c.take<float>(NL * (B_ + 1) * 48);
    P.cnt = c.take<int>(NL * NEXP);
    P.sched = c.take<int>(NL * 16);
    P.list_tok = c.take<int>((size_t)NEXP * NT);
    P.list_gate = c.take<float>((size_t)NEXP * NT);
    P.tokslot = c.take<int>((size_t)NT * 2);
    P.gst = c.take<float>((size_t)2 * B_ * 4 * 2 * NCH * 4096);
    P.gdec = c.take<float>((size_t)2 * B_ * 4 * 2 * NCH * 64);
    P.win16 = c.take<half_t>((size_t)NL * D * PPAD);
    P.wout16 = c.take<half_t>((size_t)NL * D * D);
    P.wuq16 = c.take<half_t>((size_t)NL * 192 * 384);
    P.wukv16 = c.take<half_t>((size_t)NL * 128 * 512);
    P.h = c.take<half_t>((size_t)NT * D);
    P.p = c.take<half_t>((size_t)NT * PPAD);
    P.yrows = P.p;
    P.y = c.take<half_t>((size_t)NT * D);
    P.qraw = c.take<half_t>((size_t)NT * 384);
    P.kvraw = c.take<half_t>((size_t)NT * 512);
    P.mq = c.take<half_t>((size_t)B_ * 4 * KEYS * 96);
    P.mk = c.take<half_t>((size_t)B_ * 4 * KEYS * 96);
    P.mv = c.take<half_t>((size_t)B_ * 4 * KEYS * 64);
    P.nq = c.take<half_t>((size_t)B_ * 4 * KEYS * 64);
    P.nk = c.take<half_t>((size_t)B_ * 4 * KEYS * 64);
    P.nv = c.take<half_t>((size_t)B_ * 4 * KEYS * 64);
    P.act = c.take<half_t>((size_t)ACT_ROWS * 512);
    P.w13h = c.take<half_t>((size_t)NEXP * D * 1024);
    P.w2h = c.take<half_t>((size_t)NEXP * 512 * D);
    return c.off;
}
static inline void fill_inputs(Params& P, void* const* d_in, void* d_out) {
    const float* const* in = (const float* const*)d_in;
    P.x = in[0]; P.c = in[1]; P.ctx = in[2]; P.c_ctx = in[3]; P.w_ada = in[4]; P.b_ada = in[5]; P.w_in = in[6]; P.w_out = in[7];
    P.mla_g_cq = in[8]; P.mla_g_ckv = in[9]; P.mla_w_uq = in[10]; P.mla_w_ukv = in[11]; P.mla_g_qn = in[12]; P.mla_g_qr = in[13];
    P.mla_g_kn = in[14]; P.mla_g_kr = in[15]; P.na_g_q = in[16]; P.na_g_k = in[17]; P.na_rpb = in[18]; P.ret_g_out = in[19];
    P.hg_lb_raw = in[20]; P.hg_g_out = in[21]; P.moe_w_rg = in[22]; P.moe_b_rg = in[23]; P.moe_w_re = in[24]; P.moe_b_re = in[25];
    P.moe_w1 = in[26]; P.moe_w3 = in[27]; P.moe_w2 = in[28];
    P.out = (float*)d_out;
}

#ifndef CPU_EMU
extern "C" void kernel_launch(void* const* d_in, const int* in_sizes, int n_in, void* d_out, int out_size, void* d_ws, size_t ws_size, hipStream_t stream) {
    Params P{};
    fill_inputs(P, d_in, d_out);
    carve_ws(P, d_ws);
    constexpr size_t kDynLds = SMEM_BYTES + 16;
    static int grid = 0;
    if (!grid) {
        int dev = 0, cus = 0, per_cu = 0;
        (void)hipGetDevice(&dev);
        (void)hipDeviceGetAttribute(&cus, hipDeviceAttributeMultiprocessorCount, dev);
        #if MK_MULTI
        (void)hipOccupancyMaxActiveBlocksPerMultiprocessor(&per_cu, k_phase<5>, NTHREADS, kDynLds);
#else
        (void)hipFuncSetAttribute((const void*)k_mega, hipFuncAttributeMaxDynamicSharedMemorySize, (int)kDynLds);
        (void)hipOccupancyMaxActiveBlocksPerMultiprocessor(&per_cu, k_mega, NTHREADS, kDynLds);
#endif
        if (per_cu < 1) per_cu = 1;
        grid = cus * (per_cu < 2 ? per_cu : 2);
    }
#if MK_MULTI
    k_phase<0><<<grid, NTHREADS, kDynLds, stream>>>(P, 0);
    k_phase<1><<<grid, NTHREADS, kDynLds, stream>>>(P, 0);
    for (int l = 0; l < NL; ++l) {
        k_phase<2><<<grid, NTHREADS, kDynLds, stream>>>(P, l);
        k_phase<3><<<grid, NTHREADS, kDynLds, stream>>>(P, l);
        k_phase<4><<<grid, NTHREADS, kDynLds, stream>>>(P, l);
        k_phase<5><<<grid, NTHREADS, kDynLds, stream>>>(P, l);
        k_phase<6><<<grid, NTHREADS, kDynLds, stream>>>(P, l);
        k_phase<7><<<grid, NTHREADS, kDynLds, stream>>>(P, l);
        k_phase<8><<<grid, NTHREADS, kDynLds, stream>>>(P, l);
        k_phase<9><<<grid, NTHREADS, kDynLds, stream>>>(P, l);
        k_phase<10><<<grid, NTHREADS, kDynLds, stream>>>(P, l);
    }
#else
    (void)hipMemsetAsync(P.bar, 0, XCD_BAR_WORDS * sizeof(unsigned), stream);
    k_mega<<<grid, NTHREADS, kDynLds, stream>>>(P);
#endif
}
#endif
```

```cpp
#ifndef CPU_EMU
#include <hip/hip_runtime.h>
#endif
#include <stdint.h>
#include <stddef.h>

#ifndef PROBE
#define PROBE 0
#endif
#ifndef WPROBE
#define WPROBE 0
#endif
#ifndef CFG_B
#define CFG_B 8
#define CFG_SEQ 4096
#define CFG_L 4
#define CFG_CTX 256
#endif

typedef _Float16 half_t;
typedef _Float16 half8 __attribute__((ext_vector_type(8)));
typedef _Float16 half4 __attribute__((ext_vector_type(4)));
typedef short s16x4 __attribute__((ext_vector_type(4)));
typedef float f32x4 __attribute__((ext_vector_type(4)));
typedef float f32x16 __attribute__((ext_vector_type(16)));

#ifdef CPU_EMU
#define DEV inline
#define SYNC() emu::block_sync()
#define WAVE_BARRIER() emu::wave_sync()
#define SCHED_FENCE() do {} while (0)
#define WAIT_VM(n) do {} while (0)
#define RAW_BARRIER() emu::block_sync()
inline void glds16(const void* g, void* lds_wave_base) { memcpy((unsigned char*)lds_wave_base + (threadIdx.x & 63) * 16, g, 16); }
inline int WID(int tid) { return tid >> 6; }
DEV f32x4 mfma16(half8 a, half8 b, f32x4 c) { return emu::mfma_16x16x32<half8, f32x4>(a, b, c); }
DEV f32x16 mfma32(half8 a, half8 b, f32x16 c) { return emu::mfma_32x32x16<half8, f32x16>(a, b, c); }
DEV f32x4 mfmaf(float a, float b, f32x4 c) { return emu::mfma_16x16x4_f32<f32x4>(a, b, c); }
DEV half4 tr16(const half_t* p) { return emu::ds_read_tr16<half4>((const void*)p); }
template <int OFF> DEV half4 tr16_nowait(const half_t* p) { return emu::ds_read_tr16<half4>((const void*)((const unsigned char*)p + OFF)); }
#define TR_WAIT() do {} while (0)
DEV float shfl_xor_f(float v, int m) { return emu::shfl_xor<float>(v, m); }
DEV float shfl_f(float v, int src) { return emu::shfl<float>(v, src); }
DEV int atomic_add_i(int* p, int v) { return __atomic_fetch_add(p, v, __ATOMIC_RELAXED); }
DEV bool wave_any(bool p) { float f = p ? 1.f : 0.f; for (int m = 1; m < 64; m <<= 1) f = fmaxf(f, emu::shfl_xor<float>(f, m)); return f > 0.f; }
DEV float fexp2(float x) { return exp2f(x); }
DEV float fexp(float x) { return expf(x); }
DEV float flog(float x) { return logf(x); }
DEV float frsqrt(float x) { return 1.0f / sqrtf(x); }
DEV float frcp(float x) { return 1.0f / x; }
#else
#define DEV __device__ __forceinline__
#define SYNC() __syncthreads()
#define WAVE_BARRIER() __builtin_amdgcn_wave_barrier()
#define SCHED_FENCE() __builtin_amdgcn_sched_barrier(0)
#define WAIT_VM(n) asm volatile("s_waitcnt vmcnt(" #n ")" ::: "memory")
#define RAW_BARRIER() __builtin_amdgcn_s_barrier()
__device__ __forceinline__ void glds16(const void* g, void* lds_wave_base) {
    __builtin_amdgcn_global_load_lds((const __attribute__((address_space(1))) void*)g, (__attribute__((address_space(3))) void*)lds_wave_base, 16, 0, 0);
}
__device__ __forceinline__ int WID(int tid) { return __builtin_amdgcn_readfirstlane(tid >> 6); }
#define LDSP __attribute__((address_space(3)))
DEV f32x4 mfma16(half8 a, half8 b, f32x4 c) { return __builtin_amdgcn_mfma_f32_16x16x32_f16(a, b, c, 0, 0, 0); }
DEV f32x16 mfma32(half8 a, half8 b, f32x16 c) { return __builtin_amdgcn_mfma_f32_32x32x16_f16(a, b, c, 0, 0, 0); }
DEV f32x4 mfmaf(float a, float b, f32x4 c) { return __builtin_amdgcn_mfma_f32_16x16x4f32(a, b, c, 0, 0, 0); }
DEV half4 tr16(const half_t* p) { s16x4 t = __builtin_amdgcn_ds_read_tr16_b64_v4i16((LDSP s16x4*)p); return __builtin_bit_cast(half4, t); }
template <int OFF> DEV half4 tr16_nowait(const half_t* p) { s16x4 t; const unsigned a = (unsigned)(size_t)(LDSP const half_t*)p; asm volatile("ds_read_b64_tr_b16 %0, %1 offset:%2" : "=v"(t) : "v"(a), "i"(OFF) : "memory"); return __builtin_bit_cast(half4, t); }
#define TR_WAIT() do { asm volatile("s_waitcnt lgkmcnt(0)" ::: "memory"); __builtin_amdgcn_sched_barrier(0); } while (0)
DEV float shfl_xor_f(float v, int m) { return __shfl_xor(v, m, 64); }
DEV float shfl_f(float v, int src) { return __shfl(v, src, 64); }
DEV int atomic_add_i(int* p, int v) { return atomicAdd(p, v); }
DEV bool wave_any(bool p) { return __any(p) != 0; }
DEV float fexp2(float x) { return __builtin_amdgcn_exp2f(x); }
DEV float fexp(float x) { return __expf(x); }
DEV float flog(float x) { return __logf(x); }
DEV float frsqrt(float x) { return __builtin_amdgcn_rsqf(x); }
DEV float frcp(float x) { return __builtin_amdgcn_rcpf(x); }
#endif

#ifdef CPU_EMU
DEV float opaque0() { return 0.f; }
DEV int TID() { return (int)threadIdx.x; }
#else
DEV int TID() { int t = (int)threadIdx.x; asm volatile("" : "+v"(t)); return t; }
DEV float opaque0() { float z = 0.f; asm volatile("" : "+v"(z)); return z; }
#endif
constexpr int B_ = CFG_B, SEQ = CFG_SEQ, NL = CFG_L, CTX = CFG_CTX, D = 1024;
constexpr int NLAT = B_ * SEQ, NCTX = B_ * CTX, NT = NLAT + NCTX;
constexpr int ROWS = SEQ / 64;
constexpr int KEYS = SEQ + CTX;
constexpr int PTOT = 3424, PPAD = 3456;
constexpr int O_CQ = 0, O_CKV = 192, O_KR = 320, O_NAQ = 352, O_NAK = 608, O_NAV = 864, O_RQ = 1120, O_RK = 1376, O_RV = 1632, O_RG = 1888,
              O_HQ = 2144, O_HF = 2400, O_HB = 2656, O_HI = 2912, O_HG = 3168;
constexpr int NCH = KEYS / 64, CG = CTX / 64, LG = SEQ / 64;
constexpr int NEXP = 32, ACT_ROWS = 2 * NT + NEXP * 256;
constexpr float EPS = 1e-6f;
constexpr float LOG2E = 1.4426950408889634f;
constexpr int MODW = 6 * D;
constexpr int NTHREADS = 256;
constexpr int SMEM_BYTES = 74240;

struct Params {
    const float *x, *c, *ctx, *c_ctx, *w_ada, *b_ada, *w_in, *w_out, *mla_g_cq, *mla_g_ckv, *mla_w_uq, *mla_w_ukv, *mla_g_qn, *mla_g_qr, *mla_g_kn,
        *mla_g_kr, *na_g_q, *na_g_k, *na_rpb, *ret_g_out, *hg_lb_raw, *hg_g_out, *moe_w_rg, *moe_b_rg, *moe_w_re, *moe_b_re, *moe_w1, *moe_w3, *moe_w2;
    float* out;
    unsigned* bar;
    float *xc, *mod, *hglb, *wr, *cshift, *list_gate, *gst, *gdec, *rope;
    int *cnt, *list_tok, *tokslot, *sched;
    half_t *win16, *wout16, *wuq16, *wukv16, *h, *p, *y, *qraw, *kvraw, *mq, *mk, *mv, *nq, *nk, *nv, *act, *yrows, *w13h, *w2h;
};

#ifdef CPU_EMU
typedef const Params CP;
#else
typedef const __attribute__((address_space(4))) Params CP;
#endif
DEV int tok_brow(int t) { return t < NLAT ? t / SEQ : B_; }
DEV float* xrow_ptr(CP& P, int t) { return t < NLAT ? P.out + (size_t)t * D : P.xc + (size_t)(t - NLAT) * D; }
DEV float silu_f(float x) { return x * frcp(1.0f + fexp(-x)); }
DEV float sigmoid_f(float x) { return frcp(1.0f + fexp(-x)); }
DEV float wave_sum(float v) {
    v += shfl_xor_f(v, 1); v += shfl_xor_f(v, 2); v += shfl_xor_f(v, 4); v += shfl_xor_f(v, 8); v += shfl_xor_f(v, 16); v += shfl_xor_f(v, 32);
    return v;
}
DEV half4 to_half4(f32x4 v) { half4 r; r[0] = (half_t)v[0]; r[1] = (half_t)v[1]; r[2] = (half_t)v[2]; r[3] = (half_t)v[3]; return r; }

constexpr int LDB_S = 136, G_BBUF = 32 * LDB_S;
struct BSrcH {
    const half_t* base; int ld;
    typedef half8 Raw;
    DEV Raw load(int k, int n) const { return *(const half8*)(base + (size_t)k * ld + n); }
    DEV half8 cvt(const Raw& r) const { return r; }
};
struct RawF { f32x4 a, b; };
DEV half8 cvt_rawf(const RawF& r) {
    half8 h; h[0] = (half_t)r.a[0]; h[1] = (half_t)r.a[1]; h[2] = (half_t)r.a[2]; h[3] = (half_t)r.a[3];
    h[4] = (half_t)r.b[0]; h[5] = (half_t)r.b[1]; h[6] = (half_t)r.b[2]; h[7] = (half_t)r.b[3]; return h;
}
struct BSrcF {
    const float* base; int ld;
    typedef RawF Raw;
    DEV Raw load(int k, int n) const { const float* s = base + (size_t)k * ld + n; RawF r; r.a = *(const f32x4*)s; r.b = *(const f32x4*)(s + 4); return r; }
    DEV half8 cvt(const Raw& r) const { return cvt_rawf(r); }
};
struct BSrcF2 {
    const float* b0; ptrdiff_t d10; int ld;
    typedef RawF Raw;
    DEV Raw load(int k, int n) const { const float* s = b0 + (ptrdiff_t)(n >> 6) * d10 + (n & 63) + (size_t)k * ld; RawF r; r.a = *(const f32x4*)s; r.b = *(const f32x4*)(s + 4); return r; }
    DEV half8 cvt(const Raw& r) const { return cvt_rawf(r); }
};
DEV int swzB(int k, int ch) { return k * LDB_S + (ch << 3); }
constexpr int GS_B = 32 * 128;
DEV int fswzB(int k) { return 2 * ((k & 3) | (((k >> 3) & 1) << 2)); }
#define GEMM_ISSUE(ST, KT)                                                                                                   \
    {                                                                                                                        \
        half_t* sa_ = ring + (ST) * GS_STAGE + (16 * MT * w) * 32;                                                           \
        half_t* sb_ = ring + (ST) * GS_STAGE + GS_A + (8 * w) * 128;                                                          \
        _Pragma("unroll") for (int j = 0; j < MT; ++j) glds16(asrc[j] + (KT) * 32, sa_ + 16 * j * 32);                       \
        _Pragma("unroll") for (int j = 0; j < 2; ++j) glds16(bsrc[j] + (size_t)(KT) * 32 * ldb, sb_ + 4 * j * 128);          \
    }
#define GEMM_COMPUTE(ST)                                                                                                     \
    {                                                                                                                        \
        const half_t* sa_ = ring + (ST) * GS_STAGE; const half_t* sb_ = sa_ + GS_A;                                          \
        half8 af[MT];                                                                                                        \
        _Pragma("unroll") for (int mt = 0; mt < MT; ++mt) af[mt] = *(const half8*)(sa_ + aoff + mt * 16 * 32);               \
        _Pragma("unroll") for (int nh = 0; nh < 2; ++nh) {                                                                   \
            half8 bf[4];                                                                                                     \
            _Pragma("unroll") for (int n4 = 0; n4 < 4; ++n4) {                                                               \
                const half_t* ba = sb_ + bk0 * 128 + (((2 * (4 * nh + n4) + (pp >> 1)) ^ bfz) << 3) + 4 * (pp & 1);          \
                const half4 lo = tr16_nowait<0>(ba), hi = tr16_nowait<1024>(ba);                                             \
                bf[n4][0] = lo[0]; bf[n4][1] = lo[1]; bf[n4][2] = lo[2]; bf[n4][3] = lo[3]; bf[n4][4] = hi[0]; bf[n4][5] = hi[1]; bf[n4][6] = hi[2]; bf[n4][7] = hi[3]; \
            }                                                                                                                \
            TR_WAIT();                                                                                                       \
            _Pragma("unroll") for (int n4 = 0; n4 < 4; ++n4)                                                                 \
                _Pragma("unroll") for (int mt = 0; mt < MT; ++mt) acc[mt][4 * nh + n4] = mfma16(bf[n4], af[mt], acc[mt][4 * nh + n4]); \
        }                                                                                                                    \
    }
#define GEMM_STEP(ST, ST2, itv)                                                                                              \
    {                                                                                                                        \
        const int it_ = (itv);                                                                                               \
        if (it_ + 1 < nk) { if (MT == 4) { WAIT_VM(6); } else if (MT == 2) { WAIT_VM(4); } else { WAIT_VM(3); } } else { WAIT_VM(0); } \
        RAW_BARRIER();                                                                                                       \
        if (it_ + 2 < nk) GEMM_ISSUE(ST2, it_ + 2)                                                                           \
        GEMM_COMPUTE(ST)                                                                                                     \
    }
template <int MT, class ARow, class BS, class Epi>
DEV void gemm_tile(const ARow& arow, const BS& bs, int K, Epi& epi, unsigned char* smem) {
    constexpr int GS_A = 64 * MT * 32, GS_STAGE = GS_A + GS_B;
    half_t* ring = (half_t*)smem;
    const int tid = TID(), lane = tid & 63, w = WID(tid), g = lane >> 4, li = lane & 15;
    const int q = li >> 2, pp = li & 3;
    const int nk = K >> 5;
    const int ldb = bs.ld;
    const half_t* asrc[MT];
#pragma unroll
    for (int j = 0; j < MT; ++j) asrc[j] = arow(16 * MT * w + 16 * j + (lane >> 2)) + 8 * ((lane & 3) ^ (lane >> 4));
    const half_t* bsrc[2];
#pragma unroll
    for (int j = 0; j < 2; ++j) { const int k = 8 * w + 4 * j + (lane >> 4); bsrc[j] = bs.base + (size_t)k * ldb + 8 * ((lane & 15) ^ fswzB(k)); }
    const int aoff = (16 * MT * w + li) * 32 + ((g ^ (li >> 2)) << 3);
    const int bk0 = 8 * g + q, bfz = fswzB(bk0);
    f32x4 acc[MT][8];
#pragma unroll
    for (int mt = 0; mt < MT; ++mt)
#pragma unroll
        for (int nt = 0; nt < 8; ++nt) acc[mt][nt] = (f32x4){0.f, 0.f, 0.f, 0.f};
    SYNC();
    GEMM_ISSUE(0, 0)
    GEMM_ISSUE(1, 1)
#pragma clang loop unroll(disable)
    for (int it = 0; it < nk; it += 3) {
        GEMM_STEP(0, 2, it)
        if (it + 1 < nk) GEMM_STEP(1, 0, it + 1)
        if (it + 2 < nk) GEMM_STEP(2, 1, it + 2)
    }
    epi.template run<MT>(acc, w, g, li);
}
template <class ARow, class BS, class Epi>
DEV void gemm256(const ARow& arow, const BS& bs, int K, Epi& epi, unsigned char* smem) { gemm_tile<4>(arow, bs, K, epi, smem); }
struct ARowLin { const half_t* base; int ld; DEV const half_t* operator()(int r) const { return base + (size_t)r * ld; } };
struct ARowGather { const half_t* base; int ld; const int* idx; int nvalid; DEV const half_t* operator()(int r) const { const int t = r < nvalid ? idx[r] : 0; return base + (size_t)t * ld; } };

struct EpiStoreH {
    half_t* out; int ld;
    template <int MT> DEV void run(const f32x4 (&acc)[MT][8], int w, int g, int li) const {
#pragma unroll
        for (int mt = 0; mt < MT; ++mt)
#pragma unroll
            for (int nt = 0; nt < 8; ++nt) *(half4*)(out + (size_t)(16 * MT * w + 16 * mt + li) * ld + 16 * nt + 4 * g) = to_half4(acc[mt][nt]);
    }
};
struct EpiResid {
    float* x; const float* gate;
    template <int MT> DEV void run(const f32x4 (&acc)[MT][8], int w, int g, int li) const {
#pragma unroll
        for (int nh = 0; nh < 2; ++nh) {
            f32x4 gt[4];
#pragma unroll
            for (int n4 = 0; n4 < 4; ++n4) gt[n4] = *(const f32x4*)(gate + 16 * (4 * nh + n4) + 4 * g);
#pragma unroll
            for (int mt = 0; mt < MT; ++mt) {
                f32x4 xv[4];
                float* xr = x + (size_t)(16 * MT * w + 16 * mt + li) * D + 64 * nh + 4 * g;
#pragma unroll
                for (int n4 = 0; n4 < 4; ++n4) xv[n4] = *(const f32x4*)(xr + 16 * n4);
                SCHED_FENCE();
#pragma unroll
                for (int n4 = 0; n4 < 4; ++n4) *(f32x4*)(xr + 16 * n4) = xv[n4] + gt[n4] * acc[mt][4 * nh + n4];
            }
        }
    }
};
struct EpiGlu {
    half_t* out; int ld;
    template <int MT> DEV void run(const f32x4 (&acc)[MT][8], int w, int g, int li) const {
#pragma unroll
        for (int mt = 0; mt < MT; ++mt)
#pragma unroll
            for (int nt = 0; nt < 4; ++nt) {
                f32x4 o;
#pragma unroll
                for (int r = 0; r < 4; ++r) o[r] = silu_f(acc[mt][nt][r]) * acc[mt][nt + 4][r];
                *(half4*)(out + (size_t)(16 * MT * w + 16 * mt + li) * ld + 16 * nt + 4 * g) = to_half4(o);
            }
    }
};
struct EpiRowsGate {
    half_t* out; const float* gate; int nvalid;
    template <int MT> DEV void run(const f32x4 (&acc)[MT][8], int w, int g, int li) const {
#pragma unroll
        for (int mt = 0; mt < MT; ++mt) {
            const int row = 16 * MT * w + 16 * mt + li;
            if (row < nvalid) {
                const float gt = gate[row];
#pragma unroll
                for (int nt = 0; nt < 8; ++nt) *(half4*)(out + (size_t)row * D + 16 * nt + 4 * g) = to_half4(acc[mt][nt] * gt);
            }
        }
    }
};

DEV void phase_prologue_a(CP& P, unsigned char* smem) {
    const int tid = TID(), gtid = blockIdx.x * NTHREADS + tid, gsz = gridDim.x * NTHREADS;
    for (size_t i = gtid; i < (size_t)NL * D * (PPAD / 8); i += gsz) {
        const int cc = (int)(i % (PPAD / 8)) * 8; const size_t rk = i / (PPAD / 8);
        half8 h;
#pragma unroll
        for (int j = 0; j < 8; ++j) h[j] = (cc + j < PTOT) ? (half_t)P.w_in[rk * PTOT + cc + j] : (half_t)0.f;
        *(half8*)(P.win16 + rk * PPAD + cc) = h;
    }
    for (size_t i = gtid; i < (size_t)NL * D * D / 8; i += gsz) {
        const f32x4 a = *(const f32x4*)(P.w_out + i * 8), b = *(const f32x4*)(P.w_out + i * 8 + 4);
        RawF r; r.a = a; r.b = b; *(half8*)(P.wout16 + i * 8) = cvt_rawf(r);
    }
    for (int i = gtid; i < NL * 192 * 384; i += gsz) { const int l = i / (192 * 384), k = (i / 384) % 192; P.wuq16[i] = (half_t)(P.mla_g_cq[l * 192 + k] * P.mla_w_uq[i]); }
    for (int i = gtid; i < NL * 128 * 512; i += gsz) { const int l = i / (128 * 512), k = (i / 512) % 128; P.wukv16[i] = (half_t)(P.mla_g_ckv[l * 128 + k] * P.mla_w_ukv[i]); }
    for (int i = gtid; i < 256; i += gsz) {
        float mx = -1e30f; for (int l = 0; l < NL; ++l) mx = fmaxf(mx, P.hg_lb_raw[l * 256 + i]);
        float den = 0.f; for (int l = 0; l < NL; ++l) den += fexp(P.hg_lb_raw[l * 256 + i] - mx);
        float cum = 0.f;
        for (int l = 0; l < NL; ++l) { const float wv = fexp(P.hg_lb_raw[l * 256 + i] - mx) / den; if (l > 0) cum += wv; P.hglb[l * 256 + i] = cum; }
    }
    for (int i = gtid; i < NL * D * 48; i += gsz) {
        const int n = i % 48, lk = i / 48;
        P.wr[i] = n < 4 ? P.moe_w_rg[lk * 4 + n] : (n < 36 ? P.moe_w_re[lk * 32 + (n - 4)] : 0.f);
    }
    for (int i = gtid; i < NL * NEXP; i += gsz) P.cnt[i] = 0;
    for (int i = gtid; i < NL * 16; i += gsz) P.sched[i] = 0;
    for (int i = gtid; i < SEQ * 16; i += gsz) {
        const int n = i >> 4, j = i & 15, ax = j >> 3, fi = j & 7;
        const float ang = (float)(ax == 0 ? n / 64 : n % 64) * fexp(-9.210340371976184f * (float)fi * 0.125f);
        P.rope[n * 32 + j] = cosf(ang); P.rope[n * 32 + 16 + j] = sinf(ang);
    }
    float* sc = (float*)smem;
    SYNC();
    for (int i = tid; i < (B_ + 1) * D; i += NTHREADS) { const int r = i / D, k = i % D; const float v = r < B_ ? P.c[r * D + k] : P.c_ctx[k]; sc[i] = silu_f(v); }
    SYNC();
    for (int item = blockIdx.x; item < NL * (MODW / 256); item += gridDim.x) {
        const int l = item / (MODW / 256), n = (item % (MODW / 256)) * 256 + tid;
        float acc[B_ + 1];
#pragma unroll
        for (int r = 0; r <= B_; ++r) acc[r] = 0.f;
        const float* wp = P.w_ada + (size_t)l * D * MODW + n;
        for (int k = 0; k < D; ++k) {
            const float wv = wp[(size_t)k * MODW];
#pragma unroll
            for (int r = 0; r <= B_; ++r) acc[r] += sc[r * D + k] * wv;
        }
        const float bv = P.b_ada[l * MODW + n];
#pragma unroll
        for (int r = 0; r <= B_; ++r) P.mod[((size_t)l * (B_ + 1) + r) * MODW + n] = acc[r] + bv;
    }
}

DEV void row_modulate_store(const f32x4 (&v)[4], const float* sh, const float* sc, half_t* hrow, int lane) {
    f32x4 s4[4], h4[4];
#pragma unroll
    for (int j = 0; j < 4; ++j) { s4[j] = *(const f32x4*)(sc + 256 * j + 4 * lane); h4[j] = *(const f32x4*)(sh + 256 * j + 4 * lane); }
    float ss = 0.f;
#pragma unroll
    for (int j = 0; j < 4; ++j) ss += v[j][0] * v[j][0] + v[j][1] * v[j][1] + v[j][2] * v[j][2] + v[j][3] * v[j][3];
    ss = wave_sum(ss);
    const float rstd = frsqrt(ss * (1.0f / D) + EPS);
#pragma unroll
    for (int j = 0; j < 4; ++j) {
        f32x4 o;
#pragma unroll
        for (int e = 0; e < 4; ++e) o[e] = v[j][e] * rstd * (1.0f + s4[j][e]) + h4[j][e];
        *(half4*)(hrow + 256 * j + 4 * lane) = to_half4(o);
    }
}
DEV void phase_prologue_b(CP& P) {
    const int lane = TID() & 63, gw = blockIdx.x * 4 + (TID() >> 6), nw = gridDim.x * 4;
    for (int t = gw; t < NT; t += nw) {
        const float* src = t < NLAT ? P.x + (size_t)t * D : P.ctx + (size_t)(t - NLAT) * D;
        float* dst = xrow_ptr(P, t);
        f32x4 v[4];
#pragma unroll
        for (int j = 0; j < 4; ++j) { v[j] = *(const f32x4*)(src + 256 * j + 4 * lane); *(f32x4*)(dst + 256 * j + 4 * lane) = v[j]; }
        const float* md = P.mod + (size_t)tok_brow(t) * MODW;
        row_modulate_store(v, md + 0, md + D, P.h + (size_t)t * D, lane);
    }
    for (int it = gw; it < NL * (B_ + 1) * 36; it += nw) {
        const int n = it % 36, lr = it / 36, l = lr / (B_ + 1);
        const float* sh = P.mod + (size_t)lr * MODW + 3 * D;
        float s = 0.f;
        for (int k = lane; k < D; k += 64) s += sh[k] * P.wr[((size_t)l * D + k) * 48 + n];
        s = wave_sum(s);
        if (lane == 0) P.cshift[lr * 48 + n] = s + (n < 4 ? P.moe_b_rg[l * 4 + n] : P.moe_b_re[l * 32 + n - 4]);
    }
}

DEV bool gemm_tile_idx(int idx, int ntm, int ntn, int& tm, int& tn) {
    if (idx >= ntm * ntn) return false;
    const int nig = 4 * ntn, gid = idx / nig, fm = gid * 4, gsz = (ntm - fm) < 4 ? (ntm - fm) : 4, rem = idx - gid * nig;
    tm = fm + rem % gsz; tn = rem / gsz; return true;
}
DEV bool gemm_tile_order(int round, int ntm, int ntn, int& tm, int& tn) {
    const int per = gridDim.x >> 3;
    const int idx = ((round << 3) + (blockIdx.x & 7)) * per + (blockIdx.x >> 3);
    if (idx >= ntm * ntn) return false;
    const int nig = 4 * ntn, gid = idx / nig, fm = gid * 4, gsz = (ntm - fm) < 4 ? (ntm - fm) : 4, rem = idx - gid * nig;
    tm = fm + rem % gsz; tn = rem / gsz; return true;
}
DEV void phase_inproj(CP& P, int l, unsigned char* smem) {
    constexpr int NTN = PPAD / 128, NTM = NT / 256;
    const int full = (NTM * NTN) / gridDim.x;
    for (int rep = 0; rep < ((PROBE & 1) ? 2 : 1); ++rep) {
        for (int round = 0; round < full; ++round) {
            int tm, tn;
            if (!gemm_tile_order(round, NTM, NTN, tm, tn)) continue;
            ARowLin ar{P.h + (size_t)tm * 256 * D, D};
            BSrcH bs{P.win16 + (size_t)l * D * PPAD + tn * 128, PPAD};
            EpiStoreH epi{P.p + (size_t)tm * 256 * PPAD + tn * 128, PPAD};
            gemm_tile<4>(ar, bs, D, epi, smem);
        }
        const int base = full * gridDim.x, left = NTM * NTN - base;
        for (int i = blockIdx.x; i < 4 * left; i += gridDim.x) {
            int tm, tn; gemm_tile_idx(base + (i >> 2), NTM, NTN, tm, tn);
            const size_t r0 = (size_t)tm * 256 + 64 * (i & 3);
            ARowLin ar{P.h + r0 * D, D};
            BSrcH bs{P.win16 + (size_t)l * D * PPAD + tn * 128, PPAD};
            EpiStoreH epi{P.p + r0 * PPAD + tn * 128, PPAD};
            gemm_tile<1>(ar, bs, D, epi, smem);
        }
    }
}

constexpr int GQ_LD = 68, GH_LD = 72, GS_LD = 24;
constexpr int G_QF = 0, G_KF = 17408, G_KH = 34816, G_VH = 44032, G_SC = 53248, G_DK = 56320, G_RED = 57344;
DEV float ret_loggamma(int h, int dir) { return log1pf(-exp2f(-5.0f - (float)(2 * h + dir))); }
template <int MIX, bool OUT, int dir>
DEV void gla_stage(CP& P, int l, int h, int tok0, float lgam, float& totsum, unsigned char* smem) {
    float* Qf = (float*)(smem + G_QF); float* Kf = (float*)(smem + G_KF); half_t* Kh = (half_t*)(smem + G_KH); half_t* Vh = (half_t*)(smem + G_VH);
    float* dk = (float*)(smem + G_DK);
    const int tid = TID(), d = tid & 63, I = tid >> 6;
    const half_t* pr = P.p + (size_t)(tok0 + 16 * I) * PPAD + h * 64 + d;
    float lf[16], kk[16], qq[16];
    half_t vv[16], rq[16], rk[16];
    float lb = 0.f;
    if (MIX == 1) lb = P.hglb[l * 256 + h * 64 + d];
#pragma unroll
    for (int i = 0; i < 16; ++i) {
        const half_t* pi = pr + (size_t)i * PPAD;
        if (MIX == 0) { rq[i] = OUT ? pi[O_RQ] : (half_t)0.f; rk[i] = pi[O_RK]; vv[i] = pi[O_RV]; }
        else { rq[i] = OUT ? pi[O_HQ] : (half_t)0.f; rk[i] = pi[dir ? O_HB : O_HF]; vv[i] = pi[O_HI]; }
    }
    SCHED_FENCE();
    float tot = 0.f;
#pragma unroll
    for (int i = 0; i < 16; ++i) {
        if (MIX == 0) {
            qq[i] = (float)rq[i]; kk[i] = (float)rk[i] * 0.125f; lf[i] = lgam;
        } else {
            qq[i] = OUT ? silu_f((float)rq[i]) : 0.f;
            const float sg = sigmoid_f((float)rk[i]), f = lb + (1.0f - lb) * sg;
            lf[i] = flog(fmaxf(f, 1e-20f)); kk[i] = (1.0f - lb) * (1.0f - sg);
        }
        tot += lf[i];
    }
    float bc = 0.f;
#pragma unroll
    for (int ii = 0; ii < 16; ++ii) {
        const int i = dir == 0 ? ii : 15 - ii;
        bc += lf[i];
        const int o = (I * 16 + i);
        if (OUT) { Qf[o * GQ_LD + d] = qq[i] * fexp(bc); Kf[o * GQ_LD + d] = kk[i] * fexp(fminf(-bc, 80.0f)); }
        Kh[o * GH_LD + d] = (half_t)(kk[i] * fexp(tot - bc));
        Vh[o * GH_LD + d] = vv[i];
    }
    dk[I * 64 + d] = fexp(tot);
    totsum += tot;
}
DEV half8 tok_frag(const half_t* img, int col0, int lane) {
    const int g = lane >> 4, li = lane & 15, q = li >> 2, p = li & 3;
    const half_t* a = img + (8 * (g & 1) + q) * GH_LD + col0 + 4 * p;
    const half4 lo = tr16(a), hi = tr16(a + 4 * GH_LD);
    half8 r;
    const bool z = g >= 2;
    r[0] = z ? (half_t)0.f : lo[0]; r[1] = z ? (half_t)0.f : lo[1]; r[2] = z ? (half_t)0.f : lo[2]; r[3] = z ? (half_t)0.f : lo[3];
    r[4] = z ? (half_t)0.f : hi[0]; r[5] = z ? (half_t)0.f : hi[1]; r[6] = z ? (half_t)0.f : hi[2]; r[7] = z ? (half_t)0.f : hi[3];
    return r;
}
DEV void gla_scores(int dir, unsigned char* smem) {
    const float* Qf = (const float*)(smem + G_QF); const float* Kf = (const float*)(smem + G_KF); half_t* sc = (half_t*)(smem + G_SC);
    const int tid = TID(), lane = tid & 63, w = tid >> 6, g = lane >> 4, li = lane & 15;
    f32x4 s0 = {0.f, 0.f, 0.f, 0.f}, s1 = {0.f, 0.f, 0.f, 0.f};
    const float* kp = Kf + (w * 16 + li) * GQ_LD + g; const float* qp = Qf + (w * 16 + li) * GQ_LD + g;
#pragma unroll
    for (int kk = 0; kk < 16; kk += 2) { s0 = mfmaf(kp[4 * kk], qp[4 * kk], s0); s1 = mfmaf(kp[4 * kk + 4], qp[4 * kk + 4], s1); }
    half4 o;
#pragma unroll
    for (int r = 0; r < 4; ++r) { const int sj = 4 * g + r; const bool keep = dir == 0 ? (sj <= li) : (sj >= li); o[r] = keep ? (half_t)(s0[r] + s1[r]) : (half_t)0.f; }
    *(half4*)(sc + (w * 16 + li) * GS_LD + 4 * g) = o;
}
template <bool OUT>
DEV void gla_main_sub(int I, f32x4 (&st)[4], f32x4& oacc, unsigned char* smem) {
    const float* Qf = (const float*)(smem + G_QF); const half_t* Kh = (const half_t*)(smem + G_KH); const half_t* Vh = (const half_t*)(smem + G_VH);
    const half_t* sc = (const half_t*)(smem + G_SC); const float* dk = (const float*)(smem + G_DK);
    const int tid = TID(), lane = tid & 63, w = tid >> 6, g = lane >> 4, li = lane & 15;
    const half8 vfr = tok_frag(Vh + I * 16 * GH_LD, 16 * w, lane);
    if (OUT) {
        const half8 sf = *(const half8*)(sc + (I * 16 + li) * GS_LD + 8 * (g & 1));
        oacc = mfma16(vfr, sf, oacc);
#pragma unroll
        for (int ks = 0; ks < 2; ++ks) {
            half8 sa, qb;
            const f32x4 q0 = *(const f32x4*)(Qf + (I * 16 + li) * GQ_LD + 32 * ks + 4 * g), q1 = *(const f32x4*)(Qf + (I * 16 + li) * GQ_LD + 32 * ks + 16 + 4 * g);
#pragma unroll
            for (int j = 0; j < 4; ++j) { sa[j] = (half_t)st[2 * ks][j]; sa[4 + j] = (half_t)st[2 * ks + 1][j]; qb[j] = (half_t)q0[j]; qb[4 + j] = (half_t)q1[j]; }
            oacc = mfma16(sa, qb, oacc);
        }
    }
#pragma unroll
    for (int dt = 0; dt < 4; ++dt) {
        const f32x4 dv = *(const f32x4*)(dk + I * 64 + 16 * dt + 4 * g);
#pragma unroll
        for (int r = 0; r < 4; ++r) st[dt][r] *= dv[r];
        st[dt] = mfma16(tok_frag(Kh + I * 16 * GH_LD, 16 * dt, lane), vfr, st[dt]);
    }
}
DEV int gla_tok0(int b, int gidx) { return gidx < CG ? NLAT + b * CTX + 64 * gidx : b * SEQ + 64 * (gidx - CG); }
DEV int gla_chainpos(int gidx, int dir) { return dir == 0 ? gidx : (gidx < CG ? CG - 1 - gidx : CG + (LG - 1 - (gidx - CG))); }
DEV size_t gla_chain(int mix, int b, int h, int dir) { return (((size_t)mix * B_ + b) * 4 + h) * 2 + dir; }
template <int MIX>
DEV void gla_step_a(CP& P, int l, int b, int h, int dir, int gidx, unsigned char* smem) {
    const int tid = TID(), lane = tid & 63, w = tid >> 6, g = lane >> 4, li = lane & 15;
    f32x4 st[4]; f32x4 od = {0.f, 0.f, 0.f, 0.f};
#pragma unroll
    for (int dt = 0; dt < 4; ++dt) st[dt] = (f32x4){0.f, 0.f, 0.f, 0.f};
    float totsum = 0.f;
    const float lgam = MIX == 0 ? ret_loggamma(h, dir) : 0.f;
    if (dir == 0) gla_stage<MIX, false, 0>(P, l, h, gla_tok0(b, gidx), lgam, totsum, smem); else gla_stage<MIX, false, 1>(P, l, h, gla_tok0(b, gidx), lgam, totsum, smem);
    SYNC();
#pragma unroll
    for (int ii = 0; ii < 4; ++ii) gla_main_sub<false>(dir == 0 ? ii : 3 - ii, st, od, smem);
    const size_t slot = gla_chain(MIX, b, h, dir) * NCH + gla_chainpos(gidx, dir);
    float* dst = P.gst + slot * 4096;
#pragma unroll
    for (int dt = 0; dt < 4; ++dt)
#pragma unroll
        for (int r = 0; r < 4; ++r) dst[(16 * dt + 4 * g + r) * 64 + 16 * w + li] = st[dt][r];
    if (tid < 64) { const float* dk = (const float*)(smem + G_DK); P.gdec[slot * 64 + tid] = dk[tid] * dk[64 + tid] * dk[128 + tid] * dk[192 + tid]; }
    SYNC();
}
template <int MIX>
DEV void gla_step_c(CP& P, int l, int b, int h, int gidx, unsigned char* smem) {
    const int tid = TID(), lane = tid & 63, w = tid >> 6, g = lane >> 4, li = lane & 15;
    f32x4 oacc[4];
#pragma unroll
    for (int I = 0; I < 4; ++I) oacc[I] = (f32x4){0.f, 0.f, 0.f, 0.f};
    const int tok0 = gla_tok0(b, gidx);
    float totsum = 0.f;
#pragma unroll
    for (int dir = 0; dir < 2; ++dir) {
        const size_t slot = gla_chain(MIX, b, h, dir) * NCH + gla_chainpos(gidx, dir);
        const float* src = P.gst + slot * 4096;
        f32x4 st[4];
#pragma unroll
        for (int dt = 0; dt < 4; ++dt)
#pragma unroll
            for (int r = 0; r < 4; ++r) st[dt][r] = src[(16 * dt + 4 * g + r) * 64 + 16 * w + li];
        const float lgam = MIX == 0 ? ret_loggamma(h, dir) : 0.f;
        if (dir == 1) SYNC();
        if (dir == 0) gla_stage<MIX, true, 0>(P, l, h, tok0, lgam, totsum, smem); else gla_stage<MIX, true, 1>(P, l, h, tok0, lgam, totsum, smem);
        SYNC();
        gla_scores(dir, smem);
        SYNC();
#pragma unroll
        for (int ii = 0; ii < 4; ++ii) { const int I = dir == 0 ? ii : 3 - ii; gla_main_sub<true>(I, st, oacc[I], smem); }
    }
    float* red = (float*)(smem + G_RED);
#pragma unroll
    for (int I = 0; I < 4; ++I) {
        float ss = oacc[I][0] * oacc[I][0] + oacc[I][1] * oacc[I][1] + oacc[I][2] * oacc[I][2] + oacc[I][3] * oacc[I][3];
        ss += shfl_xor_f(ss, 16); ss += shfl_xor_f(ss, 32);
        if (g == 0) red[w * 64 + 16 * I + li] = ss;
    }
    SYNC();
    const float* gain = (MIX == 0 ? P.ret_g_out : P.hg_g_out) + l * 64;
    const int ycol = (MIX == 0 ? 512 : 768) + h * 64 + 16 * w + 4 * g, gcol = (MIX == 0 ? O_RG : O_HG) + h * 64 + 16 * w + 4 * g;
#pragma unroll
    for (int I = 0; I < 4; ++I) {
        const int ti = 16 * I + li, t = tok0 + ti;
        const float tot = red[ti] + red[64 + ti] + red[128 + ti] + red[192 + ti];
        const float rstd = frsqrt(tot * (1.0f / 64.0f) + EPS);
        const half4 gt = *(const half4*)(P.p + (size_t)t * PPAD + gcol);
        f32x4 o;
#pragma unroll
        for (int r = 0; r < 4; ++r) o[r] = oacc[I][r] * rstd * gain[16 * w + 4 * g + r] * silu_f((float)gt[r]);
        *(half4*)(P.y + (size_t)t * D + ycol) = to_half4(o);
    }
    SYNC();
}
DEV void gla_scan(CP& P, int item, float* gst, int chain_off) {
    const int chain = item >> 2, e4 = ((item & 3) << 8) + TID(), d = e4 >> 4;
    float* base = gst + (size_t)(chain - chain_off) * NCH * 4096 + 4 * e4;
    const float* dec = P.gdec + (size_t)chain * NCH * 64 + d;
    const float z0 = opaque0();
    f32x4 s = {z0, z0, z0, z0};
    static_assert(NCH % 17 == 0 || NCH % 4 == 0, "scan batch");
    constexpr int BT = (NCH % 17 == 0) ? 17 : 4;
    for (int pos = 0; pos < NCH; pos += BT) {
        f32x4 ds[BT]; float dc[BT];
#pragma unroll
        for (int j = 0; j < BT; ++j) { ds[j] = *(const f32x4*)(base + (size_t)(pos + j) * 4096); dc[j] = dec[(pos + j) * 64]; }
#pragma unroll
        for (int j = 0; j < BT; ++j) { *(f32x4*)(base + (size_t)(pos + j) * 4096) = s; s = s * dc[j] + ds[j]; }
    }
}

DEV void up_glaa_item(CP& P, int l, int item, unsigned char* smem) {
    constexpr int NTM = NT / 256, NQ = NTM * 3, NKV = NTM * 4;
    if (item < NQ + NKV) {
        const bool isq = item < NQ;
        const int it = isq ? item : item - NQ, nn = isq ? 3 : 4, tm = it / nn, tn = it % nn;
        const int ldo = isq ? 384 : 512, kk = isq ? 192 : 128;
        ARowLin ar{P.p + (size_t)tm * 256 * PPAD + (isq ? O_CQ : O_CKV), PPAD};
        BSrcH bs{(isq ? P.wuq16 + (size_t)l * 192 * 384 : P.wukv16 + (size_t)l * 128 * 512) + tn * 128, ldo};
        EpiStoreH epi{(isq ? P.qraw : P.kvraw) + (size_t)tm * 256 * ldo + tn * 128, ldo};
        gemm256(ar, bs, kk, epi, smem);
    } else {
        int it = item - NQ - NKV;
        const int gidx = it % NCH; it /= NCH; const int dir = it & 1; it >>= 1; const int h = it & 3; it >>= 2; const int b = it % B_; const int mix = it / B_;
        SYNC();
        if (mix == 0) gla_step_a<0>(P, l, b, h, dir, gidx, smem); else gla_step_a<1>(P, l, b, h, dir, gidx, smem);
    }
}
DEV void phase_up_glaa(CP& P, int l, unsigned char* smem) {
    constexpr int NTM = NT / 256, NQ = NTM * 3, NKV = NTM * 4, NGA = 2 * B_ * 4 * 2 * NCH;
    for (int item = blockIdx.x; item < NQ + NKV + NGA; item += gridDim.x) up_glaa_item(P, l, item, smem);
    if (PROBE & 2) for (int item = blockIdx.x; item < NQ + NKV; item += gridDim.x) up_glaa_item(P, l, item, smem);
    if (PROBE & 4) for (int item = blockIdx.x; item < NGA; item += gridDim.x) up_glaa_item(P, l, NQ + NKV + item, smem);
}

DEV float sumsq8(half8 v) { float s = 0.f;
#pragma unroll
    for (int j = 0; j < 8; ++j) s += (float)v[j] * (float)v[j];
    return s; }
DEV void rope32(const half8 (&in)[4], float pre, const float* gain, const float* cs_tab, bool rot, float post, half8 (&out)[4]) {
    float v[32]; float ss = 0.f;
#pragma unroll
    for (int j = 0; j < 32; ++j) { v[j] = (float)in[j >> 3][j & 7] * pre; ss += v[j] * v[j]; }
    const float r = frsqrt(ss * (1.0f / 32.0f) + EPS);
#pragma unroll
    for (int j = 0; j < 32; ++j) v[j] = v[j] * r * gain[j];
#pragma unroll
    for (int ax = 0; ax < 2; ++ax)
#pragma unroll
        for (int i = 0; i < 8; ++i) {
            const float c = rot ? cs_tab[ax * 8 + i] : 1.f, sn = rot ? cs_tab[16 + ax * 8 + i] : 0.f;
            const float z1 = v[16 * ax + i], z2 = v[16 * ax + 8 + i];
            v[16 * ax + i] = z1 * c - z2 * sn; v[16 * ax + 8 + i] = z2 * c + z1 * sn;
        }
#pragma unroll
    for (int j = 0; j < 32; ++j) out[j >> 3][j & 7] = (half_t)(v[j] * post);
}
DEV void norm64_store(const half8 (&in)[8], float pre, const float* gain, float post, half_t* dst) {
    float ss = 0.f;
#pragma unroll
    for (int c = 0; c < 8; ++c) ss += sumsq8(in[c]);
    const float r = frsqrt(ss * pre * pre * (1.0f / 64.0f) + EPS) * pre * post;
#pragma unroll
    for (int c = 0; c < 8; ++c) {
        const f32x4 g0 = *(const f32x4*)(gain + 8 * c), g1 = *(const f32x4*)(gain + 8 * c + 4);
        half8 o;
#pragma unroll
        for (int j = 0; j < 4; ++j) { o[j] = (half_t)((float)in[c][j] * r * g0[j]); o[4 + j] = (half_t)((float)in[c][4 + j] * r * g1[j]); }
        *(half8*)(dst + 8 * c) = o;
    }
}
DEV void mixer_prep_item(CP& P, int l, int item) {
    const int tid = TID(), t = item * 16 + (tid & 15), job = tid >> 4, h = job & 3;
    const int b = t < NLAT ? t / SEQ : (t - NLAT) / CTX;
    const bool lat = t < NLAT;
    const int n = lat ? t % SEQ : 0;
    const int pos = lat ? n : SEQ + (t - NLAT) % CTX;
    const half_t* pr = P.p + (size_t)t * PPAD;
    const size_t row = (size_t)(b * 4 + h) * KEYS + pos;
    const float* cst = P.rope + (size_t)n * 32;
    if (job < 4) {
        const half_t* qr = P.qraw + (size_t)t * 384 + h * 96;
        half8 cq[24], qn[8], qro[4], qo[4];
#pragma unroll
        for (int c = 0; c < 24; ++c) cq[c] = *(const half8*)(pr + O_CQ + 8 * c);
#pragma unroll
        for (int c = 0; c < 8; ++c) qn[c] = *(const half8*)(qr + 8 * c);
#pragma unroll
        for (int c = 0; c < 4; ++c) qro[c] = *(const half8*)(qr + 64 + 8 * c);
        SCHED_FENCE();
        float s1 = 0.f;
#pragma unroll
        for (int c = 0; c < 24; ++c) s1 += sumsq8(cq[c]);
        const float rq = frsqrt(s1 * (1.0f / 192.0f) + EPS);
        const float qs = 0.10206207261596575f * LOG2E;
        norm64_store(qn, rq, P.mla_g_qn + l * 64, qs, P.mq + row * 96);
        rope32(qro, rq, P.mla_g_qr + l * 32, cst, lat, qs, qo);
#pragma unroll
        for (int c = 0; c < 4; ++c) *(half8*)(P.mq + row * 96 + 64 + 8 * c) = qo[c];
    } else if (job < 8) {
        const half_t* kr = P.kvraw + (size_t)t * 512 + h * 128;
        half8 ckv[16], kn[8], kvv[8], kri[4], kro[4];
#pragma unroll
        for (int c = 0; c < 16; ++c) ckv[c] = *(const half8*)(pr + O_CKV + 8 * c);
#pragma unroll
        for (int c = 0; c < 8; ++c) { kn[c] = *(const half8*)(kr + 8 * c); kvv[c] = *(const half8*)(kr + 64 + 8 * c); }
#pragma unroll
        for (int c = 0; c < 4; ++c) kri[c] = *(const half8*)(pr + O_KR + 8 * c);
        SCHED_FENCE();
        float s2 = 0.f;
#pragma unroll
        for (int c = 0; c < 16; ++c) s2 += sumsq8(ckv[c]);
        const float rkv = frsqrt(s2 * (1.0f / 128.0f) + EPS);
        norm64_store(kn, rkv, P.mla_g_kn + l * 64, 1.0f, P.mk + row * 96);
        rope32(kri, 1.0f, P.mla_g_kr + l * 32, cst, lat, 1.0f, kro);
#pragma unroll
        for (int c = 0; c < 4; ++c) *(half8*)(P.mk + row * 96 + 64 + 8 * c) = kro[c];
#pragma unroll
        for (int c = 0; c < 8; ++c) {
            const half8 v = kvv[c]; half8 o;
#pragma unroll
            for (int j = 0; j < 8; ++j) o[j] = (half_t)((float)v[j] * rkv);
            *(half8*)(P.mv + row * 64 + 8 * c) = o;
        }
    } else if (job < 12) {
        half8 a[8], a2[8];
#pragma unroll
        for (int c = 0; c < 8; ++c) { a[c] = *(const half8*)(pr + O_NAQ + h * 64 + 8 * c); a2[c] = *(const half8*)(pr + O_NAK + h * 64 + 8 * c); }
        SCHED_FENCE();
        norm64_store(a, 1.0f, P.na_g_q + l * 64, 0.125f * LOG2E, P.nq + row * 64);
        norm64_store(a2, 1.0f, P.na_g_k + l * 64, 1.0f, P.nk + row * 64);
    } else {
        half8 a[8];
#pragma unroll
        for (int c = 0; c < 8; ++c) a[c] = *(const half8*)(pr + O_NAV + h * 64 + 8 * c);
        SCHED_FENCE();
#pragma unroll
        for (int c = 0; c < 8; ++c) *(half8*)(P.nv + row * 64 + 8 * c) = a[c];
    }
}
DEV void phase_prep_scan(CP& P, int l, int rep) {
    constexpr int NSCAN = 2 * B_ * 4 * 2 * 4;
    constexpr int NPREP = NT / 16;
    for (int item = blockIdx.x; item < NSCAN + NPREP; item += gridDim.x) {
        if (item < NSCAN) {
            if (!rep) gla_scan(P, item, P.gst, 0);
            else if (item < NSCAN / 2) gla_scan(P, item, (float*)P.y, 0);
            else gla_scan(P, item, (float*)P.h, NSCAN / 8);
        }
        else mixer_prep_item(P, l, item - NSCAN);
    }
    if (PROBE & 8) for (int item = blockIdx.x; item < NPREP; item += gridDim.x) mixer_prep_item(P, l, item);
}

DEV half8 vt_frag(const half_t* Vs, int ldv, int kbase, int dv0, int lane) {
    const int grp = lane >> 4, hh = lane >> 5, i = lane & 15, q = i >> 2, pp = i & 3;
    const half_t* a = Vs + (kbase + 4 * hh + q) * ldv + dv0 + 16 * (grp & 1) + 4 * pp;
    const half4 lo = tr16(a), hi = tr16(a + 8 * ldv);
    half8 r; r[0] = lo[0]; r[1] = lo[1]; r[2] = lo[2]; r[3] = lo[3]; r[4] = hi[0]; r[5] = hi[1]; r[6] = hi[2]; r[7] = hi[3]; return r;
}
DEV void softmax_pv_step(const f32x16& s, float& m, float& lsum, f32x16 (&o)[2], const half_t* Vs, int ldv, int lane) {
    float mx = s[0];
#pragma unroll
    for (int r = 1; r < 16; ++r) mx = fmaxf(mx, s[r]);
    mx = fmaxf(mx, shfl_xor_f(mx, 32));
    const float mn = fmaxf(m, mx);
    const float alpha = fexp2(m - mn);
    m = mn;
    float ps = 0.f; half8 pf[2];
#pragma unroll
    for (int r = 0; r < 16; ++r) { const float pv = fexp2(s[r] - mn); ps += pv; pf[r >> 3][r & 7] = (half_t)pv; }
    lsum = lsum * alpha + ps;
#pragma unroll
    for (int dt = 0; dt < 2; ++dt)
#pragma unroll
        for (int r = 0; r < 16; ++r) o[dt][r] *= alpha;
#pragma unroll
    for (int s2 = 0; s2 < 2; ++s2)
#pragma unroll
        for (int dt = 0; dt < 2; ++dt) o[dt] = mfma32(vt_frag(Vs, ldv, 16 * s2, 32 * dt, lane), pf[s2], o[dt]);
}
DEV void softmax_pv_step2(const f32x16& s0, const f32x16& s1, float& m, float& lsum, f32x16 (&o)[2], const half_t* Vs, int ldv, int lane) {
    float mx = fmaxf(s0[0], s1[0]);
#pragma unroll
    for (int r = 1; r < 16; ++r) mx = fmaxf(mx, fmaxf(s0[r], s1[r]));
    mx = fmaxf(mx, shfl_xor_f(mx, 32));
    const float mn = fmaxf(m, mx);
    if (wave_any(mn != m)) {
        const float alpha = fexp2(m - mn);
        lsum *= alpha;
#pragma unroll
        for (int dt = 0; dt < 2; ++dt)
#pragma unroll
            for (int r = 0; r < 16; ++r) o[dt][r] *= alpha;
        m = mn;
    }
    float ps = 0.f; half8 pf[4];
#pragma unroll
    for (int r = 0; r < 16; ++r) { const float pa = fexp2(s0[r] - m), pb = fexp2(s1[r] - m); ps += pa + pb; pf[r >> 3][r & 7] = (half_t)pa; pf[2 + (r >> 3)][r & 7] = (half_t)pb; }
    lsum += ps;
#pragma unroll
    for (int kt2 = 0; kt2 < 2; ++kt2)
#pragma unroll
        for (int s2 = 0; s2 < 2; ++s2)
#pragma unroll
            for (int dt = 0; dt < 2; ++dt) o[dt] = mfma32(vt_frag(Vs + 32 * kt2 * ldv, ldv, 16 * s2, 32 * dt, lane), pf[2 * kt2 + s2], o[dt]);
}
DEV void attn_store(const f32x16 (&o)[2], float lsum, half_t* yrow, int lane) {
    const float inv = 1.0f / (lsum + shfl_xor_f(lsum, 32));
    const int hh = lane >> 5;
#pragma unroll
    for (int dt = 0; dt < 2; ++dt)
#pragma unroll
        for (int rq = 0; rq < 4; ++rq) {
            half4 v;
#pragma unroll
            for (int e = 0; e < 4; ++e) v[e] = (half_t)(o[dt][4 * rq + e] * inv);
            *(half4*)(yrow + 32 * dt + 8 * rq + 4 * hh) = v;
        }
}
DEV int attn_qtoken(int b, int qpos) { return qpos < SEQ ? b * SEQ + qpos : NLAT + b * CTX + (qpos - SEQ); }

constexpr int MS_K = 64 * 96, MS_V = 64 * 64, MS_STAGE = MS_K + MS_V;
DEV half8 vt_frag_swz(const half_t* Vs, int kbase, int dv0, int lane) {
    const int grp = lane >> 4, hh = lane >> 5, i = lane & 15, q = i >> 2, pp = i & 3;
    const int r0 = kbase + 4 * hh + q, col = dv0 + 16 * (grp & 1) + 4 * pp;
    const int ch = (col >> 3) ^ (4 * ((r0 >> 1) & 1));
    const half_t* a = Vs + r0 * 64 + ch * 8 + (col & 7);
    const half4 lo = tr16_nowait<0>(a), hi = tr16_nowait<8 * 64 * 2>(a);
    half8 r; r[0] = lo[0]; r[1] = lo[1]; r[2] = lo[2]; r[3] = lo[3]; r[4] = hi[0]; r[5] = hi[1]; r[6] = hi[2]; r[7] = hi[3]; return r;
}
#define MLA_ISSUE(ST, KT)                                                                                                         \
    {                                                                                                                             \
        half_t* sk_ = mring + (ST) * MS_STAGE; half_t* sv_ = sk_ + MS_K;                                                          \
        const half_t* kg_ = kg + (size_t)(KT) * 64 * 96; const half_t* vg_ = vg + (size_t)(KT) * 64 * 64;                         \
        _Pragma("unroll") for (int j = 0; j < 3; ++j) glds16(kg_ + ksrc[j], sk_ + (3 * w + j) * 512);                             \
        _Pragma("unroll") for (int j = 0; j < 2; ++j) glds16(vg_ + vsrc[j], sv_ + (2 * w + j) * 512);                             \
    }
#define MLA_COMPUTE(ST)                                                                                                           \
    {                                                                                                                             \
        const half_t* Ks = mring + (ST) * MS_STAGE; const half_t* Vs = Ks + MS_K;                                                 \
        f32x16 s0, s1;                                                                                                            \
        _Pragma("unroll") for (int r = 0; r < 16; ++r) { s0[r] = 0.f; s1[r] = 0.f; }                                              \
        half8 kf0[6], kf1[6];                                                                                                     \
        _Pragma("unroll") for (int ks = 0; ks < 6; ++ks) {                                                                        \
            const int p = 2 * ks + hh, pz = (p & ~3) | ((p & 3) ^ ((ql >> 2) & 3));      \
            kf0[ks] = *(const half8*)(Ks + ql * 96 + pz * 8); kf1[ks] = *(const half8*)(Ks + (32 + ql) * 96 + pz * 8);            \
        }                                                                                                                         \
        SCHED_FENCE();                                                \
        _Pragma("unroll") for (int ks = 0; ks < 6; ++ks) { s0 = mfma32(kf0[ks], qf[ks], s0); s1 = mfma32(kf1[ks], qf[ks], s1); }  \
        softmax_pv_step2s(s0, s1, m, lsum, o, Vs, lane);                                                                          \
    }
#define MLA_STEP(ST, ST2, ktv)                                                                                                    \
    {                                                                                                                             \
        const int kt_ = (ktv);                                                                                                    \
        if (kt_ + 1 < nkt) { WAIT_VM(5); } else { WAIT_VM(0); }                                                                   \
        RAW_BARRIER();                                                                                                            \
        if (kt_ + 2 < nkt) MLA_ISSUE(ST2, kt_ + 2)                                                                                \
        MLA_COMPUTE(ST)                                                                                                           \
    }
DEV void softmax_pv_step2s(const f32x16& s0, const f32x16& s1, float& m, float& lsum, f32x16 (&o)[2], const half_t* Vs, int lane) {
    float mx = fmaxf(s0[0], s1[0]);
#pragma unroll
    for (int r = 1; r < 16; ++r) mx = fmaxf(mx, fmaxf(s0[r], s1[r]));
    mx = fmaxf(mx, shfl_xor_f(mx, 32));
    const float mn = fmaxf(m, mx);
    if (wave_any(mn != m)) {
        const float alpha = fexp2(m - mn);
        lsum *= alpha;
#pragma unroll
        for (int dt = 0; dt < 2; ++dt)
#pragma unroll
            for (int r = 0; r < 16; ++r) o[dt][r] *= alpha;
        m = mn;
    }
    half8 vf[8];
#pragma unroll
    for (int kt2 = 0; kt2 < 2; ++kt2)
#pragma unroll
        for (int s2 = 0; s2 < 2; ++s2)
#pragma unroll
            for (int dt = 0; dt < 2; ++dt) vf[4 * kt2 + 2 * s2 + dt] = vt_frag_swz(Vs, 32 * kt2 + 16 * s2, 32 * dt, lane);
    float ps = 0.f; half8 pf[4];
#pragma unroll
    for (int r = 0; r < 16; ++r) { const float pa = fexp2(s0[r] - m), pb = fexp2(s1[r] - m); ps += pa + pb; pf[r >> 3][r & 7] = (half_t)pa; pf[2 + (r >> 3)][r & 7] = (half_t)pb; }
    lsum += ps;
    TR_WAIT();
#pragma unroll
    for (int kt2 = 0; kt2 < 2; ++kt2)
#pragma unroll
        for (int s2 = 0; s2 < 2; ++s2)
#pragma unroll
            for (int dt = 0; dt < 2; ++dt) o[dt] = mfma32(vf[4 * kt2 + 2 * s2 + dt], pf[2 * kt2 + s2], o[dt]);
}
DEV void mla_attn_item(CP& P, int b, int h, int qt, unsigned char* smem) {
    half_t* mring = (half_t*)smem;
    const int tid = TID(), lane = tid & 63, w = WID(tid), hh = lane >> 5, ql = lane & 31;
    const size_t bh = (size_t)(b * 4 + h) * KEYS;
    const int q0 = qt * 128 + 32 * w;
    const bool ctxq = q0 >= SEQ;
    const int kbeg = ctxq ? SEQ : 0, nkt = (ctxq ? CTX : KEYS) / 64;
    half8 qf[6];
#pragma unroll
    for (int ks = 0; ks < 6; ++ks) qf[ks] = *(const half8*)(P.mq + (bh + q0 + ql) * 96 + 16 * ks + 8 * hh);
    f32x16 o[2]; float m = -1e30f, lsum = 0.f;
#pragma unroll
    for (int dt = 0; dt < 2; ++dt)
#pragma unroll
        for (int r = 0; r < 16; ++r) o[dt][r] = 0.f;
    const half_t* kg = P.mk + (bh + kbeg) * 96; const half_t* vg = P.mv + (bh + kbeg) * 64;
    int ksrc[3], vsrc[2];
#pragma unroll
    for (int j = 0; j < 3; ++j) { const int L = (3 * w + j) * 64 + lane, r = L / 12, p = L % 12; ksrc[j] = r * 96 + 8 * ((p & ~3) | ((p & 3) ^ ((r >> 2) & 3))); }
#pragma unroll
    for (int j = 0; j < 2; ++j) { const int L = (2 * w + j) * 64 + lane, r = L >> 3, p = L & 7; vsrc[j] = r * 64 + 8 * (p ^ (4 * ((r >> 1) & 1))); }
    SYNC();
    MLA_ISSUE(0, 0)
    MLA_ISSUE(1, 1)
#pragma clang loop unroll(disable)
    for (int kt = 0; kt < nkt; kt += 3) {
        MLA_STEP(0, 2, kt)
        if (kt + 1 < nkt) MLA_STEP(1, 0, kt + 1)
        if (kt + 2 < nkt) MLA_STEP(2, 1, kt + 2)
    }
    attn_store(o, lsum, P.y + (size_t)attn_qtoken(b, q0 + ql) * D + 0 + h * 64, lane);
}

constexpr int NV_LD = 72, NA_WAVE_LDS = 32 * NV_LD * 2 + 15 * 32 * 4;
DEV void na_attn_unit(CP& P, int l, int unit, unsigned char* wlds, int lane) {
    constexpr int NLATU = B_ * 4 * ROWS * 2;
    half_t* Vw = (half_t*)wlds; float* bt = (float*)(wlds + 32 * NV_LD * 2);
    const int hh = lane >> 5, ql = lane & 31;
    int b, h, q0, ntile, R0 = 0, r = 0, hf = 0; bool lat;
    if (unit < NLATU) { lat = true; hf = unit & 1; r = (unit >> 1) % ROWS; const int bh = unit / (2 * ROWS); h = bh & 3; b = bh >> 2; q0 = r * 64 + 32 * hf; ntile = 16 + CTX / 32;
        R0 = r - 4 < 0 ? 0 : (r - 4 > ROWS - 8 ? ROWS - 8 : r - 4); }
    else { lat = false; const int u = unit - NLATU; const int cb = u % (CTX / 32); const int bh = u / (CTX / 32); h = bh & 3; b = bh >> 2; q0 = SEQ + 32 * cb; ntile = CTX / 32; }
    const size_t bhk = (size_t)(b * 4 + h) * KEYS;
    WAVE_BARRIER();
    if (lat) {
        const float* rp = P.na_rpb + (size_t)(l * 4 + h) * 15 * 31;
        for (int i = lane; i < 15 * 32; i += 64) { const int dr = i >> 5, dc = i & 31; bt[i] = dc < 31 ? rp[dr * 31 + dc] * LOG2E : 0.f; }
    }
    half8 qf[4];
#pragma unroll
    for (int ks = 0; ks < 4; ++ks) qf[ks] = *(const half8*)(P.nq + (bhk + q0 + ql) * 64 + 16 * ks + 8 * hh);
    f32x16 o[2]; float m = -1e30f, lsum = 0.f;
#pragma unroll
    for (int dt = 0; dt < 2; ++dt)
#pragma unroll
        for (int rr = 0; rr < 16; ++rr) o[dt][rr] = 0.f;
    const int wq = 32 * hf + ql;
    const int cs = wq - 8 < 0 ? 0 : (wq - 8 > 48 ? 48 : wq - 8);
    auto tile_kpos = [&](int tile) { return (lat && tile < 16) ? (R0 + (tile >> 1)) * 64 + 32 * (tile & 1) : SEQ + 32 * (lat ? tile - 16 : tile); };
    half8 kf[4], vf[4];
    {
        const int kp = tile_kpos(0);
#pragma unroll
        for (int ks = 0; ks < 4; ++ks) kf[ks] = *(const half8*)(P.nk + (bhk + kp + ql) * 64 + 16 * ks + 8 * hh);
#pragma unroll
        for (int i = 0; i < 4; ++i) { const int c = lane + 64 * i; vf[i] = *(const half8*)(P.nv + (bhk + kp + (c >> 3)) * 64 + (c & 7) * 8); }
    }
    for (int tile = 0; tile < ntile; ++tile) {
        const bool win = lat && tile < 16;
        const int krow = R0 + (tile >> 1), kh2 = tile & 1;
        f32x16 s;
#pragma unroll
        for (int rr = 0; rr < 16; ++rr) s[rr] = 0.f;
#pragma unroll
        for (int ks = 0; ks < 4; ++ks) s = mfma32(kf[ks], qf[ks], s);
        WAVE_BARRIER();
#pragma unroll
        for (int i = 0; i < 4; ++i) { const int c = lane + 64 * i; *(half8*)(Vw + (c >> 3) * NV_LD + (c & 7) * 8) = vf[i]; }
        if (tile + 1 < ntile) {
            const int kp = tile_kpos(tile + 1);
#pragma unroll
            for (int ks = 0; ks < 4; ++ks) kf[ks] = *(const half8*)(P.nk + (bhk + kp + ql) * 64 + 16 * ks + 8 * hh);
#pragma unroll
            for (int i = 0; i < 4; ++i) { const int c = lane + 64 * i; vf[i] = *(const half8*)(P.nv + (bhk + kp + (c >> 3)) * 64 + (c & 7) * 8); }
        }
        SCHED_FENCE();
        if (win) {
            const float* brow = bt + (krow - r + 7) * 32;
            float bv[16];
#pragma unroll
            for (int rr = 0; rr < 16; ++rr) {
                const int wk = 32 * kh2 + (rr & 3) + 8 * (rr >> 2) + 4 * hh;
                int dc = wk - wq + 15; dc = dc < 0 ? 0 : (dc > 30 ? 30 : dc);
                bv[rr] = brow[dc];
            }
#pragma unroll
            for (int rr = 0; rr < 16; ++rr) {
                const int wk = 32 * kh2 + (rr & 3) + 8 * (rr >> 2) + 4 * hh;
                const bool valid = wk >= cs && wk < cs + 16;
                s[rr] = valid ? s[rr] + bv[rr] : -INFINITY;
            }
        }
        WAVE_BARRIER();
        softmax_pv_step(s, m, lsum, o, Vw, NV_LD, lane);
    }
    attn_store(o, lsum, P.y + (size_t)attn_qtoken(b, q0 + ql) * D + 256 + h * 64, lane);
}

DEV void mixers_item(CP& P, int l, int item, unsigned char* smem) {
    const bool last = l == NL - 1;
    const int QT = (last ? SEQ : KEYS) / 128;
    const int NMLA = B_ * 4 * QT;
    const int NNA = (B_ * 4 * ROWS * 2 + (last ? 0 : B_ * 4 * (CTX / 32))) / 4;
    const int NGRP = last ? LG : NCH;
    const int lane = TID() & 63, w = TID() >> 6;
    if (item < NMLA) {
        const int qt = item % QT, bh = item / QT;
        mla_attn_item(P, bh >> 2, bh & 3, qt, smem);
    } else if (item < NMLA + NNA) {
        SYNC();
        na_attn_unit(P, l, (item - NMLA) * 4 + w, smem + w * NA_WAVE_LDS, lane);
    } else {
        int it = item - NMLA - NNA;
        const int gi = it % NGRP; it /= NGRP; const int h = it & 3; it >>= 2; const int b = it % B_; const int mix = it / B_;
        const int gidx = last ? gi + CG : gi;
        SYNC();
        if (mix == 0) gla_step_c<0>(P, l, b, h, gidx, smem); else gla_step_c<1>(P, l, b, h, gidx, smem);
    }
}
DEV int sched_next(int* ctr, unsigned char* smem) {
    int* slot = (int*)(smem + SMEM_BYTES - 16);
    SYNC();
    if (TID() == 0) *slot = atomic_add_i(ctr, 1);
    SYNC();
    return *slot;
}
constexpr int NCONV = 1024;
constexpr int CV_W13 = NEXP * D * 1024 / 8, CV_W2 = NEXP * 512 * D / 8;
DEV void moe_convert_unit(CP& P, int l, int u) {
    constexpr int PER = (CV_W13 + CV_W2) / NCONV;
    static_assert((CV_W13 + CV_W2) % NCONV == 0 && PER % NTHREADS == 0, "conversion split");
    const int tid = TID();
    for (int i0 = 0; i0 < PER; i0 += 4 * NTHREADS) {
        RawF r[4]; int c[4];
#pragma unroll
        for (int j = 0; j < 4; ++j) {
            c[j] = u * PER + i0 + j * NTHREADS + tid;
            const float* src;
            if (c[j] < CV_W13) {
                const int v = (c[j] & 127) * 8, k = (c[j] >> 7) & 1023, e = c[j] >> 17;
                const int tn = v >> 7, half = (v >> 6) & 1, col = 64 * tn + (v & 63);
                src = (half ? P.moe_w3 : P.moe_w1) + (((size_t)l * NEXP + e) * D + k) * 512 + col;
            } else { src = P.moe_w2 + (size_t)l * NEXP * 512 * D + (size_t)(c[j] - CV_W13) * 8; }
            r[j].a = *(const f32x4*)src; r[j].b = *(const f32x4*)(src + 4);
        }
        SCHED_FENCE();
#pragma unroll
        for (int j = 0; j < 4; ++j) {
            half_t* dst = c[j] < CV_W13 ? P.w13h + (size_t)c[j] * 8 : P.w2h + (size_t)(c[j] - CV_W13) * 8;
            *(half8*)dst = cvt_rawf(r[j]);
        }
    }
}
DEV void phase_mixers(CP& P, int l, unsigned char* smem, int rep) {
    const bool last = l == NL - 1;
    const int QT = (last ? SEQ : KEYS) / 128;
    const int NMLA = B_ * 4 * QT;
    const int NNA = (B_ * 4 * ROWS * 2 + (last ? 0 : B_ * 4 * (CTX / 32))) / 4;
    const int NGC = 2 * B_ * 4 * (last ? LG : NCH);
    const int NCV = rep ? 0 : NCONV;
    const int NIL = NMLA < NCV ? NMLA : NCV;
    const int NU = NMLA + NCV + NNA + NGC / 4;
    int* ctr = P.sched + l * 16 + rep;
    for (int u = sched_next(ctr, smem); u < NU; u = sched_next(ctr, smem)) {
        if (u < 2 * NIL) { if (u & 1) moe_convert_unit(P, l, u >> 1); else mixers_item(P, l, u >> 1, smem); }
        else if (u < NMLA + NCV) { const int v = u - 2 * NIL; if (NMLA > NCV) mixers_item(P, l, NIL + v, smem); else moe_convert_unit(P, l, NIL + v); }
        else if (u < NMLA + NCV + NNA) mixers_item(P, l, u - NCV, smem);
        else { const int g0 = NMLA + NNA + (u - NMLA - NCV - NNA) * 4; for (int j = 0; j < 4; ++j) mixers_item(P, l, g0 + j, smem); }
    }
    if (PROBE & 16) for (int item = blockIdx.x; item < NMLA; item += gridDim.x) mixers_item(P, l, item, smem);
    if (PROBE & 32) for (int item = blockIdx.x; item < NNA; item += gridDim.x) mixers_item(P, l, NMLA + item, smem);
    if (PROBE & 64) for (int item = blockIdx.x; item < NGC; item += gridDim.x) mixers_item(P, l, NMLA + NNA + item, smem);
}

DEV void phase_outproj(CP& P, int l, unsigned char* smem, int rep0) {
    const bool last = l == NL - 1;
    const int NTM = (last ? NLAT : NT) / 256;
    const int full = (NTM * 8) / gridDim.x;
    for (int rep = rep0; rep < ((PROBE & 512) ? 2 : rep0 + 1); ++rep) {
        for (int round = 0; round < full; ++round) {
            int tm, tn;
            if (!gemm_tile_order(round, NTM, 8, tm, tn)) continue;
            const int t0 = tm * 256;
            ARowLin ar{P.y + (size_t)t0 * D, D};
            BSrcH bs{P.wout16 + (size_t)l * D * D + tn * 128, D};
            EpiResid epi{(rep ? P.gst + (size_t)t0 * D : xrow_ptr(P, t0)) + tn * 128, P.mod + ((size_t)l * (B_ + 1) + tok_brow(t0)) * MODW + 2 * D + tn * 128};
            gemm_tile<4>(ar, bs, D, epi, smem);
        }
        const int base = full * gridDim.x, left = NTM * 8 - base;
        for (int i = blockIdx.x; i < 4 * left; i += gridDim.x) {
            int tm, tn; gemm_tile_idx(base + (i >> 2), NTM, 8, tm, tn);
            const int t0 = tm * 256 + 64 * (i & 3);
            ARowLin ar{P.y + (size_t)t0 * D, D};
            BSrcH bs{P.wout16 + (size_t)l * D * D + tn * 128, D};
            EpiResid epi{(rep ? P.gst + (size_t)t0 * D : xrow_ptr(P, t0)) + tn * 128, P.mod + ((size_t)l * (B_ + 1) + tok_brow(t0)) * MODW + 2 * D + tn * 128};
            gemm_tile<1>(ar, bs, D, epi, smem);
        }
    }
}

template <bool DRY> DEV void phase_router_t(CP& P, int l, unsigned char* smem) {
    const bool last = l == NL - 1;
    const int NI = (last ? NLAT : NT) / 64;
    const int tid = TID(), lane = tid & 63, w = tid >> 6, g = lane >> 4, li = lane & 15;
    float* wrs = (float*)smem;
    float* lg = (float*)(smem + 64 * 52 * 4) + w * 16 * 48;
    const float* wr = P.wr + (size_t)l * D * 48;
    int wrow[3], wc4[3];
#pragma unroll
    for (int i = 0; i < 3; ++i) { const int idx = tid + 256 * i; wrow[i] = idx / 12; wc4[i] = (idx % 12) * 4; }
    for (int item = blockIdx.x; item < NI; item += gridDim.x) {
        const int tok0 = item * 64 + 16 * w, br = tok_brow(item * 64);
        const float* xr = xrow_ptr(P, tok0 + li);
        const float* md = P.mod + ((size_t)l * (B_ + 1) + br) * MODW;
        const float* sh = md + 3 * D; const float* sc = md + 4 * D;
        f32x4 acc[3];
#pragma unroll
        for (int nt = 0; nt < 3; ++nt) acc[nt] = (f32x4){0.f, 0.f, 0.f, 0.f};
        float ssq = 0.f;
        f32x4 wv[3], xv[4], sv[4];
#pragma unroll
        for (int i = 0; i < 3; ++i) wv[i] = *(const f32x4*)(wr + (size_t)wrow[i] * 48 + wc4[i]);
#pragma unroll
        for (int j = 0; j < 4; ++j) { xv[j] = *(const f32x4*)(xr + 16 * j + 4 * g); sv[j] = *(const f32x4*)(sc + 16 * j + 4 * g); }
        for (int ch = 0; ch < 16; ++ch) {
            SYNC();
#pragma unroll
            for (int i = 0; i < 3; ++i) *(f32x4*)(wrs + wrow[i] * 52 + wc4[i]) = wv[i];
            SYNC();
            f32x4 xc[4], sk[4];
#pragma unroll
            for (int j = 0; j < 4; ++j) { xc[j] = xv[j]; sk[j] = sv[j]; }
            if (ch + 1 < 16) {
#pragma unroll
                for (int i = 0; i < 3; ++i) wv[i] = *(const f32x4*)(wr + (size_t)(64 * (ch + 1) + wrow[i]) * 48 + wc4[i]);
#pragma unroll
                for (int j = 0; j < 4; ++j) { xv[j] = *(const f32x4*)(xr + 64 * (ch + 1) + 16 * j + 4 * g); sv[j] = *(const f32x4*)(sc + 64 * (ch + 1) + 16 * j + 4 * g); }
            }
            SCHED_FENCE();
#pragma unroll
            for (int j = 0; j < 4; ++j) {
                ssq += xc[j][0] * xc[j][0] + xc[j][1] * xc[j][1] + xc[j][2] * xc[j][2] + xc[j][3] * xc[j][3];
#pragma unroll
                for (int c = 0; c < 4; ++c) {
                    const float a = xc[j][c] * (1.0f + sk[j][c]);
                    const float* wrow_l = wrs + (16 * j + 4 * g + c) * 52 + li;
#pragma unroll
                    for (int nt = 0; nt < 3; ++nt) acc[nt] = mfmaf(a, wrow_l[16 * nt], acc[nt]);
                }
            }
        }
        ssq += shfl_xor_f(ssq, 16); ssq += shfl_xor_f(ssq, 32);
        const float rstd = frsqrt(ssq * (1.0f / D) + EPS);
        const float* csh = P.cshift + ((size_t)l * (B_ + 1) + br) * 48;
        WAVE_BARRIER();
#pragma unroll
        for (int r = 0; r < 4; ++r) {
            const float rs = shfl_f(rstd, 4 * g + r);
#pragma unroll
            for (int nt = 0; nt < 3; ++nt) lg[(4 * g + r) * 48 + 16 * nt + li] = acc[nt][r] * rs + csh[16 * nt + li];
        }
        WAVE_BARRIER();
        if (lane < 16) {
            const float* lt = lg + lane * 48;
            int gi = 0; float gm = lt[0];
            for (int j = 1; j < 4; ++j) if (lt[j] > gm) { gm = lt[j]; gi = j; }
            float gden = 0.f; for (int j = 0; j < 4; ++j) gden += fexp(lt[j] - gm);
            const float pg = 1.0f / gden;
            const float* ft = lt + 4 + gi * 8;
            int e0 = 0; float f0 = ft[0];
            for (int j = 1; j < 8; ++j) if (ft[j] > f0) { f0 = ft[j]; e0 = j; }
            int e1 = -1; float f1 = -3.0e38f;
            for (int j = 0; j < 8; ++j) if (j != e0 && ft[j] > f1) { f1 = ft[j]; e1 = j; }
            const float p1 = fexp(f1 - f0);
            const float g0 = pg / (1.0f + p1), g1 = pg * p1 / (1.0f + p1);
            const int t = tok0 + lane, x0 = gi * 8 + e0, x1 = gi * 8 + e1;
            if (DRY) { float* dd = (float*)P.act + (size_t)t * 4; dd[0] = g0; dd[1] = g1; dd[2] = (float)x0; dd[3] = (float)x1; }
            else {
            const int s0 = atomic_add_i(P.cnt + l * NEXP + x0, 1), s1 = atomic_add_i(P.cnt + l * NEXP + x1, 1);
            P.list_tok[(size_t)x0 * NT + s0] = t; P.list_gate[(size_t)x0 * NT + s0] = g0;
            P.list_tok[(size_t)x1 * NT + s1] = t; P.list_gate[(size_t)x1 * NT + s1] = g1;
            P.tokslot[2 * t] = (x0 << 20) | s0; P.tokslot[2 * t + 1] = (x1 << 20) | s1;
            }
        }
        WAVE_BARRIER();
        half_t* hr = (DRY ? P.y : P.h) + (size_t)(tok0 + li) * D;
        for (int k8 = 0; k8 < 64; k8 += 8) {
            f32x4 xq[8], sq[8], hq[8];
#pragma unroll
            for (int j = 0; j < 8; ++j) { const int col = 16 * (k8 + j) + 4 * g; xq[j] = *(const f32x4*)(xr + col); sq[j] = *(const f32x4*)(sc + col); hq[j] = *(const f32x4*)(sh + col); }
            SCHED_FENCE();
#pragma unroll
            for (int j = 0; j < 8; ++j) {
                f32x4 o;
#pragma unroll
                for (int c = 0; c < 4; ++c) o[c] = xq[j][c] * rstd * (1.0f + sq[j][c]) + hq[j][c];
                *(half4*)(hr + 16 * (k8 + j) + 4 * g) = to_half4(o);
            }
        }
    }
}

DEV void phase_router(CP& P, int l, unsigned char* smem, int rep) {
    if (rep) { phase_router_t<true>(P, l, smem); return; }
    phase_router_t<false>(P, l, smem);
    if (PROBE & 1024) phase_router_t<true>(P, l, smem);
}
DEV void moe_tables(CP& P, int l, int* ab, int* tb) {
    if (TID() == 0) {
        int a = 0, t = 0;
        for (int e = 0; e < NEXP; ++e) { const int c = P.cnt[l * NEXP + e], nt = (c + 255) >> 8; ab[e] = a; tb[e] = t; a += nt * 256; t += nt; }
        ab[NEXP] = a; tb[NEXP] = t;
    }
    SYNC();
}
DEV int moe_find(const int* tb, int tile) { int e = 0; while (e < NEXP - 1 && tile >= tb[e + 1]) ++e; return e; }
DEV bool moe_item(const int* tb, int idx, int& e, int& mt, int& tn) {
    const int x = blockIdx.x & 7;
#pragma unroll
    for (int eg = 0; eg < 4; ++eg) {
        e = x + 8 * eg; const int n = (tb[e + 1] - tb[e]) * 8;
        if (idx < n) { mt = idx >> 3; tn = idx & 7; return true; }
        idx -= n;
    }
    return false;
}

DEV void phase_moe1(CP& P, int l, unsigned char* smem) {
    int* ab = (int*)(smem + SMEM_BYTES - 512); int* tb = ab + 40;
    moe_tables(P, l, ab, tb);
    for (int rep = 0; rep < ((PROBE & 128) ? 2 : 1); ++rep)
    for (int idx = blockIdx.x >> 3;; idx += gridDim.x >> 3) {
        int e, mt, tn; if (!moe_item(tb, idx, e, mt, tn)) break;
        const int cnt = P.cnt[l * NEXP + e], nvalid = cnt - mt * 256 < 256 ? cnt - mt * 256 : 256;
        ARowGather ar{P.h, D, P.list_tok + (size_t)e * NT + mt * 256, nvalid};
        BSrcH bs{P.w13h + (size_t)e * D * 1024 + tn * 128, 1024};
        EpiGlu epi{P.act + (size_t)(ab[e] + mt * 256) * 512 + tn * 64, 512};
        gemm256(ar, bs, D, epi, smem);
    }
}
DEV void phase_moe2(CP& P, int l, unsigned char* smem) {
    int* ab = (int*)(smem + SMEM_BYTES - 512); int* tb = ab + 40;
    moe_tables(P, l, ab, tb);
    for (int rep = 0; rep < ((PROBE & 256) ? 2 : 1); ++rep)
    for (int idx = blockIdx.x >> 3;; idx += gridDim.x >> 3) {
        int e, mt, tn; if (!moe_item(tb, idx, e, mt, tn)) break;
        const int cnt = P.cnt[l * NEXP + e], nvalid = cnt - mt * 256 < 256 ? cnt - mt * 256 : 256;
        const size_t r0 = (size_t)ab[e] + mt * 256;
        ARowLin ar{P.act + r0 * 512, 512};
        BSrcH bs{P.w2h + (size_t)e * 512 * D + tn * 128, D};
        EpiRowsGate epi{P.yrows + r0 * D + tn * 128, P.list_gate + (size_t)e * NT + mt * 256, nvalid};
        gemm256(ar, bs, 512, epi, smem);
    }
}
template <bool DRY> DEV void phase_combine_t(CP& P, int l, unsigned char* smem) {
    int* ab = (int*)(smem + SMEM_BYTES - 512); int* tb = ab + 40;
    moe_tables(P, l, ab, tb);
    const bool last = l == NL - 1;
    const int NTK = last ? NLAT : NT;
    const int lane = TID() & 63, gw = blockIdx.x * 4 + (TID() >> 6), nw = gridDim.x * 4;
    for (int t = gw; t < NTK; t += nw) {
        const int ts0 = P.tokslot[2 * t], ts1 = P.tokslot[2 * t + 1];
        const half_t* y0 = P.yrows + (size_t)(ab[ts0 >> 20] + (ts0 & 0xFFFFF)) * D;
        const half_t* y1 = P.yrows + (size_t)(ab[ts1 >> 20] + (ts1 & 0xFFFFF)) * D;
        float* xr = xrow_ptr(P, t);
        float* xw = DRY ? P.gst + (size_t)t * D : xr;
        const float* md = P.mod + ((size_t)l * (B_ + 1) + tok_brow(t)) * MODW;
        f32x4 v[4], xv[4], gt[4]; half4 ya[4], yb[4];
#pragma unroll
        for (int j = 0; j < 4; ++j) {
            const int col = 256 * j + 4 * lane;
            xv[j] = *(const f32x4*)(xr + col); gt[j] = *(const f32x4*)(md + 5 * D + col); ya[j] = *(const half4*)(y0 + col); yb[j] = *(const half4*)(y1 + col);
        }
        SCHED_FENCE();
#pragma unroll
        for (int j = 0; j < 4; ++j) {
            const int col = 256 * j + 4 * lane;
#pragma unroll
            for (int e = 0; e < 4; ++e) v[j][e] = xv[j][e] + gt[j][e] * ((float)ya[j][e] + (float)yb[j][e]);
            *(f32x4*)(xw + col) = v[j];
        }
        if (!last) { const float* mn = md + (size_t)(B_ + 1) * MODW; row_modulate_store(v, mn + 0, mn + D, (DRY ? P.y : P.h) + (size_t)t * D, lane); }
    }
}

DEV void phase_combine(CP& P, int l, unsigned char* smem, int rep) {
    if (rep) { phase_combine_t<true>(P, l, smem); return; }
    if (PROBE & 2048) phase_combine_t<true>(P, l, smem);
    phase_combine_t<false>(P, l, smem);
}
template <int PH> DEV void run_phase(CP& P, int l, unsigned char* smem, int rep = 0) {
    if (PH == 0) { phase_prologue_a(P, smem); if (PROBE & 4096) { SYNC(); phase_prologue_a(P, smem); } }
    if (PH == 1) { phase_prologue_b(P); if (PROBE & 4096) phase_prologue_b(P); }
    if (PH == 2) phase_inproj(P, l, smem);
    if (PH == 3) phase_up_glaa(P, l, smem);
    if (PH == 4) phase_prep_scan(P, l, rep);
    if (PH == 5) phase_mixers(P, l, smem, rep);
    if (PH == 6) phase_outproj(P, l, smem, rep);
    if (PH == 7) phase_router(P, l, smem, rep);
    if (PH == 8) phase_moe1(P, l, smem);
    if (PH == 9) phase_moe2(P, l, smem);
    if (PH == 10) phase_combine(P, l, smem, rep);
}

#ifndef CPU_EMU
#define XB_TMO      128
#define XB_XCNT(j)  (256  + 64 * (j))
#define XB_XSUB(j)  (1280 + 64 * (j))
#define XB_XGEN(j)  (2304 + 64 * (j))
#define XB_TOP      3328
#define XB_TOPGEN   3392
#define XCD_BAR_WORDS 3456
#define XB_SPIN_CAP (1u << 24)
__device__ __forceinline__ unsigned xb_ld(unsigned* p)              { return __hip_atomic_load(p, __ATOMIC_RELAXED, __HIP_MEMORY_SCOPE_AGENT); }
__device__ __forceinline__ unsigned xb_add(unsigned* p, unsigned v) { return __hip_atomic_fetch_add(p, v, __ATOMIC_RELAXED, __HIP_MEMORY_SCOPE_AGENT); }
__device__ __forceinline__ unsigned xb_xcc_id() { return (unsigned)__builtin_amdgcn_s_getreg((3 << 11) | 20) & 0xFu; }
#define XB_SPIN(cond, bar) do { unsigned _sp = 0; while (cond) { __builtin_amdgcn_s_sleep(1); \
    if ((++_sp & 255u) == 0u) { if (xb_ld(&(bar)[XB_TMO])) break; if (_sp > XB_SPIN_CAP) { atomicAdd(&(bar)[XB_TMO], 1u); break; } } } } while (0)
struct XcdBarrier { unsigned* bar; unsigned x; volatile LDSP unsigned* st; };
__device__ __forceinline__ XcdBarrier xcd_barrier_post(unsigned* bar, volatile LDSP unsigned* st) {
    XcdBarrier b; b.bar = bar; b.x = xb_xcc_id(); b.st = st;
    if (threadIdx.x == 0) (void)xb_add(&bar[XB_XCNT(b.x)], 1u);
    return b;
}
__device__ __forceinline__ void xcd_barrier_complete(unsigned* bar, unsigned x, unsigned& nloc, unsigned& nx) {
    const unsigned G = gridDim.x * gridDim.y * gridDim.z;
    unsigned sum, cnt, mine, sp = 0u;
    for (;;) {
        sum = 0u; cnt = 0u; mine = 0u;
#pragma unroll
        for (unsigned j = 0; j < 16; ++j) { const unsigned c = xb_ld(&bar[XB_XCNT(j)]); sum += c; cnt += (c > 0u) ? 1u : 0u; mine = (j == x) ? c : mine; }
        if (sum == G) break;
        __builtin_amdgcn_s_sleep(1);
        if ((++sp & 255u) == 0u) { if (xb_ld(&bar[XB_TMO])) break; if (sp > XB_SPIN_CAP) { atomicAdd(&bar[XB_TMO], 1u); break; } }
    }
    nloc = mine > 0u ? mine : 1u; nx = cnt > 0u ? cnt : 1u;
}
__device__ __forceinline__ void xcd_barrier1(const XcdBarrier& b) {
    asm volatile("s_waitcnt vmcnt(0)" ::: "memory");
    __syncthreads();
    if (threadIdx.x == 0) {
        unsigned* bar = b.bar;
        __builtin_amdgcn_s_waitcnt(0);
        unsigned nloc = b.st[0], nx = b.st[1];
        if (nloc == 0u) { xcd_barrier_complete(bar, b.x, nloc, nx); b.st[0] = nloc; b.st[1] = nx; }
        const unsigned old = xb_add(&bar[XB_XSUB(b.x)], 1u);
        const unsigned gen = old / nloc;
        if (old + 1u == (gen + 1u) * nloc) {
            __builtin_amdgcn_fence(__ATOMIC_RELEASE, "agent");
            asm volatile("s_waitcnt vmcnt(0)" ::: "memory");
            const unsigned og = xb_add(&bar[XB_TOP], 1u);
            const unsigned tg = og / nx;
            if (og + 1u == (tg + 1u) * nx) xb_add(&bar[XB_TOPGEN], 1u);
            else XB_SPIN(xb_ld(&bar[XB_TOPGEN]) == tg, bar);
            __builtin_amdgcn_fence(__ATOMIC_ACQUIRE, "agent");
            xb_add(&bar[XB_XGEN(b.x)], 1u);
            asm volatile("s_waitcnt vmcnt(0)" ::: "memory");
        } else {
            XB_SPIN(xb_ld(&bar[XB_XGEN(b.x)]) == gen, bar);
            __builtin_amdgcn_fence(__ATOMIC_ACQUIRE, "agent");
            asm volatile("s_waitcnt vmcnt(0)" ::: "memory");
        }
    }
    __syncthreads();
}

#ifndef MK_MULTI
#define MK_MULTI 0
#endif
__device__ __forceinline__ void xcd_barrier(const XcdBarrier& b) { xcd_barrier1(b); if (PROBE & 8192) xcd_barrier1(b); }
#if MK_MULTI
template <int PH> __global__ void __launch_bounds__(NTHREADS, 2) k_phase(Params Pv, int l) {
    extern __shared__ __attribute__((aligned(16))) unsigned char smem[];
    CP& P = *(CP*)__builtin_amdgcn_kernarg_segment_ptr();
    run_phase<PH>(P, l, smem);
}
#else
template <int PH> static __device__ __forceinline__ void phase_ni(int l, int rep = 0) {
    extern __shared__ __attribute__((aligned(16))) unsigned char smem[];
    CP& P = *(CP*)__builtin_amdgcn_kernarg_segment_ptr();
    run_phase<PH>(P, l, smem, rep);
}
__global__ void __launch_bounds__(NTHREADS, 2) k_mega(Params Pv) {
    extern __shared__ __attribute__((aligned(16))) unsigned char smem[];
    CP& P = *(CP*)__builtin_amdgcn_kernarg_segment_ptr();
    volatile LDSP unsigned* xbw = (volatile LDSP unsigned*)(smem + SMEM_BYTES);
    if (threadIdx.x == 0) { xbw[0] = 0u; xbw[1] = 0u; xbw[2] = 0u; xbw[3] = 0u; }
    __syncthreads();
    XcdBarrier bar = xcd_barrier_post(P.bar, xbw);
    phase_ni<0>(0); xcd_barrier(bar);
    phase_ni<1>(0); xcd_barrier(bar);
#pragma clang loop unroll(disable)
    for (int l = 0; l < NL; ++l) {
        phase_ni<2>(l); xcd_barrier(bar); if (WPROBE == 2) { phase_ni<2>(l, 1); xcd_barrier(bar); }
        phase_ni<3>(l); xcd_barrier(bar); if (WPROBE == 3) { phase_ni<3>(l, 1); xcd_barrier(bar); }
        phase_ni<4>(l); xcd_barrier(bar); if (WPROBE == 4) { phase_ni<4>(l, 1); xcd_barrier(bar); }
        phase_ni<5>(l); xcd_barrier(bar); if (WPROBE == 5) { phase_ni<5>(l, 1); xcd_barrier(bar); }
        phase_ni<6>(l); xcd_barrier(bar); if (WPROBE == 6) { phase_ni<6>(l, 1); xcd_barrier(bar); }
        phase_ni<7>(l); xcd_barrier(bar); if (WPROBE == 7) { phase_ni<7>(l, 1); xcd_barrier(bar); }
        phase_ni<8>(l); xcd_barrier(bar); if (WPROBE == 8) { phase_ni<8>(l, 1); xcd_barrier(bar); }
        phase_ni<9>(l); xcd_barrier(bar); if (WPROBE == 9) { phase_ni<9>(l, 1); xcd_barrier(bar); }
        phase_ni<10>(l); if (WPROBE == 10) { xcd_barrier(bar); phase_ni<10>(l, 1); } if (l + 1 < NL) xcd_barrier(bar);
    }
}
#endif
#endif

struct Carver { unsigned char* base; size_t off; template <class T> T* take(size_t n) { off = (off + 255) & ~(size_t)255; T* p = (T*)(base + off); off += n * sizeof(T); return p; } };
static inline size_t carve_ws(Params& P, void* d_ws) {
    Carver c{(unsigned char*)d_ws, 0};
    P.bar = c.take<unsigned>(4096);
    P.xc = c.take<float>((size_t)NCTX * D);
    P.mod = c.take<float>((size_t)NL * (B_ + 1) * MODW);
    P.hglb = c.take<float>(NL * 256);
    P.rope = c.take<float>((size_t)SEQ * 32);
    P.wr = c.take<float>((size_t)NL * D * 48);
    P.cshift = c.take<float>(NL * (B_ + 1) * 48);
    P.cnt = c.take<int>(NL * NEXP);
    P.sched = c.take<int>(NL * 16);
    P.list_tok = c.take<int>((size_t)NEXP * NT);
    P.list_gate = c.take<float>((size_t)NEXP * NT);
    P.tokslot = c.take<int>((size_t)NT * 2);
    P.gst = c.take<float>((size_t)2 * B_ * 4 * 2 * NCH * 4096);
    P.gdec = c.take<float>((size_t)2 * B_ * 4 * 2 * NCH * 64);
    P.win16 = c.take<half_t>((size_t)NL * D * PPAD);
    P.wout16 = c.take<half_t>((size_t)NL * D * D);
    P.wuq16 = c.take<half_t>((size_t)NL * 192 * 384);
    P.wukv16 = c.take<half_t>((size_t)NL * 128 * 512);
    P.h = c.take<half_t>((size_t)NT * D);
    P.p = c.take<half_t>((size_t)NT * PPAD);
    P.yrows = P.p;
    P.y = c.take<half_t>((size_t)NT * D);
    P.qraw = c.take<half_t>((size_t)NT * 384);
    P.kvraw = c.take<half_t>((size_t)NT * 512);
    P.mq = c.take<half_t>((size_t)B_ * 4 * KEYS * 96);
    P.mk = c.take<half_t>((size_t)B_ * 4 * KEYS * 96);
    P.mv = c.take<half_t>((size_t)B_ * 4 * KEYS * 64);
    P.nq = c.take<half_t>((size_t)B_ * 4 * KEYS * 64);
    P.nk = c.take<half_t>((size_t)B_ * 4 * KEYS * 64);
    P.nv = c.take<half_t>((size_t)B_ * 4 * KEYS * 64);
    P.act = c.take<half_t>((size_t)ACT_ROWS * 512);
    P.w13h = c.take<half_t>((size_t)NEXP * D * 1024);
    P.w2h = c.take<half_t>((size_t)NEXP * 512 * D);
    return c.off;
}
static inline void fill_inputs(Params& P, void* const* d_in, void* d_out) {
    const float* const* in = (const float* const*)d_in;
    P.x = in[0]; P.c = in[1]; P.ctx = in[2]; P.c_ctx = in[3]; P.w_ada = in[4]; P.b_ada = in[5]; P.w_in = in[6]; P.w_out = in[7];
    P.mla_g_cq = in[8]; P.mla_g_ckv = in[9]; P.mla_w_uq = in[10]; P.mla_w_ukv = in[11]; P.mla_g_qn = in[12]; P.mla_g_qr = in[13];
    P.mla_g_kn = in[14]; P.mla_g_kr = in[15]; P.na_g_q = in[16]; P.na_g_k = in[17]; P.na_rpb = in[18]; P.ret_g_out = in[19];
    P.hg_lb_raw = in[20]; P.hg_g_out = in[21]; P.moe_w_rg = in[22]; P.moe_b_rg = in[23]; P.moe_w_re = in[24]; P.moe_b_re = in[25];
    P.moe_w1 = in[26]; P.moe_w3 = in[27]; P.moe_w2 = in[28];
    P.out = (float*)d_out;
}

#ifndef CPU_EMU
extern "C" void kernel_launch(void* const* d_in, const int* in_sizes, int n_in, void* d_out, int out_size, void* d_ws, size_t ws_size, hipStream_t stream) {
    Params P{};
    fill_inputs(P, d_in, d_out);
    carve_ws(P, d_ws);
    constexpr size_t kDynLds = SMEM_BYTES + 16;
    static int grid = 0;
    if (!grid) {
        int dev = 0, cus = 0, per_cu = 0;
        (void)hipGetDevice(&dev);
        (void)hipDeviceGetAttribute(&cus, hipDeviceAttributeMultiprocessorCount, dev);
        #if MK_MULTI
        (void)hipOccupancyMaxActiveBlocksPerMultiprocessor(&per_cu, k_phase<5>, NTHREADS, kDynLds);
#else
        (void)hipFuncSetAttribute((const void*)k_mega, hipFuncAttributeMaxDynamicSharedMemorySize, (int)kDynLds);
        (void)hipOccupancyMaxActiveBlocksPerMultiprocessor(&per_cu, k_mega, NTHREADS, kDynLds);
#endif
        if (per_cu < 1) per_cu = 1;
        grid = cus * (per_cu < 2 ? per_cu : 2);
    }
#if MK_MULTI
    k_phase<0><<<grid, NTHREADS, kDynLds, stream>>>(P, 0);
    k_phase<1><<<grid, NTHREADS, kDynLds, stream>>>(P, 0);
    for (int l = 0; l < NL; ++l) {
        k_phase<2><<<grid, NTHREADS, kDynLds, stream>>>(P, l);
        k_phase<3><<<grid, NTHREADS, kDynLds, stream>>>(P, l);
        k_phase<4><<<grid, NTHREADS, kDynLds, stream>>>(P, l);
        k_phase<5><<<grid, NTHREADS, kDynLds, stream>>>(P, l);
        k_phase<6><<<grid, NTHREADS, kDynLds, stream>>>(P, l);
        k_phase<7><<<grid, NTHREADS, kDynLds, stream>>>(P, l);
        k_phase<8><<<grid, NTHREADS, kDynLds, stream>>>(P, l);
        k_phase<9><<<grid, NTHREADS, kDynLds, stream>>>(P, l);
        k_phase<10><<<grid, NTHREADS, kDynLds, stream>>>(P, l);
    }
#else
    (void)hipMemsetAsync(P.bar, 0, XCD_BAR_WORDS * sizeof(unsigned), stream);
    k_mega<<<grid, NTHREADS, kDynLds, stream>>>(P);
#endif
}
#endif
```

```cpp
#ifndef CPU_EMU
#include <hip/hip_runtime.h>
#endif
#include <stdint.h>
#include <stddef.h>

#ifndef PROBE
#define PROBE 0
#endif
#ifndef WPROBE
#define WPROBE 0
#endif
#ifndef CFG_B
#define CFG_B 8
#define CFG_SEQ 4096
#define CFG_L 4
#define CFG_CTX 256
#endif

typedef _Float16 half_t;
typedef _Float16 half8 __attribute__((ext_vector_type(8)));
typedef _Float16 half4 __attribute__((ext_vector_type(4)));
typedef short s16x4 __attribute__((ext_vector_type(4)));
typedef float f32x4 __attribute__((ext_vector_type(4)));
typedef float f32x16 __attribute__((ext_vector_type(16)));

#ifdef CPU_EMU
#define DEV inline
#define SYNC() emu::block_sync()
#define WAVE_BARRIER() emu::wave_sync()
#define SCHED_FENCE() do {} while (0)
#define WAIT_VM(n) do {} while (0)
#define RAW_BARRIER() emu::block_sync()
inline void glds16(const void* g, void* lds_wave_base) { memcpy((unsigned char*)lds_wave_base + (threadIdx.x & 63) * 16, g, 16); }
inline int WID(int tid) { return tid >> 6; }
DEV f32x4 mfma16(half8 a, half8 b, f32x4 c) { return emu::mfma_16x16x32<half8, f32x4>(a, b, c); }
DEV f32x16 mfma32(half8 a, half8 b, f32x16 c) { return emu::mfma_32x32x16<half8, f32x16>(a, b, c); }
DEV f32x4 mfmaf(float a, float b, f32x4 c) { return emu::mfma_16x16x4_f32<f32x4>(a, b, c); }
DEV half4 tr16(const half_t* p) { return emu::ds_read_tr16<half4>((const void*)p); }
template <int OFF> DEV half4 tr16_nowait(const half_t* p) { return emu::ds_read_tr16<half4>((const void*)((const unsigned char*)p + OFF)); }
#define TR_WAIT() do {} while (0)
DEV float shfl_xor_f(float v, int m) { return emu::shfl_xor<float>(v, m); }
DEV float shfl_f(float v, int src) { return emu::shfl<float>(v, src); }
DEV int atomic_add_i(int* p, int v) { return __atomic_fetch_add(p, v, __ATOMIC_RELAXED); }
DEV bool wave_any(bool p) { float f = p ? 1.f : 0.f; for (int m = 1; m < 64; m <<= 1) f = fmaxf(f, emu::shfl_xor<float>(f, m)); return f > 0.f; }
DEV float fexp2(float x) { return exp2f(x); }
DEV float fexp(float x) { return expf(x); }
DEV float flog(float x) { return logf(x); }
DEV float frsqrt(float x) { return 1.0f / sqrtf(x); }
DEV float frcp(float x) { return 1.0f / x; }
#else
#define DEV __device__ __forceinline__
#define SYNC() __syncthreads()
#define WAVE_BARRIER() __builtin_amdgcn_wave_barrier()
#define SCHED_FENCE() __builtin_amdgcn_sched_barrier(0)
#define WAIT_VM(n) asm volatile("s_waitcnt vmcnt(" #n ")" ::: "memory")
#define RAW_BARRIER() __builtin_amdgcn_s_barrier()
__device__ __forceinline__ void glds16(const void* g, void* lds_wave_base) {
    __builtin_amdgcn_global_load_lds((const __attribute__((address_space(1))) void*)g, (__attribute__((address_space(3))) void*)lds_wave_base, 16, 0, 0);
}
__device__ __forceinline__ int WID(int tid) { return __builtin_amdgcn_readfirstlane(tid >> 6); }
#define LDSP __attribute__((address_space(3)))
DEV f32x4 mfma16(half8 a, half8 b, f32x4 c) { return __builtin_amdgcn_mfma_f32_16x16x32_f16(a, b, c, 0, 0, 0); }
DEV f32x16 mfma32(half8 a, half8 b, f32x16 c) { return __builtin_amdgcn_mfma_f32_32x32x16_f16(a, b, c, 0, 0, 0); }
DEV f32x4 mfmaf(float a, float b, f32x4 c) { return __builtin_amdgcn_mfma_f32_16x16x4f32(a, b, c, 0, 0, 0); }
DEV half4 tr16(const half_t* p) { s16x4 t = __builtin_amdgcn_ds_read_tr16_b64_v4i16((LDSP s16x4*)p); return __builtin_bit_cast(half4, t); }
template <int OFF> DEV half4 tr16_nowait(const half_t* p) { s16x4 t; const unsigned a = (unsigned)(size_t)(LDSP const half_t*)p; asm volatile("ds_read_b64_tr_b16 %0, %1 offset:%2" : "=v"(t) : "v"(a), "i"(OFF) : "memory"); return __builtin_bit_cast(half4, t); }
#define TR_WAIT() do { asm volatile("s_waitcnt lgkmcnt(0)" ::: "memory"); __builtin_amdgcn_sched_barrier(0); } while (0)
DEV float shfl_xor_f(float v, int m) { return __shfl_xor(v, m, 64); }
DEV float shfl_f(float v, int src) { return __shfl(v, src, 64); }
DEV int atomic_add_i(int* p, int v) { return atomicAdd(p, v); }
DEV bool wave_any(bool p) { return __any(p) != 0; }
DEV float fexp2(float x) { return __builtin_amdgcn_exp2f(x); }
DEV float fexp(float x) { return __expf(x); }
DEV float flog(float x) { return __logf(x); }
DEV float frsqrt(float x) { return __builtin_amdgcn_rsqf(x); }
DEV float frcp(float x) { return __builtin_amdgcn_rcpf(x); }
#endif

#ifdef CPU_EMU
DEV float opaque0() { return 0.f; }
DEV int TID() { return (int)threadIdx.x; }
#else
DEV int TID() { int t = (int)threadIdx.x; asm volatile("" : "+v"(t)); return t; }
DEV float opaque0() { float z = 0.f; asm volatile("" : "+v"(z)); return z; }
#endif
constexpr int B_ = CFG_B, SEQ = CFG_SEQ, NL = CFG_L, CTX = CFG_CTX, D = 1024;
constexpr int NLAT = B_ * SEQ, NCTX = B_ * CTX, NT = NLAT + NCTX;
constexpr int ROWS = SEQ / 64;
constexpr int KEYS = SEQ + CTX;
constexpr int PTOT = 3424, PPAD = 3456;
constexpr int O_CQ = 0, O_CKV = 192, O_KR = 320, O_NAQ = 352, O_NAK = 608, O_NAV = 864, O_RQ = 1120, O_RK = 1376, O_RV = 1632, O_RG = 1888,
              O_HQ = 2144, O_HF = 2400, O_HB = 2656, O_HI = 2912, O_HG = 3168;
constexpr int NCH = KEYS / 64, CG = CTX / 64, LG = SEQ / 64;
constexpr int NEXP = 32, ACT_ROWS = 2 * NT + NEXP * 256;
constexpr float EPS = 1e-6f;
constexpr float LOG2E = 1.4426950408889634f;
constexpr int MODW = 6 * D;
constexpr int NTHREADS = 256;
constexpr int SMEM_BYTES = 74240;

struct Params {
    const float *x, *c, *ctx, *c_ctx, *w_ada, *b_ada, *w_in, *w_out, *mla_g_cq, *mla_g_ckv, *mla_w_uq, *mla_w_ukv, *mla_g_qn, *mla_g_qr, *mla_g_kn,
        *mla_g_kr, *na_g_q, *na_g_k, *na_rpb, *ret_g_out, *hg_lb_raw, *hg_g_out, *moe_w_rg, *moe_b_rg, *moe_w_re, *moe_b_re, *moe_w1, *moe_w3, *moe_w2;
    float* out;
    unsigned* bar;
    float *xc, *mod, *hglb, *wr, *cshift, *list_gate, *gst, *gdec, *rope;
    int *cnt, *list_tok, *tokslot, *sched;
    half_t *win16, *wout16, *wuq16, *wukv16, *h, *p, *y, *qraw, *kvraw, *mq, *mk, *mv, *nq, *nk, *nv, *act, *yrows, *w13h, *w2h;
};

#ifdef CPU_EMU
typedef const Params CP;
#else
typedef const __attribute__((address_space(4))) Params CP;
#endif
DEV int tok_brow(int t) { return t < NLAT ? t / SEQ : B_; }
DEV float* xrow_ptr(CP& P, int t) { return t < NLAT ? P.out + (size_t)t * D : P.xc + (size_t)(t - NLAT) * D; }
DEV const float* xin_ptr(CP& P, int t) { return t < NLAT ? P.x + (size_t)t * D : P.ctx + (size_t)(t - NLAT) * D; }
DEV float silu_f(float x) { return x * frcp(1.0f + fexp(-x)); }
DEV float sigmoid_f(float x) { return frcp(1.0f + fexp(-x)); }
DEV float wave_sum(float v) {
    v += shfl_xor_f(v, 1); v += shfl_xor_f(v, 2); v += shfl_xor_f(v, 4); v += shfl_xor_f(v, 8); v += shfl_xor_f(v, 16); v += shfl_xor_f(v, 32);
    return v;
}
DEV half4 to_half4(f32x4 v) { half4 r; r[0] = (half_t)v[0]; r[1] = (half_t)v[1]; r[2] = (half_t)v[2]; r[3] = (half_t)v[3]; return r; }

constexpr int LDB_S = 136, G_BBUF = 32 * LDB_S;
struct BSrcH {
    const half_t* base; int ld;
    typedef half8 Raw;
    DEV Raw load(int k, int n) const { return *(const half8*)(base + (size_t)k * ld + n); }
    DEV half8 cvt(const Raw& r) const { return r; }
};
struct RawF { f32x4 a, b; };
DEV half8 cvt_rawf(const RawF& r) {
    half8 h; h[0] = (half_t)r.a[0]; h[1] = (half_t)r.a[1]; h[2] = (half_t)r.a[2]; h[3] = (half_t)r.a[3];
    h[4] = (half_t)r.b[0]; h[5] = (half_t)r.b[1]; h[6] = (half_t)r.b[2]; h[7] = (half_t)r.b[3]; return h;
}
struct BSrcF {
    const float* base; int ld;
    typedef RawF Raw;
    DEV Raw load(int k, int n) const { const float* s = base + (size_t)k * ld + n; RawF r; r.a = *(const f32x4*)s; r.b = *(const f32x4*)(s + 4); return r; }
    DEV half8 cvt(const Raw& r) const { return cvt_rawf(r); }
};
struct BSrcF2 {
    const float* b0; ptrdiff_t d10; int ld;
    typedef RawF Raw;
    DEV Raw load(int k, int n) const { const float* s = b0 + (ptrdiff_t)(n >> 6) * d10 + (n & 63) + (size_t)k * ld; RawF r; r.a = *(const f32x4*)s; r.b = *(const f32x4*)(s + 4); return r; }
    DEV half8 cvt(const Raw& r) const { return cvt_rawf(r); }
};
DEV int swzB(int k, int ch) { return k * LDB_S + (ch << 3); }
constexpr int GS_B = 32 * 128;
DEV int fswzB(int k) { return 2 * ((k & 3) | (((k >> 3) & 1) << 2)); }
#define GEMM_ISSUE(ST, KT)                                                                                                   \
    {                                                                                                                        \
        half_t* sa_ = ring + (ST) * GS_STAGE + (16 * MT * w) * 32;                                                           \
        half_t* sb_ = ring + (ST) * GS_STAGE + GS_A + (8 * w) * 128;                                                          \
        _Pragma("unroll") for (int j = 0; j < MT; ++j) glds16(asrc[j] + (KT) * 32, sa_ + 16 * j * 32);                       \
        _Pragma("unroll") for (int j = 0; j < 2; ++j) glds16(bsrc[j] + (size_t)(KT) * 32 * ldb, sb_ + 4 * j * 128);          \
    }
#define GEMM_COMPUTE(ST)                                                                                                     \
    {                                                                                                                        \
        const half_t* sa_ = ring + (ST) * GS_STAGE; const half_t* sb_ = sa_ + GS_A;                                          \
        half8 af[MT];                                                                                                        \
        _Pragma("unroll") for (int mt = 0; mt < MT; ++mt) af[mt] = *(const half8*)(sa_ + aoff + mt * 16 * 32);               \
        _Pragma("unroll") for (int nh = 0; nh < 2; ++nh) {                                                                   \
            half8 bf[4];                                                                                                     \
            _Pragma("unroll") for (int n4 = 0; n4 < 4; ++n4) {                                                               \
                const half_t* ba = sb_ + bk0 * 128 + (((2 * (4 * nh + n4) + (pp >> 1)) ^ bfz) << 3) + 4 * (pp & 1);          \
                const half4 lo = tr16_nowait<0>(ba), hi = tr16_nowait<1024>(ba);                                             \
                bf[n4][0] = lo[0]; bf[n4][1] = lo[1]; bf[n4][2] = lo[2]; bf[n4][3] = lo[3]; bf[n4][4] = hi[0]; bf[n4][5] = hi[1]; bf[n4][6] = hi[2]; bf[n4][7] = hi[3]; \
            }                                                                                                                \
            TR_WAIT();                                                                                                       \
            _Pragma("unroll") for (int n4 = 0; n4 < 4; ++n4)                                                                 \
                _Pragma("unroll") for (int mt = 0; mt < MT; ++mt) acc[mt][4 * nh + n4] = mfma16(bf[n4], af[mt], acc[mt][4 * nh + n4]); \
        }                                                                                                                    \
    }
#define GEMM_STEP(ST, ST2, itv)                                                                                              \
    {                                                                                                                        \
        const int it_ = (itv);                                                                                               \
        if (it_ + 1 < nk) { if (MT == 4) { WAIT_VM(6); } else if (MT == 2) { WAIT_VM(4); } else { WAIT_VM(3); } } else { WAIT_VM(0); } \
        RAW_BARRIER();                                                                                                       \
        if (it_ + 2 < nk) GEMM_ISSUE(ST2, it_ + 2)                                                                           \
        GEMM_COMPUTE(ST)                                                                                                     \
    }
template <int MT, class ARow, class BS, class Epi>
DEV void gemm_tile(const ARow& arow, const BS& bs, int K, Epi& epi, unsigned char* smem) {
    constexpr int GS_A = 64 * MT * 32, GS_STAGE = GS_A + GS_B;
    half_t* ring = (half_t*)smem;
    const int tid = TID(), lane = tid & 63, w = WID(tid), g = lane >> 4, li = lane & 15;
    const int q = li >> 2, pp = li & 3;
    const int nk = K >> 5;
    const int ldb = bs.ld;
    const half_t* asrc[MT];
#pragma unroll
    for (int j = 0; j < MT; ++j) asrc[j] = arow(16 * MT * w + 16 * j + (lane >> 2)) + 8 * ((lane & 3) ^ (lane >> 4));
    const half_t* bsrc[2];
#pragma unroll
    for (int j = 0; j < 2; ++j) { const int k = 8 * w + 4 * j + (lane >> 4); bsrc[j] = bs.base + (size_t)k * ldb + 8 * ((lane & 15) ^ fswzB(k)); }
    const int aoff = (16 * MT * w + li) * 32 + ((g ^ (li >> 2)) << 3);
    const int bk0 = 8 * g + q, bfz = fswzB(bk0);
    f32x4 acc[MT][8];
#pragma unroll
    for (int mt = 0; mt < MT; ++mt)
#pragma unroll
        for (int nt = 0; nt < 8; ++nt) acc[mt][nt] = (f32x4){0.f, 0.f, 0.f, 0.f};
    SYNC();
    GEMM_ISSUE(0, 0)
    GEMM_ISSUE(1, 1)
#pragma clang loop unroll(disable)
    for (int it = 0; it < nk; it += 3) {
        GEMM_STEP(0, 2, it)
        if (it + 1 < nk) GEMM_STEP(1, 0, it + 1)
        if (it + 2 < nk) GEMM_STEP(2, 1, it + 2)
    }
    epi.template run<MT>(acc, w, g, li);
}
template <class ARow, class BS, class Epi>
DEV void gemm256(const ARow& arow, const BS& bs, int K, Epi& epi, unsigned char* smem) { gemm_tile<4>(arow, bs, K, epi, smem); }
struct ARowLin { const half_t* base; int ld; DEV const half_t* operator()(int r) const { return base + (size_t)r * ld; } };
struct ARowGather { const half_t* base; int ld; const int* idx; int nvalid; DEV const half_t* operator()(int r) const { const int t = r < nvalid ? idx[r] : 0; return base + (size_t)t * ld; } };

struct EpiStoreH {
    half_t* out; int ld;
    template <int MT> DEV void run(const f32x4 (&acc)[MT][8], int w, int g, int li) const {
#pragma unroll
        for (int mt = 0; mt < MT; ++mt)
#pragma unroll
            for (int nt = 0; nt < 8; ++nt) *(half4*)(out + (size_t)(16 * MT * w + 16 * mt + li) * ld + 16 * nt + 4 * g) = to_half4(acc[mt][nt]);
    }
};
struct EpiResid {
    float* x; const float* xsrc; const float* gate;
    template <int MT> DEV void run(const f32x4 (&acc)[MT][8], int w, int g, int li) const {
#pragma unroll
        for (int nh = 0; nh < 2; ++nh) {
            f32x4 gt[4];
#pragma unroll
            for (int n4 = 0; n4 < 4; ++n4) gt[n4] = *(const f32x4*)(gate + 16 * (4 * nh + n4) + 4 * g);
#pragma unroll
            for (int mt = 0; mt < MT; ++mt) {
                f32x4 xv[4];
                const size_t ro = (size_t)(16 * MT * w + 16 * mt + li) * D + 64 * nh + 4 * g;
#pragma unroll
                for (int n4 = 0; n4 < 4; ++n4) xv[n4] = *(const f32x4*)(xsrc + ro + 16 * n4);
                SCHED_FENCE();
#pragma unroll
                for (int n4 = 0; n4 < 4; ++n4) *(f32x4*)(x + ro + 16 * n4) = xv[n4] + gt[n4] * acc[mt][4 * nh + n4];
            }
        }
    }
};
struct EpiGlu {
    half_t* out; int ld;
    template <int MT> DEV void run(const f32x4 (&acc)[MT][8], int w, int g, int li) const {
#pragma unroll
        for (int mt = 0; mt < MT; ++mt)
#pragma unroll
            for (int nt = 0; nt < 4; ++nt) {
                f32x4 o;
#pragma unroll
                for (int r = 0; r < 4; ++r) o[r] = silu_f(acc[mt][nt][r]) * acc[mt][nt + 4][r];
                *(half4*)(out + (size_t)(16 * MT * w + 16 * mt + li) * ld + 16 * nt + 4 * g) = to_half4(o);
            }
    }
};
struct EpiRowsGate {
    half_t* out; const float* gate; int nvalid;
    template <int MT> DEV void run(const f32x4 (&acc)[MT][8], int w, int g, int li) const {
#pragma unroll
        for (int mt = 0; mt < MT; ++mt) {
            const int row = 16 * MT * w + 16 * mt + li;
            if (row < nvalid) {
                const float gt = gate[row];
#pragma unroll
                for (int nt = 0; nt < 8; ++nt) *(half4*)(out + (size_t)row * D + 16 * nt + 4 * g) = to_half4(acc[mt][nt] * gt);
            }
        }
    }
};

DEV void phase_prologue_a(CP& P, unsigned char* smem) {
    const int tid = TID(), gtid = blockIdx.x * NTHREADS + tid, gsz = gridDim.x * NTHREADS;
    for (size_t i = gtid; i < (size_t)NL * D * (PPAD / 8); i += gsz) {
        const int cc = (int)(i % (PPAD / 8)) * 8; const size_t rk = i / (PPAD / 8);
        half8 h;
#pragma unroll
        for (int j = 0; j < 8; ++j) h[j] = (cc + j < PTOT) ? (half_t)P.w_in[rk * PTOT + cc + j] : (half_t)0.f;
        *(half8*)(P.win16 + rk * PPAD + cc) = h;
    }
    for (size_t i = gtid; i < (size_t)NL * D * D / 8; i += gsz) {
        const f32x4 a = *(const f32x4*)(P.w_out + i * 8), b = *(const f32x4*)(P.w_out + i * 8 + 4);
        RawF r; r.a = a; r.b = b; *(half8*)(P.wout16 + i * 8) = cvt_rawf(r);
    }
    for (int i = gtid; i < NL * 192 * 384; i += gsz) { const int l = i / (192 * 384), k = (i / 384) % 192; P.wuq16[i] = (half_t)(P.mla_g_cq[l * 192 + k] * P.mla_w_uq[i]); }
    for (int i = gtid; i < NL * 128 * 512; i += gsz) { const int l = i / (128 * 512), k = (i / 512) % 128; P.wukv16[i] = (half_t)(P.mla_g_ckv[l * 128 + k] * P.mla_w_ukv[i]); }
    for (int i = gtid; i < 256; i += gsz) {
        float mx = -1e30f; for (int l = 0; l < NL; ++l) mx = fmaxf(mx, P.hg_lb_raw[l * 256 + i]);
        float den = 0.f; for (int l = 0; l < NL; ++l) den += fexp(P.hg_lb_raw[l * 256 + i] - mx);
        float cum = 0.f;
        for (int l = 0; l < NL; ++l) { const float wv = fexp(P.hg_lb_raw[l * 256 + i] - mx) / den; if (l > 0) cum += wv; P.hglb[l * 256 + i] = cum; }
    }
    for (int i = gtid; i < NL * D * 48; i += gsz) {
        const int n = i % 48, lk = i / 48;
        P.wr[i] = n < 4 ? P.moe_w_rg[lk * 4 + n] : (n < 36 ? P.moe_w_re[lk * 32 + (n - 4)] : 0.f);
    }
    for (int i = gtid; i < NL * NEXP; i += gsz) P.cnt[i] = 0;
    for (int i = gtid; i < NL * 16; i += gsz) P.sched[i] = 0;
    for (int i = gtid; i < SEQ * 16; i += gsz) {
        const int n = i >> 4, j = i & 15, ax = j >> 3, fi = j & 7;
        const float ang = (float)(ax == 0 ? n / 64 : n % 64) * fexp(-9.210340371976184f * (float)fi * 0.125f);
        P.rope[n * 32 + j] = cosf(ang); P.rope[n * 32 + 16 + j] = sinf(ang);
    }
    float* sc = (float*)smem;
    SYNC();
    for (int i = tid; i < (B_ + 1) * D; i += NTHREADS) { const int r = i / D, k = i % D; const float v = r < B_ ? P.c[r * D + k] : P.c_ctx[k]; sc[i] = silu_f(v); }
    SYNC();
    float* red = sc + (B_ + 1) * D;
    for (int item = blockIdx.x; item < NL * (MODW / 64); item += gridDim.x) {
        const int l = item / (MODW / 64), n = (item % (MODW / 64)) * 64 + (tid & 63), kq = tid >> 6;
        float acc[B_ + 1];
#pragma unroll
        for (int r = 0; r <= B_; ++r) acc[r] = 0.f;
        const float* wp = P.w_ada + (size_t)l * D * MODW + (size_t)(256 * kq) * MODW + n;
        for (int k0 = 0; k0 < 256; k0 += 8) {
            float wv[8];
#pragma unroll
            for (int j = 0; j < 8; ++j) wv[j] = wp[(size_t)(k0 + j) * MODW];
#pragma unroll
            for (int j = 0; j < 8; ++j)
#pragma unroll
                for (int r = 0; r <= B_; ++r) acc[r] += sc[r * D + 256 * kq + k0 + j] * wv[j];
        }
        SYNC();
#pragma unroll
        for (int r = 0; r <= B_; ++r) red[(kq * 64 + (tid & 63)) * (B_ + 1) + r] = acc[r];
        SYNC();
        if (kq == 0) {
            const float bv = P.b_ada[l * MODW + n];
#pragma unroll
            for (int r = 0; r <= B_; ++r) {
                const int o = (tid & 63) * (B_ + 1) + r;
                P.mod[((size_t)l * (B_ + 1) + r) * MODW + n] = ((red[o] + red[64 * (B_ + 1) + o]) + (red[128 * (B_ + 1) + o] + red[192 * (B_ + 1) + o])) + bv;
            }
        }
    }
}

DEV void row_modulate_store(const f32x4 (&v)[4], const float* sh, const float* sc, half_t* hrow, int lane) {
    f32x4 s4[4], h4[4];
#pragma unroll
    for (int j = 0; j < 4; ++j) { s4[j] = *(const f32x4*)(sc + 256 * j + 4 * lane); h4[j] = *(const f32x4*)(sh + 256 * j + 4 * lane); }
    float ss = 0.f;
#pragma unroll
    for (int j = 0; j < 4; ++j) ss += v[j][0] * v[j][0] + v[j][1] * v[j][1] + v[j][2] * v[j][2] + v[j][3] * v[j][3];
    ss = wave_sum(ss);
    const float rstd = frsqrt(ss * (1.0f / D) + EPS);
#pragma unroll
    for (int j = 0; j < 4; ++j) {
        f32x4 o;
#pragma unroll
        for (int e = 0; e < 4; ++e) o[e] = v[j][e] * rstd * (1.0f + s4[j][e]) + h4[j][e];
        *(half4*)(hrow + 256 * j + 4 * lane) = to_half4(o);
    }
}
DEV void phase_prologue_b(CP& P) {
    const int lane = TID() & 63, gw = blockIdx.x * 4 + (TID() >> 6), nw = gridDim.x * 4;
    for (int t = gw; t < NT; t += nw) {
        const float* src = t < NLAT ? P.x + (size_t)t * D : P.ctx + (size_t)(t - NLAT) * D;
        f32x4 v[4];
#pragma unroll
        for (int j = 0; j < 4; ++j) v[j] = *(const f32x4*)(src + 256 * j + 4 * lane);
        const float* md = P.mod + (size_t)tok_brow(t) * MODW;
        row_modulate_store(v, md + 0, md + D, P.h + (size_t)t * D, lane);
    }
    for (int it = gw; it < NL * (B_ + 1) * 36; it += nw) {
        const int n = it % 36, lr = it / 36, l = lr / (B_ + 1);
        const float* sh = P.mod + (size_t)lr * MODW + 3 * D;
        float s = 0.f;
        for (int k = lane; k < D; k += 64) s += sh[k] * P.wr[((size_t)l * D + k) * 48 + n];
        s = wave_sum(s);
        if (lane == 0) P.cshift[lr * 48 + n] = s + (n < 4 ? P.moe_b_rg[l * 4 + n] : P.moe_b_re[l * 32 + n - 4]);
    }
}

DEV bool gemm_tile_idx(int idx, int ntm, int ntn, int& tm, int& tn) {
    if (idx >= ntm * ntn) return false;
    const int nig = 4 * ntn, gid = idx / nig, fm = gid * 4, gsz = (ntm - fm) < 4 ? (ntm - fm) : 4, rem = idx - gid * nig;
    tm = fm + rem % gsz; tn = rem / gsz; return true;
}
DEV bool gemm_tile_order(int round, int ntm, int ntn, int& tm, int& tn) {
    const int per = gridDim.x >> 3;
    const int idx = ((round << 3) + (blockIdx.x & 7)) * per + (blockIdx.x >> 3);
    if (idx >= ntm * ntn) return false;
    const int nig = 4 * ntn, gid = idx / nig, fm = gid * 4, gsz = (ntm - fm) < 4 ? (ntm - fm) : 4, rem = idx - gid * nig;
    tm = fm + rem % gsz; tn = rem / gsz; return true;
}
DEV void phase_inproj(CP& P, int l, unsigned char* smem) {
    constexpr int NTN = PPAD / 128, NTM = NT / 256;
    const int full = (NTM * NTN) / gridDim.x;
    for (int rep = 0; rep < ((PROBE & 1) ? 2 : 1); ++rep) {
        for (int round = 0; round < full; ++round) {
            int tm, tn;
            if (!gemm_tile_order(round, NTM, NTN, tm, tn)) continue;
            ARowLin ar{P.h + (size_t)tm * 256 * D, D};
            BSrcH bs{P.win16 + (size_t)l * D * PPAD + tn * 128, PPAD};
            EpiStoreH epi{P.p + (size_t)tm * 256 * PPAD + tn * 128, PPAD};
            gemm_tile<4>(ar, bs, D, epi, smem);
        }
        const int base = full * gridDim.x, left = NTM * NTN - base;
        for (int i = blockIdx.x; i < 4 * left; i += gridDim.x) {
            int tm, tn; gemm_tile_idx(base + (i >> 2), NTM, NTN, tm, tn);
            const size_t r0 = (size_t)tm * 256 + 64 * (i & 3);
            ARowLin ar{P.h + r0 * D, D};
            BSrcH bs{P.win16 + (size_t)l * D * PPAD + tn * 128, PPAD};
            EpiStoreH epi{P.p + r0 * PPAD + tn * 128, PPAD};
            gemm_tile<1>(ar, bs, D, epi, smem);
        }
    }
}

constexpr int GQ_LD = 68, GH_LD = 72, GS_LD = 24;
constexpr int G_QF = 0, G_KF = 17408, G_KH = 34816, G_VH = 44032, G_SC = 53248, G_DK = 56320, G_RED = 57344;
DEV float ret_loggamma(int h, int dir) { return log1pf(-exp2f(-5.0f - (float)(2 * h + dir))); }
template <int MIX, bool OUT, int dir>
DEV void gla_stage(CP& P, int l, int h, int tok0, float lgam, float& totsum, unsigned char* smem) {
    float* Qf = (float*)(smem + G_QF); float* Kf = (float*)(smem + G_KF); half_t* Kh = (half_t*)(smem + G_KH); half_t* Vh = (half_t*)(smem + G_VH);
    float* dk = (float*)(smem + G_DK);
    const int tid = TID(), d = tid & 63, I = tid >> 6;
    const half_t* pr = P.p + (size_t)(tok0 + 16 * I) * PPAD + h * 64 + d;
    float lf[16], kk[16], qq[16];
    half_t vv[16], rq[16], rk[16];
    float lb = 0.f;
    if (MIX == 1) lb = P.hglb[l * 256 + h * 64 + d];
#pragma unroll
    for (int i = 0; i < 16; ++i) {
        const half_t* pi = pr + (size_t)i * PPAD;
        if (MIX == 0) { rq[i] = OUT ? pi[O_RQ] : (half_t)0.f; rk[i] = pi[O_RK]; vv[i] = pi[O_RV]; }
        else { rq[i] = OUT ? pi[O_HQ] : (half_t)0.f; rk[i] = pi[dir ? O_HB : O_HF]; vv[i] = pi[O_HI]; }
    }
    SCHED_FENCE();
    float tot = 0.f;
#pragma unroll
    for (int i = 0; i < 16; ++i) {
        if (MIX == 0) {
            qq[i] = (float)rq[i]; kk[i] = (float)rk[i] * 0.125f; lf[i] = lgam;
        } else {
            qq[i] = OUT ? silu_f((float)rq[i]) : 0.f;
            const float sg = sigmoid_f((float)rk[i]), f = lb + (1.0f - lb) * sg;
            lf[i] = flog(fmaxf(f, 1e-20f)); kk[i] = (1.0f - lb) * (1.0f - sg);
        }
        tot += lf[i];
    }
    float bc = 0.f;
#pragma unroll
    for (int ii = 0; ii < 16; ++ii) {
        const int i = dir == 0 ? ii : 15 - ii;
        bc += lf[i];
        const int o = (I * 16 + i);
        if (OUT) { Qf[o * GQ_LD + d] = qq[i] * fexp(bc); Kf[o * GQ_LD + d] = kk[i] * fexp(fminf(-bc, 80.0f)); }
        Kh[o * GH_LD + d] = (half_t)(kk[i] * fexp(tot - bc));
        Vh[o * GH_LD + d] = vv[i];
    }
    dk[I * 64 + d] = fexp(tot);
    totsum += tot;
}
DEV half8 tok_frag(const half_t* img, int col0, int lane) {
    const int g = lane >> 4, li = lane & 15, q = li >> 2, p = li & 3;
    const half_t* a = img + (8 * (g & 1) + q) * GH_LD + col0 + 4 * p;
    const half4 lo = tr16(a), hi = tr16(a + 4 * GH_LD);
    half8 r;
    const bool z = g >= 2;
    r[0] = z ? (half_t)0.f : lo[0]; r[1] = z ? (half_t)0.f : lo[1]; r[2] = z ? (half_t)0.f : lo[2]; r[3] = z ? (half_t)0.f : lo[3];
    r[4] = z ? (half_t)0.f : hi[0]; r[5] = z ? (half_t)0.f : hi[1]; r[6] = z ? (half_t)0.f : hi[2]; r[7] = z ? (half_t)0.f : hi[3];
    return r;
}
DEV void gla_scores(int dir, unsigned char* smem) {
    const float* Qf = (const float*)(smem + G_QF); const float* Kf = (const float*)(smem + G_KF); half_t* sc = (half_t*)(smem + G_SC);
    const int tid = TID(), lane = tid & 63, w = tid >> 6, g = lane >> 4, li = lane & 15;
    f32x4 s0 = {0.f, 0.f, 0.f, 0.f}, s1 = {0.f, 0.f, 0.f, 0.f};
    const float* kp = Kf + (w * 16 + li) * GQ_LD + g; const float* qp = Qf + (w * 16 + li) * GQ_LD + g;
#pragma unroll
    for (int kk = 0; kk < 16; kk += 2) { s0 = mfmaf(kp[4 * kk], qp[4 * kk], s0); s1 = mfmaf(kp[4 * kk + 4], qp[4 * kk + 4], s1); }
    half4 o;
#pragma unroll
    for (int r = 0; r < 4; ++r) { const int sj = 4 * g + r; const bool keep = dir == 0 ? (sj <= li) : (sj >= li); o[r] = keep ? (half_t)(s0[r] + s1[r]) : (half_t)0.f; }
    *(half4*)(sc + (w * 16 + li) * GS_LD + 4 * g) = o;
}
template <bool OUT>
DEV void gla_main_sub(int I, f32x4 (&st)[4], f32x4& oacc, unsigned char* smem) {
    const float* Qf = (const float*)(smem + G_QF); const half_t* Kh = (const half_t*)(smem + G_KH); const half_t* Vh = (const half_t*)(smem + G_VH);
    const half_t* sc = (const half_t*)(smem + G_SC); const float* dk = (const float*)(smem + G_DK);
    const int tid = TID(), lane = tid & 63, w = tid >> 6, g = lane >> 4, li = lane & 15;
    const half8 vfr = tok_frag(Vh + I * 16 * GH_LD, 16 * w, lane);
    if (OUT) {
        const half8 sf = *(const half8*)(sc + (I * 16 + li) * GS_LD + 8 * (g & 1));
        oacc = mfma16(vfr, sf, oacc);
#pragma unroll
        for (int ks = 0; ks < 2; ++ks) {
            half8 sa, qb;
            const f32x4 q0 = *(const f32x4*)(Qf + (I * 16 + li) * GQ_LD + 32 * ks + 4 * g), q1 = *(const f32x4*)(Qf + (I * 16 + li) * GQ_LD + 32 * ks + 16 + 4 * g);
#pragma unroll
            for (int j = 0; j < 4; ++j) { sa[j] = (half_t)st[2 * ks][j]; sa[4 + j] = (half_t)st[2 * ks + 1][j]; qb[j] = (half_t)q0[j]; qb[4 + j] = (half_t)q1[j]; }
            oacc = mfma16(sa, qb, oacc);
        }
    }
#pragma unroll
    for (int dt = 0; dt < 4; ++dt) {
        const f32x4 dv = *(const f32x4*)(dk + I * 64 + 16 * dt + 4 * g);
#pragma unroll
        for (int r = 0; r < 4; ++r) st[dt][r] *= dv[r];
        st[dt] = mfma16(tok_frag(Kh + I * 16 * GH_LD, 16 * dt, lane), vfr, st[dt]);
    }
}
DEV int gla_tok0(int b, int gidx) { return gidx < CG ? NLAT + b * CTX + 64 * gidx : b * SEQ + 64 * (gidx - CG); }
DEV int gla_chainpos(int gidx, int dir) { return dir == 0 ? gidx : (gidx < CG ? CG - 1 - gidx : CG + (LG - 1 - (gidx - CG))); }
DEV size_t gla_chain(int mix, int b, int h, int dir) { return (((size_t)mix * B_ + b) * 4 + h) * 2 + dir; }
template <int MIX>
DEV void gla_step_a(CP& P, int l, int b, int h, int dir, int gidx, unsigned char* smem) {
    const int tid = TID(), lane = tid & 63, w = tid >> 6, g = lane >> 4, li = lane & 15;
    f32x4 st[4]; f32x4 od = {0.f, 0.f, 0.f, 0.f};
#pragma unroll
    for (int dt = 0; dt < 4; ++dt) st[dt] = (f32x4){0.f, 0.f, 0.f, 0.f};
    float totsum = 0.f;
    const float lgam = MIX == 0 ? ret_loggamma(h, dir) : 0.f;
    if (dir == 0) gla_stage<MIX, false, 0>(P, l, h, gla_tok0(b, gidx), lgam, totsum, smem); else gla_stage<MIX, false, 1>(P, l, h, gla_tok0(b, gidx), lgam, totsum, smem);
    SYNC();
#pragma unroll
    for (int ii = 0; ii < 4; ++ii) gla_main_sub<false>(dir == 0 ? ii : 3 - ii, st, od, smem);
    const size_t slot = gla_chain(MIX, b, h, dir) * NCH + gla_chainpos(gidx, dir);
    half_t* dst = (half_t*)P.gst + slot * 4096;
#pragma unroll
    for (int dt = 0; dt < 4; ++dt)
#pragma unroll
        for (int r = 0; r < 4; ++r) dst[(16 * dt + 4 * g + r) * 64 + 16 * w + li] = (half_t)st[dt][r];
    if (tid < 64) { const float* dk = (const float*)(smem + G_DK); P.gdec[slot * 64 + tid] = dk[tid] * dk[64 + tid] * dk[128 + tid] * dk[192 + tid]; }
    SYNC();
}
template <int MIX>
DEV void gla_step_c(CP& P, int l, int b, int h, int gidx, unsigned char* smem) {
    const int tid = TID(), lane = tid & 63, w = tid >> 6, g = lane >> 4, li = lane & 15;
    f32x4 oacc[4];
#pragma unroll
    for (int I = 0; I < 4; ++I) oacc[I] = (f32x4){0.f, 0.f, 0.f, 0.f};
    const int tok0 = gla_tok0(b, gidx);
    float totsum = 0.f;
#pragma unroll
    for (int dir = 0; dir < 2; ++dir) {
        const size_t slot = gla_chain(MIX, b, h, dir) * NCH + gla_chainpos(gidx, dir);
        const half_t* src = (const half_t*)P.gst + slot * 4096;
        f32x4 st[4];
#pragma unroll
        for (int dt = 0; dt < 4; ++dt)
#pragma unroll
            for (int r = 0; r < 4; ++r) st[dt][r] = (float)src[(16 * dt + 4 * g + r) * 64 + 16 * w + li];
        const float lgam = MIX == 0 ? ret_loggamma(h, dir) : 0.f;
        if (dir == 1) SYNC();
        if (dir == 0) gla_stage<MIX, true, 0>(P, l, h, tok0, lgam, totsum, smem); else gla_stage<MIX, true, 1>(P, l, h, tok0, lgam, totsum, smem);
        SYNC();
        gla_scores(dir, smem);
        SYNC();
#pragma unroll
        for (int ii = 0; ii < 4; ++ii) { const int I = dir == 0 ? ii : 3 - ii; gla_main_sub<true>(I, st, oacc[I], smem); }
    }
    float* red = (float*)(smem + G_RED);
#pragma unroll
    for (int I = 0; I < 4; ++I) {
        float ss = oacc[I][0] * oacc[I][0] + oacc[I][1] * oacc[I][1] + oacc[I][2] * oacc[I][2] + oacc[I][3] * oacc[I][3];
        ss += shfl_xor_f(ss, 16); ss += shfl_xor_f(ss, 32);
        if (g == 0) red[w * 64 + 16 * I + li] = ss;
    }
    SYNC();
    const float* gain = (MIX == 0 ? P.ret_g_out : P.hg_g_out) + l * 64;
    const int ycol = (MIX == 0 ? 512 : 768) + h * 64 + 16 * w + 4 * g, gcol = (MIX == 0 ? O_RG : O_HG) + h * 64 + 16 * w + 4 * g;
#pragma unroll
    for (int I = 0; I < 4; ++I) {
        const int ti = 16 * I + li, t = tok0 + ti;
        const float tot = red[ti] + red[64 + ti] + red[128 + ti] + red[192 + ti];
        const float rstd = frsqrt(tot * (1.0f / 64.0f) + EPS);
        const half4 gt = *(const half4*)(P.p + (size_t)t * PPAD + gcol);
        f32x4 o;
#pragma unroll
        for (int r = 0; r < 4; ++r) o[r] = oacc[I][r] * rstd * gain[16 * w + 4 * g + r] * silu_f((float)gt[r]);
        *(half4*)(P.y + (size_t)t * D + ycol) = to_half4(o);
    }
    SYNC();
}
DEV void gla_scan(CP& P, int item, half_t* gst, int chain_off) {
    const int chain = item >> 1, e8 = ((item & 1) << 8) + TID(), d = e8 >> 3;
    half_t* base = gst + (size_t)(chain - chain_off) * NCH * 4096 + 8 * e8;
    const float* dec = P.gdec + (size_t)chain * NCH * 64 + d;
    const float z0 = opaque0();
    float s[8];
#pragma unroll
    for (int i = 0; i < 8; ++i) s[i] = z0;
    static_assert(NCH % 17 == 0 || NCH % 4 == 0, "scan batch");
    constexpr int BT = (NCH % 17 == 0) ? 17 : 4;
    for (int pos = 0; pos < NCH; pos += BT) {
        half8 ds[BT]; float dc[BT];
#pragma unroll
        for (int j = 0; j < BT; ++j) { ds[j] = *(const half8*)(base + (size_t)(pos + j) * 4096); dc[j] = dec[(pos + j) * 64]; }
#pragma unroll
        for (int j = 0; j < BT; ++j) {
            half8 o;
#pragma unroll
            for (int i = 0; i < 8; ++i) { o[i] = (half_t)s[i]; s[i] = s[i] * dc[j] + (float)ds[j][i]; }
            *(half8*)(base + (size_t)(pos + j) * 4096) = o;
        }
    }
}

DEV void up_glaa_item(CP& P, int l, int item, unsigned char* smem) {
    constexpr int NTM = NT / 256, NQ = NTM * 3, NKV = NTM * 4;
    if (item < NQ + NKV) {
        const bool isq = item < NQ;
        const int it = isq ? item : item - NQ, nn = isq ? 3 : 4, tm = it / nn, tn = it % nn;
        const int ldo = isq ? 384 : 512, kk = isq ? 192 : 128;
        ARowLin ar{P.p + (size_t)tm * 256 * PPAD + (isq ? O_CQ : O_CKV), PPAD};
        BSrcH bs{(isq ? P.wuq16 + (size_t)l * 192 * 384 : P.wukv16 + (size_t)l * 128 * 512) + tn * 128, ldo};
        EpiStoreH epi{(isq ? P.qraw : P.kvraw) + (size_t)tm * 256 * ldo + tn * 128, ldo};
        gemm256(ar, bs, kk, epi, smem);
    } else {
        int it = item - NQ - NKV;
        const int gidx = it % NCH; it /= NCH; const int dir = it & 1; it >>= 1; const int h = it & 3; it >>= 2; const int b = it % B_; const int mix = it / B_;
        SYNC();
        if (mix == 0) gla_step_a<0>(P, l, b, h, dir, gidx, smem); else gla_step_a<1>(P, l, b, h, dir, gidx, smem);
    }
}
DEV void phase_up_glaa(CP& P, int l, unsigned char* smem) {
    constexpr int NTM = NT / 256, NQ = NTM * 3, NKV = NTM * 4, NGA = 2 * B_ * 4 * 2 * NCH;
    for (int item = blockIdx.x; item < NQ + NKV + NGA; item += gridDim.x) up_glaa_item(P, l, item, smem);
    if (PROBE & 2) for (int item = blockIdx.x; item < NQ + NKV; item += gridDim.x) up_glaa_item(P, l, item, smem);
    if (PROBE & 4) for (int item = blockIdx.x; item < NGA; item += gridDim.x) up_glaa_item(P, l, NQ + NKV + item, smem);
}

DEV float sumsq8(half8 v) { float s = 0.f;
#pragma unroll
    for (int j = 0; j < 8; ++j) s += (float)v[j] * (float)v[j];
    return s; }
DEV float group8_sum(float v) { v += shfl_xor_f(v, 1); v += shfl_xor_f(v, 2); v += shfl_xor_f(v, 4); return v; }
DEV void mixer_prep_item(CP& P, int l, int item) {
    const int tid = TID(), c = tid & 7, grp = tid >> 3, job = grp & 15, h = job & 3;
    const half8 zero8 = {0, 0, 0, 0, 0, 0, 0, 0};
    for (int pass = 0; pass < 8; ++pass) {
        const int t = item * 16 + pass * 2 + (grp >> 4);
        const int b = t < NLAT ? t / SEQ : (t - NLAT) / CTX;
        const bool lat = t < NLAT;
        const int n = lat ? t % SEQ : 0;
        const int pos = lat ? n : SEQ + (t - NLAT) % CTX;
        const half_t* pr = P.p + (size_t)t * PPAD;
        const size_t row = (size_t)(b * 4 + h) * KEYS + pos;
        half8 pre[3] = {zero8, zero8, zero8}, r1 = zero8, r2 = zero8, r3 = zero8;
        const float* g1 = P.mla_g_qn; const float* g2 = P.mla_g_qr;
        if (job < 4) {
            const half_t* qr = P.qraw + (size_t)t * 384 + h * 96;
#pragma unroll
            for (int i = 0; i < 3; ++i) pre[i] = *(const half8*)(pr + O_CQ + 8 * (c + 8 * i));
            r1 = *(const half8*)(qr + 8 * c); if (c < 4) r2 = *(const half8*)(qr + 64 + 8 * c);
            g1 = P.mla_g_qn + l * 64; g2 = P.mla_g_qr + l * 32;
        } else if (job < 8) {
            const half_t* kr = P.kvraw + (size_t)t * 512 + h * 128;
#pragma unroll
            for (int i = 0; i < 2; ++i) pre[i] = *(const half8*)(pr + O_CKV + 8 * (c + 8 * i));
            r1 = *(const half8*)(kr + 8 * c); r3 = *(const half8*)(kr + 64 + 8 * c); if (c < 4) r2 = *(const half8*)(pr + O_KR + 8 * c);
            g1 = P.mla_g_kn + l * 64; g2 = P.mla_g_kr + l * 32;
        } else if (job < 12) {
            r1 = *(const half8*)(pr + O_NAQ + h * 64 + 8 * c); r3 = *(const half8*)(pr + O_NAK + h * 64 + 8 * c);
            g1 = P.na_g_q + l * 64; g2 = P.na_g_k + l * 64;
        } else {
            r1 = *(const half8*)(pr + O_NAV + h * 64 + 8 * c);
        }
        const f32x4 ga = *(const f32x4*)(g1 + 8 * c), gb = *(const f32x4*)(g1 + 8 * c + 4);
        const int c2 = (job >= 8 && job < 12) ? c : (c & 3);
        const f32x4 gc = *(const f32x4*)(g2 + 8 * c2), gd = *(const f32x4*)(g2 + 8 * c2 + 4);
        f32x4 cs0 = {1.f, 1.f, 1.f, 1.f}, cs1 = cs0, sn0 = {0.f, 0.f, 0.f, 0.f}, sn1 = sn0;
        if (lat && job < 8) { const float* cst = P.rope + (size_t)n * 32 + 8 * ((c >> 1) & 1); cs0 = *(const f32x4*)cst; cs1 = *(const f32x4*)(cst + 4); sn0 = *(const f32x4*)(cst + 16); sn1 = *(const f32x4*)(cst + 20); }
        SCHED_FENCE();
        const float spre = group8_sum(sumsq8(pre[0]) + sumsq8(pre[1]) + sumsq8(pre[2]));
        const float s1 = group8_sum(sumsq8(r1)), s2 = group8_sum(sumsq8(r2)), s3 = group8_sum(sumsq8(r3));
        float part[8];
#pragma unroll
        for (int j = 0; j < 8; ++j) part[j] = shfl_xor_f((float)r2[j], 1);
        const float rpre = job < 4 ? frsqrt(spre * (1.0f / 192.0f) + EPS) : (job < 8 ? frsqrt(spre * (1.0f / 128.0f) + EPS) : 1.0f);
        if (job < 8) {
            const float qs = job < 4 ? 0.10206207261596575f * LOG2E : 1.0f;
            const float pre1 = rpre;
            const float rn = frsqrt(s1 * pre1 * pre1 * (1.0f / 64.0f) + EPS) * pre1 * qs;
            half8 o1;
#pragma unroll
            for (int j = 0; j < 4; ++j) { o1[j] = (half_t)((float)r1[j] * rn * ga[j]); o1[4 + j] = (half_t)((float)r1[4 + j] * rn * gb[j]); }
            half_t* d1 = (job < 4 ? P.mq : P.mk) + row * 96;
            *(half8*)(d1 + 8 * c) = o1;
            const float pre2 = job < 4 ? rpre : 1.0f;
            const float rr = frsqrt(s2 * pre2 * pre2 * (1.0f / 32.0f) + EPS) * pre2;
            half8 o2;
            const f32x4 pc = *(const f32x4*)(g2 + 8 * ((c & 3) ^ 1)), pd = *(const f32x4*)(g2 + 8 * ((c & 3) ^ 1) + 4);
            const float sgn = (c & 1) ? 1.f : -1.f;
#pragma unroll
            for (int j = 0; j < 8; ++j) {
                const float gown = j < 4 ? gc[j] : gd[j - 4], gp = j < 4 ? pc[j] : pd[j - 4];
                const float own = (float)r2[j] * rr * gown, oth = part[j] * rr * gp;
                const float cj = j < 4 ? cs0[j] : cs1[j - 4], sj = j < 4 ? sn0[j] : sn1[j - 4];
                o2[j] = (half_t)((own * cj + sgn * oth * sj) * qs);
            }
            if (c < 4) *(half8*)(d1 + 64 + 8 * c) = o2;
            if (job >= 4) {
                half8 o3;
#pragma unroll
                for (int j = 0; j < 8; ++j) o3[j] = (half_t)((float)r3[j] * rpre);
                *(half8*)(P.mv + row * 64 + 8 * c) = o3;
            }
        } else if (job < 12) {
            const float rq = frsqrt(s1 * (1.0f / 64.0f) + EPS) * (0.125f * LOG2E), rk = frsqrt(s3 * (1.0f / 64.0f) + EPS);
            half8 o1, o3;
#pragma unroll
            for (int j = 0; j < 4; ++j) {
                o1[j] = (half_t)((float)r1[j] * rq * ga[j]); o1[4 + j] = (half_t)((float)r1[4 + j] * rq * gb[j]);
                o3[j] = (half_t)((float)r3[j] * rk * gc[j]); o3[4 + j] = (half_t)((float)r3[4 + j] * rk * gd[j]);
            }
            *(half8*)(P.nq + row * 64 + 8 * c) = o1; *(half8*)(P.nk + row * 64 + 8 * c) = o3;
        } else {
            *(half8*)(P.nv + row * 64 + 8 * c) = r1;
        }
    }
}
DEV void phase_prep_scan(CP& P, int l, int rep) {
    constexpr int NSCAN = 2 * B_ * 4 * 2 * 2;
    constexpr int NPREP = NT / 16;
    for (int item = blockIdx.x; item < NSCAN + NPREP; item += gridDim.x) {
        if (item < NSCAN) {
            if (!rep) gla_scan(P, item, (half_t*)P.gst, 0);
            else gla_scan(P, item, P.y, 0);
        }
        else mixer_prep_item(P, l, item - NSCAN);
    }
    if (PROBE & 8) for (int item = blockIdx.x; item < NPREP; item += gridDim.x) mixer_prep_item(P, l, item);
}

DEV half8 vt_frag(const half_t* Vs, int ldv, int kbase, int dv0, int lane) {
    const int grp = lane >> 4, hh = lane >> 5, i = lane & 15, q = i >> 2, pp = i & 3;
    const half_t* a = Vs + (kbase + 4 * hh + q) * ldv + dv0 + 16 * (grp & 1) + 4 * pp;
    const half4 lo = tr16(a), hi = tr16(a + 8 * ldv);
    half8 r; r[0] = lo[0]; r[1] = lo[1]; r[2] = lo[2]; r[3] = lo[3]; r[4] = hi[0]; r[5] = hi[1]; r[6] = hi[2]; r[7] = hi[3]; return r;
}
DEV void softmax_pv_step(const f32x16& s, float& m, float& lsum, f32x16 (&o)[2], const half_t* Vs, int ldv, int lane) {
    float mx = s[0];
#pragma unroll
    for (int r = 1; r < 16; ++r) mx = fmaxf(mx, s[r]);
    mx = fmaxf(mx, shfl_xor_f(mx, 32));
    const float mn = fmaxf(m, mx);
    const float alpha = fexp2(m - mn);
    m = mn;
    float ps = 0.f; half8 pf[2];
#pragma unroll
    for (int r = 0; r < 16; ++r) { const float pv = fexp2(s[r] - mn); ps += pv; pf[r >> 3][r & 7] = (half_t)pv; }
    lsum = lsum * alpha + ps;
#pragma unroll
    for (int dt = 0; dt < 2; ++dt)
#pragma unroll
        for (int r = 0; r < 16; ++r) o[dt][r] *= alpha;
#pragma unroll
    for (int s2 = 0; s2 < 2; ++s2)
#pragma unroll
        for (int dt = 0; dt < 2; ++dt) o[dt] = mfma32(vt_frag(Vs, ldv, 16 * s2, 32 * dt, lane), pf[s2], o[dt]);
}
DEV void softmax_pv_step2(const f32x16& s0, const f32x16& s1, float& m, float& lsum, f32x16 (&o)[2], const half_t* Vs, int ldv, int lane) {
    float mx = fmaxf(s0[0], s1[0]);
#pragma unroll
    for (int r = 1; r < 16; ++r) mx = fmaxf(mx, fmaxf(s0[r], s1[r]));
    mx = fmaxf(mx, shfl_xor_f(mx, 32));
    const float mn = fmaxf(m, mx);
    if (wave_any(mn != m)) {
        const float alpha = fexp2(m - mn);
        lsum *= alpha;
#pragma unroll
        for (int dt = 0; dt < 2; ++dt)
#pragma unroll
            for (int r = 0; r < 16; ++r) o[dt][r] *= alpha;
        m = mn;
    }
    float ps = 0.f; half8 pf[4];
#pragma unroll
    for (int r = 0; r < 16; ++r) { const float pa = fexp2(s0[r] - m), pb = fexp2(s1[r] - m); ps += pa + pb; pf[r >> 3][r & 7] = (half_t)pa; pf[2 + (r >> 3)][r & 7] = (half_t)pb; }
    lsum += ps;
#pragma unroll
    for (int kt2 = 0; kt2 < 2; ++kt2)
#pragma unroll
        for (int s2 = 0; s2 < 2; ++s2)
#pragma unroll
            for (int dt = 0; dt < 2; ++dt) o[dt] = mfma32(vt_frag(Vs + 32 * kt2 * ldv, ldv, 16 * s2, 32 * dt, lane), pf[2 * kt2 + s2], o[dt]);
}
DEV void attn_store(const f32x16 (&o)[2], float lsum, half_t* yrow, int lane) {
    const float inv = 1.0f / (lsum + shfl_xor_f(lsum, 32));
    const int hh = lane >> 5;
#pragma unroll
    for (int dt = 0; dt < 2; ++dt)
#pragma unroll
        for (int rq = 0; rq < 4; ++rq) {
            half4 v;
#pragma unroll
            for (int e = 0; e < 4; ++e) v[e] = (half_t)(o[dt][4 * rq + e] * inv);
            *(half4*)(yrow + 32 * dt + 8 * rq + 4 * hh) = v;
        }
}
DEV int attn_qtoken(int b, int qpos) { return qpos < SEQ ? b * SEQ + qpos : NLAT + b * CTX + (qpos - SEQ); }

constexpr int MS_K = 64 * 96, MS_V = 64 * 64, MS_STAGE = MS_K + MS_V;
DEV half8 vt_frag_swz(const half_t* Vs, int kbase, int dv0, int lane) {
    const int grp = lane >> 4, hh = lane >> 5, i = lane & 15, q = i >> 2, pp = i & 3;
    const int r0 = kbase + 4 * hh + q, col = dv0 + 16 * (grp & 1) + 4 * pp;
    const int ch = (col >> 3) ^ (4 * ((r0 >> 1) & 1));
    const half_t* a = Vs + r0 * 64 + ch * 8 + (col & 7);
    const half4 lo = tr16_nowait<0>(a), hi = tr16_nowait<8 * 64 * 2>(a);
    half8 r; r[0] = lo[0]; r[1] = lo[1]; r[2] = lo[2]; r[3] = lo[3]; r[4] = hi[0]; r[5] = hi[1]; r[6] = hi[2]; r[7] = hi[3]; return r;
}
#define MLA_ISSUE(ST, KT)                                                                                                         \
    {                                                                                                                             \
        half_t* sk_ = mring + (ST) * MS_STAGE; half_t* sv_ = sk_ + MS_K;                                                          \
        const half_t* kg_ = kg + (size_t)(KT) * 64 * 96; const half_t* vg_ = vg + (size_t)(KT) * 64 * 64;                         \
        _Pragma("unroll") for (int j = 0; j < 3; ++j) glds16(kg_ + ksrc[j], sk_ + (3 * w + j) * 512);                             \
        _Pragma("unroll") for (int j = 0; j < 2; ++j) glds16(vg_ + vsrc[j], sv_ + (2 * w + j) * 512);                             \
    }
#define MLA_COMPUTE(ST)                                                                                                           \
    {                                                                                                                             \
        const half_t* Ks = mring + (ST) * MS_STAGE; const half_t* Vs = Ks + MS_K;                                                 \
        f32x16 s0, s1;                                                                                                            \
        _Pragma("unroll") for (int r = 0; r < 16; ++r) { s0[r] = 0.f; s1[r] = 0.f; }                                              \
        half8 kf0[6], kf1[6];                                                                                                     \
        _Pragma("unroll") for (int ks = 0; ks < 6; ++ks) {                                                                        \
            const int p = 2 * ks + hh, pz = (p & ~3) | ((p & 3) ^ ((ql >> 2) & 3));      \
            kf0[ks] = *(const half8*)(Ks + ql * 96 + pz * 8); kf1[ks] = *(const half8*)(Ks + (32 + ql) * 96 + pz * 8);            \
        }                                                                                                                         \
        SCHED_FENCE();                                                \
        _Pragma("unroll") for (int ks = 0; ks < 6; ++ks) { s0 = mfma32(kf0[ks], qf[ks], s0); s1 = mfma32(kf1[ks], qf[ks], s1); }  \
        softmax_pv_step2s(s0, s1, m, lsum, o, Vs, lane);                                                                          \
    }
#define MLA_STEP(ST, ST2, ktv)                                                                                                    \
    {                                                                                                                             \
        const int kt_ = (ktv);                                                                                                    \
        if (kt_ + 1 < nkt) { WAIT_VM(5); } else { WAIT_VM(0); }                                                                   \
        RAW_BARRIER();                                                                                                            \
        if (kt_ + 2 < nkt) MLA_ISSUE(ST2, kt_ + 2)                                                                                \
        MLA_COMPUTE(ST)                                                                                                           \
    }
DEV void softmax_pv_step2s(const f32x16& s0, const f32x16& s1, float& m, float& lsum, f32x16 (&o)[2], const half_t* Vs, int lane) {
    float mx = fmaxf(s0[0], s1[0]);
#pragma unroll
    for (int r = 1; r < 16; ++r) mx = fmaxf(mx, fmaxf(s0[r], s1[r]));
    mx = fmaxf(mx, shfl_xor_f(mx, 32));
    const float mn = fmaxf(m, mx);
    if (wave_any(mn != m)) {
        const float alpha = fexp2(m - mn);
        lsum *= alpha;
#pragma unroll
        for (int dt = 0; dt < 2; ++dt)
#pragma unroll
            for (int r = 0; r < 16; ++r) o[dt][r] *= alpha;
        m = mn;
    }
    half8 vf[8];
#pragma unroll
    for (int kt2 = 0; kt2 < 2; ++kt2)
#pragma unroll
        for (int s2 = 0; s2 < 2; ++s2)
#pragma unroll
            for (int dt = 0; dt < 2; ++dt) vf[4 * kt2 + 2 * s2 + dt] = vt_frag_swz(Vs, 32 * kt2 + 16 * s2, 32 * dt, lane);
    float ps = 0.f; half8 pf[4];
#pragma unroll
    for (int r = 0; r < 16; ++r) { const float pa = fexp2(s0[r] - m), pb = fexp2(s1[r] - m); ps += pa + pb; pf[r >> 3][r & 7] = (half_t)pa; pf[2 + (r >> 3)][r & 7] = (half_t)pb; }
    lsum += ps;
    TR_WAIT();
#pragma unroll
    for (int kt2 = 0; kt2 < 2; ++kt2)
#pragma unroll
        for (int s2 = 0; s2 < 2; ++s2)
#pragma unroll
            for (int dt = 0; dt < 2; ++dt) o[dt] = mfma32(vf[4 * kt2 + 2 * s2 + dt], pf[2 * kt2 + s2], o[dt]);
}
DEV void mla_attn_item(CP& P, int b, int h, int qt, unsigned char* smem) {
    half_t* mring = (half_t*)smem;
    const int tid = TID(), lane = tid & 63, w = WID(tid), hh = lane >> 5, ql = lane & 31;
    const size_t bh = (size_t)(b * 4 + h) * KEYS;
    const int q0 = qt * 128 + 32 * w;
    const bool ctxq = q0 >= SEQ;
    const int kbeg = ctxq ? SEQ : 0, nkt = (ctxq ? CTX : KEYS) / 64;
    half8 qf[6];
#pragma unroll
    for (int ks = 0; ks < 6; ++ks) qf[ks] = *(const half8*)(P.mq + (bh + q0 + ql) * 96 + 16 * ks + 8 * hh);
    f32x16 o[2]; float m = -1e30f, lsum = 0.f;
#pragma unroll
    for (int dt = 0; dt < 2; ++dt)
#pragma unroll
        for (int r = 0; r < 16; ++r) o[dt][r] = 0.f;
    const half_t* kg = P.mk + (bh + kbeg) * 96; const half_t* vg = P.mv + (bh + kbeg) * 64;
    int ksrc[3], vsrc[2];
#pragma unroll
    for (int j = 0; j < 3; ++j) { const int L = (3 * w + j) * 64 + lane, r = L / 12, p = L % 12; ksrc[j] = r * 96 + 8 * ((p & ~3) | ((p & 3) ^ ((r >> 2) & 3))); }
#pragma unroll
    for (int j = 0; j < 2; ++j) { const int L = (2 * w + j) * 64 + lane, r = L >> 3, p = L & 7; vsrc[j] = r * 64 + 8 * (p ^ (4 * ((r >> 1) & 1))); }
    SYNC();
    MLA_ISSUE(0, 0)
    MLA_ISSUE(1, 1)
#pragma clang loop unroll(disable)
    for (int kt = 0; kt < nkt; kt += 3) {
        MLA_STEP(0, 2, kt)
        if (kt + 1 < nkt) MLA_STEP(1, 0, kt + 1)
        if (kt + 2 < nkt) MLA_STEP(2, 1, kt + 2)
    }
    attn_store(o, lsum, P.y + (size_t)attn_qtoken(b, q0 + ql) * D + 0 + h * 64, lane);
}

constexpr int NV_LD = 72, NA_WAVE_LDS = 32 * NV_LD * 2 + 15 * 32 * 4;
DEV void na_attn_unit(CP& P, int l, int unit, unsigned char* wlds, int lane) {
    constexpr int NLATU = B_ * 4 * ROWS * 2;
    half_t* Vw = (half_t*)wlds; float* bt = (float*)(wlds + 32 * NV_LD * 2);
    const int hh = lane >> 5, ql = lane & 31;
    int b, h, q0, ntile, R0 = 0, r = 0, hf = 0; bool lat;
    if (unit < NLATU) { lat = true; hf = unit & 1; r = (unit >> 1) % ROWS; const int bh = unit / (2 * ROWS); h = bh & 3; b = bh >> 2; q0 = r * 64 + 32 * hf; ntile = 16 + CTX / 32;
        R0 = r - 4 < 0 ? 0 : (r - 4 > ROWS - 8 ? ROWS - 8 : r - 4); }
    else { lat = false; const int u = unit - NLATU; const int cb = u % (CTX / 32); const int bh = u / (CTX / 32); h = bh & 3; b = bh >> 2; q0 = SEQ + 32 * cb; ntile = CTX / 32; }
    const size_t bhk = (size_t)(b * 4 + h) * KEYS;
    WAVE_BARRIER();
    if (lat) {
        const float* rp = P.na_rpb + (size_t)(l * 4 + h) * 15 * 31;
        for (int i = lane; i < 15 * 32; i += 64) { const int dr = i >> 5, dc = i & 31; bt[i] = dc < 31 ? rp[dr * 31 + dc] * LOG2E : 0.f; }
    }
    half8 qf[4];
#pragma unroll
    for (int ks = 0; ks < 4; ++ks) qf[ks] = *(const half8*)(P.nq + (bhk + q0 + ql) * 64 + 16 * ks + 8 * hh);
    f32x16 o[2]; float m = -1e30f, lsum = 0.f;
#pragma unroll
    for (int dt = 0; dt < 2; ++dt)
#pragma unroll
        for (int rr = 0; rr < 16; ++rr) o[dt][rr] = 0.f;
    const int wq = 32 * hf + ql;
    const int cs = wq - 8 < 0 ? 0 : (wq - 8 > 48 ? 48 : wq - 8);
    auto tile_kpos = [&](int tile) { return (lat && tile < 16) ? (R0 + (tile >> 1)) * 64 + 32 * (tile & 1) : SEQ + 32 * (lat ? tile - 16 : tile); };
    half8 kf[4], vf[4];
    {
        const int kp = tile_kpos(0);
#pragma unroll
        for (int ks = 0; ks < 4; ++ks) kf[ks] = *(const half8*)(P.nk + (bhk + kp + ql) * 64 + 16 * ks + 8 * hh);
#pragma unroll
        for (int i = 0; i < 4; ++i) { const int c = lane + 64 * i; vf[i] = *(const half8*)(P.nv + (bhk + kp + (c >> 3)) * 64 + (c & 7) * 8); }
    }
    for (int tile = 0; tile < ntile; ++tile) {
        const bool win = lat && tile < 16;
        const int krow = R0 + (tile >> 1), kh2 = tile & 1;
        f32x16 s;
#pragma unroll
        for (int rr = 0; rr < 16; ++rr) s[rr] = 0.f;
#pragma unroll
        for (int ks = 0; ks < 4; ++ks) s = mfma32(kf[ks], qf[ks], s);
        WAVE_BARRIER();
#pragma unroll
        for (int i = 0; i < 4; ++i) { const int c = lane + 64 * i; *(half8*)(Vw + (c >> 3) * NV_LD + (c & 7) * 8) = vf[i]; }
        if (tile + 1 < ntile) {
            const int kp = tile_kpos(tile + 1);
#pragma unroll
            for (int ks = 0; ks < 4; ++ks) kf[ks] = *(const half8*)(P.nk + (bhk + kp + ql) * 64 + 16 * ks + 8 * hh);
#pragma unroll
            for (int i = 0; i < 4; ++i) { const int c = lane + 64 * i; vf[i] = *(const half8*)(P.nv + (bhk + kp + (c >> 3)) * 64 + (c & 7) * 8); }
        }
        SCHED_FENCE();
        if (win) {
            const float* brow = bt + (krow - r + 7) * 32;
            float bv[16];
#pragma unroll
            for (int rr = 0; rr < 16; ++rr) {
                const int wk = 32 * kh2 + (rr & 3) + 8 * (rr >> 2) + 4 * hh;
                int dc = wk - wq + 15; dc = dc < 0 ? 0 : (dc > 30 ? 30 : dc);
                bv[rr] = brow[dc];
            }
#pragma unroll
            for (int rr = 0; rr < 16; ++rr) {
                const int wk = 32 * kh2 + (rr & 3) + 8 * (rr >> 2) + 4 * hh;
                const bool valid = wk >= cs && wk < cs + 16;
                s[rr] = valid ? s[rr] + bv[rr] : -INFINITY;
            }
        }
        WAVE_BARRIER();
        softmax_pv_step(s, m, lsum, o, Vw, NV_LD, lane);
    }
    attn_store(o, lsum, P.y + (size_t)attn_qtoken(b, q0 + ql) * D + 256 + h * 64, lane);
}

DEV void mixers_item(CP& P, int l, int item, unsigned char* smem) {
    const bool last = l == NL - 1;
    const int QT = (last ? SEQ : KEYS) / 128;
    const int NMLA = B_ * 4 * QT;
    const int NNA = (B_ * 4 * ROWS * 2 + (last ? 0 : B_ * 4 * (CTX / 32))) / 4;
    const int NGRP = last ? LG : NCH;
    const int lane = TID() & 63, w = TID() >> 6;
    if (item < NMLA) {
        const int qt = item % QT, bh = item / QT;
        mla_attn_item(P, bh >> 2, bh & 3, qt, smem);
    } else if (item < NMLA + NNA) {
        SYNC();
        na_attn_unit(P, l, (item - NMLA) * 4 + w, smem + w * NA_WAVE_LDS, lane);
    } else {
        int it = item - NMLA - NNA;
        const int gi = it % NGRP; it /= NGRP; const int h = it & 3; it >>= 2; const int b = it % B_; const int mix = it / B_;
        const int gidx = last ? gi + CG : gi;
        SYNC();
        if (mix == 0) gla_step_c<0>(P, l, b, h, gidx, smem); else gla_step_c<1>(P, l, b, h, gidx, smem);
    }
}
DEV int sched_next(int* ctr, unsigned char* smem) {
    int* slot = (int*)(smem + SMEM_BYTES - 16);
    SYNC();
    if (TID() == 0) *slot = atomic_add_i(ctr, 1);
    SYNC();
    return *slot;
}
constexpr int NCONV = 1024;
constexpr int CV_W13 = NEXP * D * 1024 / 8, CV_W2 = NEXP * 512 * D / 8;
DEV void moe_convert_unit(CP& P, int l, int u) {
    constexpr int PER = (CV_W13 + CV_W2) / NCONV;
    static_assert((CV_W13 + CV_W2) % NCONV == 0 && PER % NTHREADS == 0, "conversion split");
    const int tid = TID();
    for (int i0 = 0; i0 < PER; i0 += 4 * NTHREADS) {
        RawF r[4]; int c[4];
#pragma unroll
        for (int j = 0; j < 4; ++j) {
            c[j] = u * PER + i0 + j * NTHREADS + tid;
            const float* src;
            if (c[j] < CV_W13) {
                const int v = (c[j] & 127) * 8, k = (c[j] >> 7) & 1023, e = c[j] >> 17;
                const int tn = v >> 7, half = (v >> 6) & 1, col = 64 * tn + (v & 63);
                src = (half ? P.moe_w3 : P.moe_w1) + (((size_t)l * NEXP + e) * D + k) * 512 + col;
            } else { src = P.moe_w2 + (size_t)l * NEXP * 512 * D + (size_t)(c[j] - CV_W13) * 8; }
            r[j].a = *(const f32x4*)src; r[j].b = *(const f32x4*)(src + 4);
        }
        SCHED_FENCE();
#pragma unroll
        for (int j = 0; j < 4; ++j) {
            half_t* dst = c[j] < CV_W13 ? P.w13h + (size_t)c[j] * 8 : P.w2h + (size_t)(c[j] - CV_W13) * 8;
            *(half8*)dst = cvt_rawf(r[j]);
        }
    }
}
DEV void phase_mixers(CP& P, int l, unsigned char* smem, int rep) {
    const bool last = l == NL - 1;
    const int QT = (last ? SEQ : KEYS) / 128;
    const int NMLA = B_ * 4 * QT;
    const int NNA = (B_ * 4 * ROWS * 2 + (last ? 0 : B_ * 4 * (CTX / 32))) / 4;
    const int NGC = 2 * B_ * 4 * (last ? LG : NCH);
    const int NCV = rep ? 0 : NCONV;
    const int NIL = NMLA < NCV ? NMLA : NCV;
    const int NU = NMLA + NCV + NNA + NGC / 4;
    int* ctr = P.sched + l * 16 + rep;
    for (int u = sched_next(ctr, smem); u < NU; u = sched_next(ctr, smem)) {
        if (u < 2 * NIL) { if (u & 1) moe_convert_unit(P, l, u >> 1); else mixers_item(P, l, u >> 1, smem); }
        else if (u < NMLA + NCV) { const int v = u - 2 * NIL; if (NMLA > NCV) mixers_item(P, l, NIL + v, smem); else moe_convert_unit(P, l, NIL + v); }
        else if (u < NMLA + NCV + NNA) mixers_item(P, l, u - NCV, smem);
        else { const int g0 = NMLA + NNA + (u - NMLA - NCV - NNA) * 4; for (int j = 0; j < 4; ++j) mixers_item(P, l, g0 + j, smem); }
    }
    if (PROBE & 16) for (int item = blockIdx.x; item < NMLA; item += gridDim.x) mixers_item(P, l, item, smem);
    if (PROBE & 32) for (int item = blockIdx.x; item < NNA; item += gridDim.x) mixers_item(P, l, NMLA + item, smem);
    if (PROBE & 64) for (int item = blockIdx.x; item < NGC; item += gridDim.x) mixers_item(P, l, NMLA + NNA + item, smem);
}

DEV void phase_outproj(CP& P, int l, unsigned char* smem, int rep0) {
    const bool last = l == NL - 1;
    const int NTM = (last ? NLAT : NT) / 256;
    const int full = (NTM * 8) / gridDim.x;
    for (int rep = rep0; rep < ((PROBE & 512) ? 2 : rep0 + 1); ++rep) {
        for (int round = 0; round < full; ++round) {
            int tm, tn;
            if (!gemm_tile_order(round, NTM, 8, tm, tn)) continue;
            const int t0 = tm * 256;
            ARowLin ar{P.y + (size_t)t0 * D, D};
            BSrcH bs{P.wout16 + (size_t)l * D * D + tn * 128, D};
            EpiResid epi{(rep ? P.gst + (size_t)t0 * D : xrow_ptr(P, t0)) + tn * 128, (l == 0 ? xin_ptr(P, t0) : (const float*)xrow_ptr(P, t0)) + tn * 128, P.mod + ((size_t)l * (B_ + 1) + tok_brow(t0)) * MODW + 2 * D + tn * 128};
            gemm_tile<4>(ar, bs, D, epi, smem);
        }
        const int base = full * gridDim.x, left = NTM * 8 - base;
        for (int i = blockIdx.x; i < 4 * left; i += gridDim.x) {
            int tm, tn; gemm_tile_idx(base + (i >> 2), NTM, 8, tm, tn);
            const int t0 = tm * 256 + 64 * (i & 3);
            ARowLin ar{P.y + (size_t)t0 * D, D};
            BSrcH bs{P.wout16 + (size_t)l * D * D + tn * 128, D};
            EpiResid epi{(rep ? P.gst + (size_t)t0 * D : xrow_ptr(P, t0)) + tn * 128, (l == 0 ? xin_ptr(P, t0) : (const float*)xrow_ptr(P, t0)) + tn * 128, P.mod + ((size_t)l * (B_ + 1) + tok_brow(t0)) * MODW + 2 * D + tn * 128};
            gemm_tile<1>(ar, bs, D, epi, smem);
        }
    }
}

template <bool DRY> DEV void phase_router_t(CP& P, int l, unsigned char* smem) {
    const bool last = l == NL - 1;
    const int NI = (last ? NLAT : NT) / 64;
    const int tid = TID(), lane = tid & 63, w = tid >> 6, g = lane >> 4, li = lane & 15;
    float* wrs = (float*)smem;
    float* lg = (float*)(smem + 64 * 52 * 4) + w * 16 * 48;
    const float* wr = P.wr + (size_t)l * D * 48;
    int wrow[3], wc4[3];
#pragma unroll
    for (int i = 0; i < 3; ++i) { const int idx = tid + 256 * i; wrow[i] = idx / 12; wc4[i] = (idx % 12) * 4; }
    for (int item = blockIdx.x; item < NI; item += gridDim.x) {
        const int tok0 = item * 64 + 16 * w, br = tok_brow(item * 64);
        const float* xr = xrow_ptr(P, tok0 + li);
        const float* md = P.mod + ((size_t)l * (B_ + 1) + br) * MODW;
        const float* sh = md + 3 * D; const float* sc = md + 4 * D;
        f32x4 acc[3];
#pragma unroll
        for (int nt = 0; nt < 3; ++nt) acc[nt] = (f32x4){0.f, 0.f, 0.f, 0.f};
        float ssq = 0.f;
        f32x4 wv[3], xv[4], sv[4];
#pragma unroll
        for (int i = 0; i < 3; ++i) wv[i] = *(const f32x4*)(wr + (size_t)wrow[i] * 48 + wc4[i]);
#pragma unroll
        for (int j = 0; j < 4; ++j) { xv[j] = *(const f32x4*)(xr + 16 * j + 4 * g); sv[j] = *(const f32x4*)(sc + 16 * j + 4 * g); }
        for (int ch = 0; ch < 16; ++ch) {
            SYNC();
#pragma unroll
            for (int i = 0; i < 3; ++i) *(f32x4*)(wrs + wrow[i] * 52 + wc4[i]) = wv[i];
            SYNC();
            f32x4 xc[4], sk[4];
#pragma unroll
            for (int j = 0; j < 4; ++j) { xc[j] = xv[j]; sk[j] = sv[j]; }
            if (ch + 1 < 16) {
#pragma unroll
                for (int i = 0; i < 3; ++i) wv[i] = *(const f32x4*)(wr + (size_t)(64 * (ch + 1) + wrow[i]) * 48 + wc4[i]);
#pragma unroll
                for (int j = 0; j < 4; ++j) { xv[j] = *(const f32x4*)(xr + 64 * (ch + 1) + 16 * j + 4 * g); sv[j] = *(const f32x4*)(sc + 64 * (ch + 1) + 16 * j + 4 * g); }
            }
            SCHED_FENCE();
#pragma unroll
            for (int j = 0; j < 4; ++j) {
                ssq += xc[j][0] * xc[j][0] + xc[j][1] * xc[j][1] + xc[j][2] * xc[j][2] + xc[j][3] * xc[j][3];
#pragma unroll
                for (int c = 0; c < 4; ++c) {
                    const float a = xc[j][c] * (1.0f + sk[j][c]);
                    const float* wrow_l = wrs + (16 * j + 4 * g + c) * 52 + li;
#pragma unroll
                    for (int nt = 0; nt < 3; ++nt) acc[nt] = mfmaf(a, wrow_l[16 * nt], acc[nt]);
                }
            }
        }
        ssq += shfl_xor_f(ssq, 16); ssq += shfl_xor_f(ssq, 32);
        const float rstd = frsqrt(ssq * (1.0f / D) + EPS);
        const float* csh = P.cshift + ((size_t)l * (B_ + 1) + br) * 48;
        WAVE_BARRIER();
#pragma unroll
        for (int r = 0; r < 4; ++r) {
            const float rs = shfl_f(rstd, 4 * g + r);
#pragma unroll
            for (int nt = 0; nt < 3; ++nt) lg[(4 * g + r) * 48 + 16 * nt + li] = acc[nt][r] * rs + csh[16 * nt + li];
        }
        WAVE_BARRIER();
        if (lane < 16) {
            const float* lt = lg + lane * 48;
            int gi = 0; float gm = lt[0];
            for (int j = 1; j < 4; ++j) if (lt[j] > gm) { gm = lt[j]; gi = j; }
            float gden = 0.f; for (int j = 0; j < 4; ++j) gden += fexp(lt[j] - gm);
            const float pg = 1.0f / gden;
            const float* ft = lt + 4 + gi * 8;
            int e0 = 0; float f0 = ft[0];
            for (int j = 1; j < 8; ++j) if (ft[j] > f0) { f0 = ft[j]; e0 = j; }
            int e1 = -1; float f1 = -3.0e38f;
            for (int j = 0; j < 8; ++j) if (j != e0 && ft[j] > f1) { f1 = ft[j]; e1 = j; }
            const float p1 = fexp(f1 - f0);
            const float g0 = pg / (1.0f + p1), g1 = pg * p1 / (1.0f + p1);
            const int t = tok0 + lane, x0 = gi * 8 + e0, x1 = gi * 8 + e1;
            if (DRY) { float* dd = (float*)P.act + (size_t)t * 4; dd[0] = g0; dd[1] = g1; dd[2] = (float)x0; dd[3] = (float)x1; }
            else {
            const int s0 = atomic_add_i(P.cnt + l * NEXP + x0, 1), s1 = atomic_add_i(P.cnt + l * NEXP + x1, 1);
            P.list_tok[(size_t)x0 * NT + s0] = t; P.list_gate[(size_t)x0 * NT + s0] = g0;
            P.list_tok[(size_t)x1 * NT + s1] = t; P.list_gate[(size_t)x1 * NT + s1] = g1;
            P.tokslot[2 * t] = (x0 << 20) | s0; P.tokslot[2 * t + 1] = (x1 << 20) | s1;
            }
        }
        WAVE_BARRIER();
        half_t* hr = (DRY ? P.y : P.h) + (size_t)(tok0 + li) * D;
        for (int k8 = 0; k8 < 64; k8 += 8) {
            f32x4 xq[8], sq[8], hq[8];
#pragma unroll
            for (int j = 0; j < 8; ++j) { const int col = 16 * (k8 + j) + 4 * g; xq[j] = *(const f32x4*)(xr + col); sq[j] = *(const f32x4*)(sc + col); hq[j] = *(const f32x4*)(sh + col); }
            SCHED_FENCE();
#pragma unroll
            for (int j = 0; j < 8; ++j) {
                f32x4 o;
#pragma unroll
                for (int c = 0; c < 4; ++c) o[c] = xq[j][c] * rstd * (1.0f + sq[j][c]) + hq[j][c];
                *(half4*)(hr + 16 * (k8 + j) + 4 * g) = to_half4(o);
            }
        }
    }
}

DEV void phase_router(CP& P, int l, unsigned char* smem, int rep) {
    if (rep) { phase_router_t<true>(P, l, smem); return; }
    phase_router_t<false>(P, l, smem);
    if (PROBE & 1024) phase_router_t<true>(P, l, smem);
}
DEV void moe_tables(CP& P, int l, int* ab, int* tb) {
    if (TID() == 0) {
        int a = 0, t = 0;
        for (int e = 0; e < NEXP; ++e) { const int c = P.cnt[l * NEXP + e], nt = (c + 255) >> 8; ab[e] = a; tb[e] = t; a += nt * 256; t += nt; }
        ab[NEXP] = a; tb[NEXP] = t;
    }
    SYNC();
}
DEV int moe_find(const int* tb, int tile) { int e = 0; while (e < NEXP - 1 && tile >= tb[e + 1]) ++e; return e; }
DEV bool moe_item(const int* tb, int idx, int& e, int& mt, int& tn) {
    const int x = blockIdx.x & 7;
#pragma unroll
    for (int eg = 0; eg < 4; ++eg) {
        e = x + 8 * eg; const int n = (tb[e + 1] - tb[e]) * 8;
        if (idx < n) { mt = idx >> 3; tn = idx & 7; return true; }
        idx -= n;
    }
    return false;
}

DEV void phase_moe1(CP& P, int l, unsigned char* smem) {
    int* ab = (int*)(smem + SMEM_BYTES - 512); int* tb = ab + 40;
    moe_tables(P, l, ab, tb);
    for (int rep = 0; rep < ((PROBE & 128) ? 2 : 1); ++rep)
    for (int idx = blockIdx.x >> 3;; idx += gridDim.x >> 3) {
        int e, mt, tn; if (!moe_item(tb, idx, e, mt, tn)) break;
        const int cnt = P.cnt[l * NEXP + e], nvalid = cnt - mt * 256 < 256 ? cnt - mt * 256 : 256;
        ARowGather ar{P.h, D, P.list_tok + (size_t)e * NT + mt * 256, nvalid};
        BSrcH bs{P.w13h + (size_t)e * D * 1024 + tn * 128, 1024};
        EpiGlu epi{P.act + (size_t)(ab[e] + mt * 256) * 512 + tn * 64, 512};
        gemm256(ar, bs, D, epi, smem);
    }
}
DEV void phase_moe2(CP& P, int l, unsigned char* smem) {
    int* ab = (int*)(smem + SMEM_BYTES - 512); int* tb = ab + 40;
    moe_tables(P, l, ab, tb);
    for (int rep = 0; rep < ((PROBE & 256) ? 2 : 1); ++rep)
    for (int idx = blockIdx.x >> 3;; idx += gridDim.x >> 3) {
        int e, mt, tn; if (!moe_item(tb, idx, e, mt, tn)) break;
        const int cnt = P.cnt[l * NEXP + e], nvalid = cnt - mt * 256 < 256 ? cnt - mt * 256 : 256;
        const size_t r0 = (size_t)ab[e] + mt * 256;
        ARowLin ar{P.act + r0 * 512, 512};
        BSrcH bs{P.w2h + (size_t)e * 512 * D + tn * 128, D};
        EpiRowsGate epi{P.yrows + r0 * D + tn * 128, P.list_gate + (size_t)e * NT + mt * 256, nvalid};
        gemm256(ar, bs, 512, epi, smem);
    }
}
template <bool DRY> DEV void phase_combine_t(CP& P, int l, unsigned char* smem) {
    int* ab = (int*)(smem + SMEM_BYTES - 512); int* tb = ab + 40;
    moe_tables(P, l, ab, tb);
    const bool last = l == NL - 1;
    const int NTK = last ? NLAT : NT;
    const int lane = TID() & 63, gw = blockIdx.x * 4 + (TID() >> 6), nw = gridDim.x * 4;
    for (int t = gw; t < NTK; t += nw) {
        const int ts0 = P.tokslot[2 * t], ts1 = P.tokslot[2 * t + 1];
        const half_t* y0 = P.yrows + (size_t)(ab[ts0 >> 20] + (ts0 & 0xFFFFF)) * D;
        const half_t* y1 = P.yrows + (size_t)(ab[ts1 >> 20] + (ts1 & 0xFFFFF)) * D;
        float* xr = xrow_ptr(P, t);
        float* xw = DRY ? P.gst + (size_t)t * D : xr;
        const float* md = P.mod + ((size_t)l * (B_ + 1) + tok_brow(t)) * MODW;
        f32x4 v[4], xv[4], gt[4]; half4 ya[4], yb[4];
#pragma unroll
        for (int j = 0; j < 4; ++j) {
            const int col = 256 * j + 4 * lane;
            xv[j] = *(const f32x4*)(xr + col); gt[j] = *(const f32x4*)(md + 5 * D + col); ya[j] = *(const half4*)(y0 + col); yb[j] = *(const half4*)(y1 + col);
        }
        SCHED_FENCE();
#pragma unroll
        for (int j = 0; j < 4; ++j) {
            const int col = 256 * j + 4 * lane;
#pragma unroll
            for (int e = 0; e < 4; ++e) v[j][e] = xv[j][e] + gt[j][e] * ((float)ya[j][e] + (float)yb[j][e]);
            *(f32x4*)(xw + col) = v[j];
        }
        if (!last) { const float* mn = md + (size_t)(B_ + 1) * MODW; row_modulate_store(v, mn + 0, mn + D, (DRY ? P.y : P.h) + (size_t)t * D, lane); }
    }
}

DEV void phase_combine(CP& P, int l, unsigned char* smem, int rep) {
    if (rep) { phase_combine_t<true>(P, l, smem); return; }
    if (PROBE & 2048) phase_combine_t<true>(P, l, smem);
    phase_combine_t<false>(P, l, smem);
}
template <int PH> DEV void run_phase(CP& P, int l, unsigned char* smem, int rep = 0) {
    if (PH == 0) { phase_prologue_a(P, smem); if (PROBE & 4096) { SYNC(); phase_prologue_a(P, smem); } }
    if (PH == 1) { phase_prologue_b(P); if (PROBE & 4096) phase_prologue_b(P); }
    if (PH == 2) phase_inproj(P, l, smem);
    if (PH == 3) phase_up_glaa(P, l, smem);
    if (PH == 4) phase_prep_scan(P, l, rep);
    if (PH == 5) phase_mixers(P, l, smem, rep);
    if (PH == 6) phase_outproj(P, l, smem, rep);
    if (PH == 7) phase_router(P, l, smem, rep);
    if (PH == 8) phase_moe1(P, l, smem);
    if (PH == 9) phase_moe2(P, l, smem);
    if (PH == 10) phase_combine(P, l, smem, rep);
}

#ifndef CPU_EMU
#define XB_TMO      128
#define XB_XCNT(j)  (256  + 64 * (j))
#define XB_XSUB(j)  (1280 + 64 * (j))
#define XB_XGEN(j)  (2304 + 64 * (j))
#define XB_TOP      3328
#define XB_TOPGEN   3392
#define XCD_BAR_WORDS 3456
#define XB_SPIN_CAP (1u << 24)
__device__ __forceinline__ unsigned xb_ld(unsigned* p)              { return __hip_atomic_load(p, __ATOMIC_RELAXED, __HIP_MEMORY_SCOPE_AGENT); }
__device__ __forceinline__ unsigned xb_add(unsigned* p, unsigned v) { return __hip_atomic_fetch_add(p, v, __ATOMIC_RELAXED, __HIP_MEMORY_SCOPE_AGENT); }
__device__ __forceinline__ unsigned xb_xcc_id() { return (unsigned)__builtin_amdgcn_s_getreg((3 << 11) | 20) & 0xFu; }
#define XB_SPIN(cond, bar) do { unsigned _sp = 0; while (cond) { __builtin_amdgcn_s_sleep(1); \
    if ((++_sp & 255u) == 0u) { if (xb_ld(&(bar)[XB_TMO])) break; if (_sp > XB_SPIN_CAP) { atomicAdd(&(bar)[XB_TMO], 1u); break; } } } } while (0)
struct XcdBarrier { unsigned* bar; unsigned x; volatile LDSP unsigned* st; };
__device__ __forceinline__ XcdBarrier xcd_barrier_post(unsigned* bar, volatile LDSP unsigned* st) {
    XcdBarrier b; b.bar = bar; b.x = xb_xcc_id(); b.st = st;
    if (threadIdx.x == 0) (void)xb_add(&bar[XB_XCNT(b.x)], 1u);
    return b;
}
__device__ __forceinline__ void xcd_barrier_complete(unsigned* bar, unsigned x, unsigned& nloc, unsigned& nx) {
    const unsigned G = gridDim.x * gridDim.y * gridDim.z;
    unsigned sum, cnt, mine, sp = 0u;
    for (;;) {
        sum = 0u; cnt = 0u; mine = 0u;
#pragma unroll
        for (unsigned j = 0; j < 16; ++j) { const unsigned c = xb_ld(&bar[XB_XCNT(j)]); sum += c; cnt += (c > 0u) ? 1u : 0u; mine = (j == x) ? c : mine; }
        if (sum == G) break;
        __builtin_amdgcn_s_sleep(1);
        if ((++sp & 255u) == 0u) { if (xb_ld(&bar[XB_TMO])) break; if (sp > XB_SPIN_CAP) { atomicAdd(&bar[XB_TMO], 1u); break; } }
    }
    nloc = mine > 0u ? mine : 1u; nx = cnt > 0u ? cnt : 1u;
}
__device__ __forceinline__ void xcd_barrier1(const XcdBarrier& b) {
    asm volatile("s_waitcnt vmcnt(0)" ::: "memory");
    __syncthreads();
    if (threadIdx.x == 0) {
        unsigned* bar = b.bar;
        __builtin_amdgcn_s_waitcnt(0);
        unsigned nloc = b.st[0], nx = b.st[1];
        if (nloc == 0u) { xcd_barrier_complete(bar, b.x, nloc, nx); b.st[0] = nloc; b.st[1] = nx; }
        const unsigned old = xb_add(&bar[XB_XSUB(b.x)], 1u);
        const unsigned gen = old / nloc;
        if (old + 1u == (gen + 1u) * nloc) {
            __builtin_amdgcn_fence(__ATOMIC_RELEASE, "agent");
            asm volatile("s_waitcnt vmcnt(0)" ::: "memory");
            const unsigned og = xb_add(&bar[XB_TOP], 1u);
            const unsigned tg = og / nx;
            if (og + 1u == (tg + 1u) * nx) xb_add(&bar[XB_TOPGEN], 1u);
            else XB_SPIN(xb_ld(&bar[XB_TOPGEN]) == tg, bar);
            __builtin_amdgcn_fence(__ATOMIC_ACQUIRE, "agent");
            xb_add(&bar[XB_XGEN(b.x)], 1u);
            asm volatile("s_waitcnt vmcnt(0)" ::: "memory");
        } else {
            XB_SPIN(xb_ld(&bar[XB_XGEN(b.x)]) == gen, bar);
            __builtin_amdgcn_fence(__ATOMIC_ACQUIRE, "agent");
            asm volatile("s_waitcnt vmcnt(0)" ::: "memory");
        }
    }
    __syncthreads();
}

#ifndef MK_MULTI
#define MK_MULTI 0
#endif
__device__ __forceinline__ void xcd_barrier(const XcdBarrier& b) { xcd_barrier1(b); if (PROBE & 8192) xcd_barrier1(b); }
#if MK_MULTI
template <int PH> __global__ void __launch_bounds__(NTHREADS, 2) k_phase(Params Pv, int l) {
    extern __shared__ __attribute__((aligned(16))) unsigned char smem[];
    CP& P = *(CP*)__builtin_amdgcn_kernarg_segment_ptr();
    run_phase<PH>(P, l, smem);
}
#else
template <int PH> static __device__ __forceinline__ void phase_ni(int l, int rep = 0) {
    extern __shared__ __attribute__((aligned(16))) unsigned char smem[];
    CP& P = *(CP*)__builtin_amdgcn_kernarg_segment_ptr();
    run_phase<PH>(P, l, smem, rep);
}
__global__ void __launch_bounds__(NTHREADS, 2) k_mega(Params Pv) {
    extern __shared__ __attribute__((aligned(16))) unsigned char smem[];
    CP& P = *(CP*)__builtin_amdgcn_kernarg_segment_ptr();
    volatile LDSP unsigned* xbw = (volatile LDSP unsigned*)(smem + SMEM_BYTES);
    if (threadIdx.x == 0) { xbw[0] = 0u; xbw[1] = 0u; xbw[2] = 0u; xbw[3] = 0u; }
    __syncthreads();
    XcdBarrier bar = xcd_barrier_post(P.bar, xbw);
    phase_ni<0>(0); xcd_barrier(bar);
    phase_ni<1>(0); xcd_barrier(bar);
#pragma clang loop unroll(disable)
    for (int l = 0; l < NL; ++l) {
        phase_ni<2>(l); xcd_barrier(bar); if (WPROBE == 2) { phase_ni<2>(l, 1); xcd_barrier(bar); }
        phase_ni<3>(l); xcd_barrier(bar); if (WPROBE == 3) { phase_ni<3>(l, 1); xcd_barrier(bar); }
        phase_ni<4>(l); xcd_barrier(bar); if (WPROBE == 4) { phase_ni<4>(l, 1); xcd_barrier(bar); }
        phase_ni<5>(l); xcd_barrier(bar); if (WPROBE == 5) { phase_ni<5>(l, 1); xcd_barrier(bar); }
        phase_ni<6>(l); xcd_barrier(bar); if (WPROBE == 6) { phase_ni<6>(l, 1); xcd_barrier(bar); }
        phase_ni<7>(l); xcd_barrier(bar); if (WPROBE == 7) { phase_ni<7>(l, 1); xcd_barrier(bar); }
        phase_ni<8>(l); xcd_barrier(bar); if (WPROBE == 8) { phase_ni<8>(l, 1); xcd_barrier(bar); }
        phase_ni<9>(l); xcd_barrier(bar); if (WPROBE == 9) { phase_ni<9>(l, 1); xcd_barrier(bar); }
        phase_ni<10>(l); if (WPROBE == 10) { xcd_barrier(bar); phase_ni<10>(l, 1); } if (l + 1 < NL) xcd_barrier(bar);
    }
}
#endif
#endif

struct Carver { unsigned char* base; size_t off; template <class T> T* take(size_t n) { off = (off + 255) & ~(size_t)255; T* p = (T*)(base + off); off += n * sizeof(T); return p; } };
static inline size_t carve_ws(Params& P, void* d_ws) {
    Carver c{(unsigned char*)d_ws, 0};
    P.bar = c.take<unsigned>(4096);
    P.xc = c.take<float>((size_t)NCTX * D);
    P.mod = c.take<float>((size_t)NL * (B_ + 1) * MODW);
    P.hglb = c.take<float>(NL * 256);
    P.rope = c.take<float>((size_t)SEQ * 32);
    P.wr = c.take<float>((size_t)NL * D * 48);
    P.cshift = c.take<float>(NL * (B_ + 1) * 48);
    P.cnt = c.take<int>(NL * NEXP);
    P.sched = c.take<int>(NL * 16);
    P.list_tok = c.take<int>((size_t)NEXP * NT);
    P.list_gate = c.take<float>((size_t)NEXP * NT);
    P.tokslot = c.take<int>((size_t)NT * 2);
    P.gst = c.take<float>((size_t)2 * B_ * 4 * 2 * NCH * 4096);
    P.gdec = c.take<float>((size_t)2 * B_ * 4 * 2 * NCH * 64);
    P.win16 = c.take<half_t>((size_t)NL * D * PPAD);
    P.wout16 = c.take<half_t>((size_t)NL * D * D);
    P.wuq16 = c.take<half_t>((size_t)NL * 192 * 384);
    P.wukv16 = c.take<half_t>((size_t)NL * 128 * 512);
    P.h = c.take<half_t>((size_t)NT * D);
    P.p = c.take<half_t>((size_t)NT * PPAD);
    P.yrows = P.p;
    P.y = c.take<half_t>((size_t)NT * D);
    P.qraw = c.take<half_t>((size_t)NT * 384);
    P.kvraw = c.take<half_t>((size_t)NT * 512);
    P.mq = c.take<half_t>((size_t)B_ * 4 * KEYS * 96);
    P.mk = c.take<half_t>((size_t)B_ * 4 * KEYS * 96);
    P.mv = c.take<half_t>((size_t)B_ * 4 * KEYS * 64);
    P.nq = c.take<half_t>((size_t)B_ * 4 * KEYS * 64);
    P.nk = c.take<half_t>((size_t)B_ * 4 * KEYS * 64);
    P.nv = c.take<half_t>((size_t)B_ * 4 * KEYS * 64);
    P.act = c.take<half_t>((size_t)ACT_ROWS * 512);
    P.w13h = c.take<half_t>((size_t)NEXP * D * 1024);
    P.w2h = c.take<half_t>((size_t)NEXP * 512 * D);
    return c.off;
}
static inline void fill_inputs(Params& P, void* const* d_in, void* d_out) {
    const float* const* in = (const float* const*)d_in;
    P.x = in[0]; P.c = in[1]; P.ctx = in[2]; P.c_ctx = in[3]; P.w_ada = in[4]; P.b_ada = in[5]; P.w_in = in[6]; P.w_out = in[7];
    P.mla_g_cq = in[8]; P.mla_g_ckv = in[9]; P.mla_w_uq = in[10]; P.mla_w_ukv = in[11]; P.mla_g_qn = in[12]; P.mla_g_qr = in[13];
    P.mla_g_kn = in[14]; P.mla_g_kr = in[15]; P.na_g_q = in[16]; P.na_g_k = in[17]; P.na_rpb = in[18]; P.ret_g_out = in[19];
    P.hg_lb_raw = in[20]; P.hg_g_out = in[21]; P.moe_w_rg = in[22]; P.moe_b_rg = in[23]; P.moe_w_re = in[24]; P.moe_b_re = in[25];
    P.moe_w1 = in[26]; P.moe_w3 = in[27]; P.moe_w2 = in[28];
    P.out = (float*)d_out;
}

#ifndef CPU_EMU
extern "C" void kernel_launch(void* const* d_in, const int* in_sizes, int n_in, void* d_out, int out_size, void* d_ws, size_t ws_size, hipStream_t stream) {
    Params P{};
    fill_inputs(P, d_in, d_out);
    carve_ws(P, d_ws);
    constexpr size_t kDynLds = SMEM_BYTES + 16;
    static int grid = 0;
    if (!grid) {
        int dev = 0, cus = 0, per_cu = 0;
        (void)hipGetDevice(&dev);
        (void)hipDeviceGetAttribute(&cus, hipDeviceAttributeMultiprocessorCount, dev);
        #if MK_MULTI
        (void)hipOccupancyMaxActiveBlocksPerMultiprocessor(&per_cu, k_phase<5>, NTHREADS, kDynLds);
#else
        (void)hipFuncSetAttribute((const void*)k_mega, hipFuncAttributeMaxDynamicSharedMemorySize, (int)kDynLds);
        (void)hipOccupancyMaxActiveBlocksPerMultiprocessor(&per_cu, k_mega, NTHREADS, kDynLds);
#endif
        if (per_cu < 1) per_cu = 1;
        grid = cus * (per_cu < 2 ? per_cu : 2);
    }
#if MK_MULTI
    k_phase<0><<<grid, NTHREADS, kDynLds, stream>>>(P, 0);
    k_phase<1><<<grid, NTHREADS, kDynLds, stream>>>(P, 0);
    for (int l = 0; l < NL; ++l) {
        k_phase<2><<<grid, NTHREADS, kDynLds, stream>>>(P, l);
        k_phase<3><<<grid, NTHREADS, kDynLds, stream>>>(P, l);
        k_phase<4><<<grid, NTHREADS, kDynLds, stream>>>(P, l);
        k_phase<5><<<grid, NTHREADS, kDynLds, stream>>>(P, l);
        k_phase<6><<<grid, NTHREADS, kDynLds, stream>>>(P, l);
        k_phase<7><<<grid, NTHREADS, kDynLds, stream>>>(P, l);
        k_phase<8><<<grid, NTHREADS, kDynLds, stream>>>(P, l);
        k_phase<9><<<grid, NTHREADS, kDynLds, stream>>>(P, l);
        k_phase<10><<<grid, NTHREADS, kDynLds, stream>>>(P, l);
    }
#else
    (void)hipMemsetAsync(P.bar, 0, XCD_BAR_WORDS * sizeof(unsigned), stream);
    k_mega<<<grid, NTHREADS, kDynLds, stream>>>(P);
#endif
}
#endif
```

```cpp
#ifndef CPU_EMU
#include <hip/hip_runtime.h>
#endif
#include <stdint.h>
#include <stddef.h>

#ifndef PROBE
#define PROBE 0
#endif
#ifndef WPROBE
#define WPROBE 0
#endif
#ifndef CFG_B
#define CFG_B 8
#define CFG_SEQ 4096
#define CFG_L 4
#define CFG_CTX 256
#endif

typedef _Float16 half_t;
typedef _Float16 half8 __attribute__((ext_vector_type(8)));
typedef _Float16 half4 __attribute__((ext_vector_type(4)));
typedef short s16x4 __attribute__((ext_vector_type(4)));
typedef float f32x4 __attribute__((ext_vector_type(4)));
typedef float f32x16 __attribute__((ext_vector_type(16)));

#ifdef CPU_EMU
#define DEV inline
#define SYNC() emu::block_sync()
#define WAVE_BARRIER() emu::wave_sync()
#define SCHED_FENCE() do {} while (0)
#define WAIT_VM(n) do {} while (0)
#define RAW_BARRIER() emu::block_sync()
inline void glds16(const void* g, void* lds_wave_base) { memcpy((unsigned char*)lds_wave_base + (threadIdx.x & 63) * 16, g, 16); }
inline int WID(int tid) { return tid >> 6; }
DEV f32x4 mfma16(half8 a, half8 b, f32x4 c) { return emu::mfma_16x16x32<half8, f32x4>(a, b, c); }
DEV f32x16 mfma32(half8 a, half8 b, f32x16 c) { return emu::mfma_32x32x16<half8, f32x16>(a, b, c); }
DEV f32x4 mfmaf(float a, float b, f32x4 c) { return emu::mfma_16x16x4_f32<f32x4>(a, b, c); }
DEV half4 tr16(const half_t* p) { return emu::ds_read_tr16<half4>((const void*)p); }
template <int OFF> DEV half4 tr16_nowait(const half_t* p) { return emu::ds_read_tr16<half4>((const void*)((const unsigned char*)p + OFF)); }
#define TR_WAIT() do {} while (0)
DEV float shfl_xor_f(float v, int m) { return emu::shfl_xor<float>(v, m); }
DEV float shfl_f(float v, int src) { return emu::shfl<float>(v, src); }
DEV int atomic_add_i(int* p, int v) { return __atomic_fetch_add(p, v, __ATOMIC_RELAXED); }
DEV bool wave_any(bool p) { float f = p ? 1.f : 0.f; for (int m = 1; m < 64; m <<= 1) f = fmaxf(f, emu::shfl_xor<float>(f, m)); return f > 0.f; }
DEV float fexp2(float x) { return exp2f(x); }
DEV float fexp(float x) { return expf(x); }
DEV float flog(float x) { return logf(x); }
DEV float frsqrt(float x) { return 1.0f / sqrtf(x); }
DEV float frcp(float x) { return 1.0f / x; }
#else
#define DEV __device__ __forceinline__
#define SYNC() __syncthreads()
#define WAVE_BARRIER() __builtin_amdgcn_wave_barrier()
#define SCHED_FENCE() __builtin_amdgcn_sched_barrier(0)
#define WAIT_VM(n) asm volatile("s_waitcnt vmcnt(" #n ")" ::: "memory")
#define RAW_BARRIER() __builtin_amdgcn_s_barrier()
__device__ __forceinline__ void glds16(const void* g, void* lds_wave_base) {
    __builtin_amdgcn_global_load_lds((const __attribute__((address_space(1))) void*)g, (__attribute__((address_space(3))) void*)lds_wave_base, 16, 0, 0);
}
__device__ __forceinline__ int WID(int tid) { return __builtin_amdgcn_readfirstlane(tid >> 6); }
#define LDSP __attribute__((address_space(3)))
DEV f32x4 mfma16(half8 a, half8 b, f32x4 c) { return __builtin_amdgcn_mfma_f32_16x16x32_f16(a, b, c, 0, 0, 0); }
DEV f32x16 mfma32(half8 a, half8 b, f32x16 c) { return __builtin_amdgcn_mfma_f32_32x32x16_f16(a, b, c, 0, 0, 0); }
DEV f32x4 mfmaf(float a, float b, f32x4 c) { return __builtin_amdgcn_mfma_f32_16x16x4f32(a, b, c, 0, 0, 0); }
DEV half4 tr16(const half_t* p) { s16x4 t = __builtin_amdgcn_ds_read_tr16_b64_v4i16((LDSP s16x4*)p); return __builtin_bit_cast(half4, t); }
template <int OFF> DEV half4 tr16_nowait(const half_t* p) { s16x4 t; const unsigned a = (unsigned)(size_t)(LDSP const half_t*)p; asm volatile("ds_read_b64_tr_b16 %0, %1 offset:%2" : "=v"(t) : "v"(a), "i"(OFF) : "memory"); return __builtin_bit_cast(half4, t); }
#define TR_WAIT() do { asm volatile("s_waitcnt lgkmcnt(0)" ::: "memory"); __builtin_amdgcn_sched_barrier(0); } while (0)
DEV float shfl_xor_f(float v, int m) { return __shfl_xor(v, m, 64); }
DEV float shfl_f(float v, int src) { return __shfl(v, src, 64); }
DEV int atomic_add_i(int* p, int v) { return atomicAdd(p, v); }
DEV bool wave_any(bool p) { return __any(p) != 0; }
DEV float fexp2(float x) { return __builtin_amdgcn_exp2f(x); }
DEV float fexp(float x) { return __expf(x); }
DEV float flog(float x) { return __logf(x); }
DEV float frsqrt(float x) { return __builtin_amdgcn_rsqf(x); }
DEV float frcp(float x) { return __builtin_amdgcn_rcpf(x); }
#endif

#ifdef CPU_EMU
DEV float opaque0() { return 0.f; }
DEV int TID() { return (int)threadIdx.x; }
#else
DEV int TID() { int t = (int)threadIdx.x; asm volatile("" : "+v"(t)); return t; }
DEV float opaque0() { float z = 0.f; asm volatile("" : "+v"(z)); return z; }
#endif
constexpr int B_ = CFG_B, SEQ = CFG_SEQ, NL = CFG_L, CTX = CFG_CTX, D = 1024;
constexpr int NLAT = B_ * SEQ, NCTX = B_ * CTX, NT = NLAT + NCTX;
constexpr int ROWS = SEQ / 64;
constexpr int KEYS = SEQ + CTX;
constexpr int PTOT = 3424, PPAD = 3456;
constexpr int O_CQ = 0, O_CKV = 192, O_KR = 320, O_NAQ = 352, O_NAK = 608, O_NAV = 864, O_RQ = 1120, O_RK = 1376, O_RV = 1632, O_RG = 1888,
              O_HQ = 2144, O_HF = 2400, O_HB = 2656, O_HI = 2912, O_HG = 3168;
constexpr int NCH = KEYS / 64, CG = CTX / 64, LG = SEQ / 64;
constexpr int NEXP = 32, ACT_ROWS = 2 * NT + NEXP * 256;
constexpr float EPS = 1e-6f;
constexpr float LOG2E = 1.4426950408889634f;
constexpr int MODW = 6 * D;
constexpr int NTHREADS = 256;
constexpr int SMEM_BYTES = 74240;

struct Params {
    const float *x, *c, *ctx, *c_ctx, *w_ada, *b_ada, *w_in, *w_out, *mla_g_cq, *mla_g_ckv, *mla_w_uq, *mla_w_ukv, *mla_g_qn, *mla_g_qr, *mla_g_kn,
        *mla_g_kr, *na_g_q, *na_g_k, *na_rpb, *ret_g_out, *hg_lb_raw, *hg_g_out, *moe_w_rg, *moe_b_rg, *moe_w_re, *moe_b_re, *moe_w1, *moe_w3, *moe_w2;
    float* out;
    unsigned* bar;
    float *xc, *mod, *hglb, *wr, *cshift, *list_gate, *gst, *gdec, *rope;
    int *cnt, *list_tok, *tokslot, *sched;
    half_t *win16, *wout16, *wuq16, *wukv16, *h, *p, *y, *qraw, *kvraw, *mq, *mk, *mv, *nq, *nk, *nv, *act, *yrows, *w13h, *w2h;
};

#ifdef CPU_EMU
typedef const Params CP;
#else
typedef const __attribute__((address_space(4))) Params CP;
#endif
DEV int tok_brow(int t) { return t < NLAT ? t / SEQ : B_; }
DEV float* xrow_ptr(CP& P, int t) { return t < NLAT ? P.out + (size_t)t * D : P.xc + (size_t)(t - NLAT) * D; }
DEV const float* xin_ptr(CP& P, int t) { return t < NLAT ? P.x + (size_t)t * D : P.ctx + (size_t)(t - NLAT) * D; }
DEV float silu_f(float x) { return x * frcp(1.0f + fexp(-x)); }
DEV float sigmoid_f(float x) { return frcp(1.0f + fexp(-x)); }
DEV float wave_sum(float v) {
    v += shfl_xor_f(v, 1); v += shfl_xor_f(v, 2); v += shfl_xor_f(v, 4); v += shfl_xor_f(v, 8); v += shfl_xor_f(v, 16); v += shfl_xor_f(v, 32);
    return v;
}
DEV half4 to_half4(f32x4 v) { half4 r; r[0] = (half_t)v[0]; r[1] = (half_t)v[1]; r[2] = (half_t)v[2]; r[3] = (half_t)v[3]; return r; }

constexpr int LDB_S = 136, G_BBUF = 32 * LDB_S;
struct BSrcH {
    const half_t* base; int ld;
    typedef half8 Raw;
    DEV Raw load(int k, int n) const { return *(const half8*)(base + (size_t)k * ld + n); }
    DEV half8 cvt(const Raw& r) const { return r; }
};
struct RawF { f32x4 a, b; };
DEV half8 cvt_rawf(const RawF& r) {
    half8 h; h[0] = (half_t)r.a[0]; h[1] = (half_t)r.a[1]; h[2] = (half_t)r.a[2]; h[3] = (half_t)r.a[3];
    h[4] = (half_t)r.b[0]; h[5] = (half_t)r.b[1]; h[6] = (half_t)r.b[2]; h[7] = (half_t)r.b[3]; return h;
}
struct BSrcF {
    const float* base; int ld;
    typedef RawF Raw;
    DEV Raw load(int k, int n) const { const float* s = base + (size_t)k * ld + n; RawF r; r.a = *(const f32x4*)s; r.b = *(const f32x4*)(s + 4); return r; }
    DEV half8 cvt(const Raw& r) const { return cvt_rawf(r); }
};
struct BSrcF2 {
    const float* b0; ptrdiff_t d10; int ld;
    typedef RawF Raw;
    DEV Raw load(int k, int n) const { const float* s = b0 + (ptrdiff_t)(n >> 6) * d10 + (n & 63) + (size_t)k * ld; RawF r; r.a = *(const f32x4*)s; r.b = *(const f32x4*)(s + 4); return r; }
    DEV half8 cvt(const Raw& r) const { return cvt_rawf(r); }
};
DEV int swzB(int k, int ch) { return k * LDB_S + (ch << 3); }
constexpr int GS_B = 32 * 128;
DEV int fswzB(int k) { return 2 * ((k & 3) | (((k >> 3) & 1) << 2)); }
#define GEMM_ISSUE(ST, KT)                                                                                                   \
    {                                                                                                                        \
        half_t* sa_ = ring + (ST) * GS_STAGE + (16 * MT * w) * 32;                                                           \
        half_t* sb_ = ring + (ST) * GS_STAGE + GS_A + (8 * w) * 128;                                                          \
        _Pragma("unroll") for (int j = 0; j < MT; ++j) glds16(asrc[j] + (KT) * 32, sa_ + 16 * j * 32);                       \
        _Pragma("unroll") for (int j = 0; j < 2; ++j) glds16(bsrc[j] + (size_t)(KT) * 32 * ldb, sb_ + 4 * j * 128);          \
    }
#define GEMM_COMPUTE(ST)                                                                                                     \
    {                                                                                                                        \
        const half_t* sa_ = ring + (ST) * GS_STAGE; const half_t* sb_ = sa_ + GS_A;                                          \
        half8 af[MT];                                                                                                        \
        _Pragma("unroll") for (int mt = 0; mt < MT; ++mt) af[mt] = *(const half8*)(sa_ + aoff + mt * 16 * 32);               \
        _Pragma("unroll") for (int nh = 0; nh < 2; ++nh) {                                                                   \
            half8 bf[4];                                                                                                     \
            _Pragma("unroll") for (int n4 = 0; n4 < 4; ++n4) {                                                               \
                const half_t* ba = sb_ + bk0 * 128 + (((2 * (4 * nh + n4) + (pp >> 1)) ^ bfz) << 3) + 4 * (pp & 1);          \
                const half4 lo = tr16_nowait<0>(ba), hi = tr16_nowait<1024>(ba);                                             \
                bf[n4][0] = lo[0]; bf[n4][1] = lo[1]; bf[n4][2] = lo[2]; bf[n4][3] = lo[3]; bf[n4][4] = hi[0]; bf[n4][5] = hi[1]; bf[n4][6] = hi[2]; bf[n4][7] = hi[3]; \
            }                                                                                                                \
            TR_WAIT();                                                                                                       \
            _Pragma("unroll") for (int n4 = 0; n4 < 4; ++n4)                                                                 \
                _Pragma("unroll") for (int mt = 0; mt < MT; ++mt) acc[mt][4 * nh + n4] = mfma16(bf[n4], af[mt], acc[mt][4 * nh + n4]); \
        }                                                                                                                    \
    }
#define GEMM_STEP(ST, ST2, itv)                                                                                              \
    {                                                                                                                        \
        const int it_ = (itv);                                                                                               \
        if (it_ + 1 < nk) { if (MT == 4) { WAIT_VM(6); } else if (MT == 2) { WAIT_VM(4); } else { WAIT_VM(3); } } else { WAIT_VM(0); } \
        RAW_BARRIER();                                                                                                       \
        if (it_ + 2 < nk) GEMM_ISSUE(ST2, it_ + 2)                                                                           \
        GEMM_COMPUTE(ST)                                                                                                     \
    }
template <int MT, class ARow, class BS, class Epi>
DEV void gemm_tile(const ARow& arow, const BS& bs, int K, Epi& epi, unsigned char* smem) {
    constexpr int GS_A = 64 * MT * 32, GS_STAGE = GS_A + GS_B;
    half_t* ring = (half_t*)smem;
    const int tid = TID(), lane = tid & 63, w = WID(tid), g = lane >> 4, li = lane & 15;
    const int q = li >> 2, pp = li & 3;
    const int nk = K >> 5;
    const int ldb = bs.ld;
    const half_t* asrc[MT];
#pragma unroll
    for (int j = 0; j < MT; ++j) asrc[j] = arow(16 * MT * w + 16 * j + (lane >> 2)) + 8 * ((lane & 3) ^ (lane >> 4));
    const half_t* bsrc[2];
#pragma unroll
    for (int j = 0; j < 2; ++j) { const int k = 8 * w + 4 * j + (lane >> 4); bsrc[j] = bs.base + (size_t)k * ldb + 8 * ((lane & 15) ^ fswzB(k)); }
    const int aoff = (16 * MT * w + li) * 32 + ((g ^ (li >> 2)) << 3);
    const int bk0 = 8 * g + q, bfz = fswzB(bk0);
    f32x4 acc[MT][8];
#pragma unroll
    for (int mt = 0; mt < MT; ++mt)
#pragma unroll
        for (int nt = 0; nt < 8; ++nt) acc[mt][nt] = (f32x4){0.f, 0.f, 0.f, 0.f};
    SYNC();
    GEMM_ISSUE(0, 0)
    GEMM_ISSUE(1, 1)
#pragma clang loop unroll(disable)
    for (int it = 0; it < nk; it += 3) {
        GEMM_STEP(0, 2, it)
        if (it + 1 < nk) GEMM_STEP(1, 0, it + 1)
        if (it + 2 < nk) GEMM_STEP(2, 1, it + 2)
    }
    epi.template run<MT>(acc, w, g, li);
}
template <class ARow, class BS, class Epi>
DEV void gemm256(const ARow& arow, const BS& bs, int K, Epi& epi, unsigned char* smem) { gemm_tile<4>(arow, bs, K, epi, smem); }
struct ARowLin { const half_t* base; int ld; DEV const half_t* operator()(int r) const { return base + (size_t)r * ld; } };
struct ARowGather { const half_t* base; int ld; const int* idx; int nvalid; DEV const half_t* operator()(int r) const { const int t = r < nvalid ? idx[r] : 0; return base + (size_t)t * ld; } };

struct EpiStoreH {
    half_t* out; int ld;
    template <int MT> DEV void run(const f32x4 (&acc)[MT][8], int w, int g, int li) const {
#pragma unroll
        for (int mt = 0; mt < MT; ++mt)
#pragma unroll
            for (int nt = 0; nt < 8; ++nt) *(half4*)(out + (size_t)(16 * MT * w + 16 * mt + li) * ld + 16 * nt + 4 * g) = to_half4(acc[mt][nt]);
    }
};
struct EpiResid {
    float* x; const float* xsrc; const float* gate;
    template <int MT> DEV void run(const f32x4 (&acc)[MT][8], int w, int g, int li) const {
#pragma unroll
        for (int nh = 0; nh < 2; ++nh) {
            f32x4 gt[4];
#pragma unroll
            for (int n4 = 0; n4 < 4; ++n4) gt[n4] = *(const f32x4*)(gate + 16 * (4 * nh + n4) + 4 * g);
#pragma unroll
            for (int mt = 0; mt < MT; ++mt) {
                f32x4 xv[4];
                const size_t ro = (size_t)(16 * MT * w + 16 * mt + li) * D + 64 * nh + 4 * g;
#pragma unroll
                for (int n4 = 0; n4 < 4; ++n4) xv[n4] = *(const f32x4*)(xsrc + ro + 16 * n4);
                SCHED_FENCE();
#pragma unroll
                for (int n4 = 0; n4 < 4; ++n4) *(f32x4*)(x + ro + 16 * n4) = xv[n4] + gt[n4] * acc[mt][4 * nh + n4];
            }
        }
    }
};
struct EpiGlu {
    half_t* out; int ld;
    template <int MT> DEV void run(const f32x4 (&acc)[MT][8], int w, int g, int li) const {
#pragma unroll
        for (int mt = 0; mt < MT; ++mt)
#pragma unroll
            for (int nt = 0; nt < 4; ++nt) {
                f32x4 o;
#pragma unroll
                for (int r = 0; r < 4; ++r) o[r] = silu_f(acc[mt][nt][r]) * acc[mt][nt + 4][r];
                *(half4*)(out + (size_t)(16 * MT * w + 16 * mt + li) * ld + 16 * nt + 4 * g) = to_half4(o);
            }
    }
};
struct EpiRowsGate {
    half_t* out; const float* gate; int nvalid;
    template <int MT> DEV void run(const f32x4 (&acc)[MT][8], int w, int g, int li) const {
#pragma unroll
        for (int mt = 0; mt < MT; ++mt) {
            const int row = 16 * MT * w + 16 * mt + li;
            if (row < nvalid) {
                const float gt = gate[row];
#pragma unroll
                for (int nt = 0; nt < 8; ++nt) *(half4*)(out + (size_t)row * D + 16 * nt + 4 * g) = to_half4(acc[mt][nt] * gt);
            }
        }
    }
};

DEV void phase_prologue_a(CP& P, unsigned char* smem) {
    const int tid = TID(), gtid = blockIdx.x * NTHREADS + tid, gsz = gridDim.x * NTHREADS;
    for (size_t i = gtid; i < (size_t)NL * D * (PPAD / 8); i += gsz) {
        const int cc = (int)(i % (PPAD / 8)) * 8; const size_t rk = i / (PPAD / 8);
        half8 h;
#pragma unroll
        for (int j = 0; j < 8; ++j) h[j] = (cc + j < PTOT) ? (half_t)P.w_in[rk * PTOT + cc + j] : (half_t)0.f;
        *(half8*)(P.win16 + rk * PPAD + cc) = h;
    }
    for (size_t i = gtid; i < (size_t)NL * D * D / 8; i += gsz) {
        const f32x4 a = *(const f32x4*)(P.w_out + i * 8), b = *(const f32x4*)(P.w_out + i * 8 + 4);
        RawF r; r.a = a; r.b = b; *(half8*)(P.wout16 + i * 8) = cvt_rawf(r);
    }
    for (int i = gtid; i < NL * 192 * 384; i += gsz) { const int l = i / (192 * 384), k = (i / 384) % 192; P.wuq16[i] = (half_t)(P.mla_g_cq[l * 192 + k] * P.mla_w_uq[i]); }
    for (int i = gtid; i < NL * 128 * 512; i += gsz) { const int l = i / (128 * 512), k = (i / 512) % 128; P.wukv16[i] = (half_t)(P.mla_g_ckv[l * 128 + k] * P.mla_w_ukv[i]); }
    for (int i = gtid; i < 256; i += gsz) {
        float mx = -1e30f; for (int l = 0; l < NL; ++l) mx = fmaxf(mx, P.hg_lb_raw[l * 256 + i]);
        float den = 0.f; for (int l = 0; l < NL; ++l) den += fexp(P.hg_lb_raw[l * 256 + i] - mx);
        float cum = 0.f;
        for (int l = 0; l < NL; ++l) { const float wv = fexp(P.hg_lb_raw[l * 256 + i] - mx) / den; if (l > 0) cum += wv; P.hglb[l * 256 + i] = cum; }
    }
    for (int i = gtid; i < NL * D * 48; i += gsz) {
        const int n = i % 48, lk = i / 48;
        P.wr[i] = n < 4 ? P.moe_w_rg[lk * 4 + n] : (n < 36 ? P.moe_w_re[lk * 32 + (n - 4)] : 0.f);
    }
    for (int i = gtid; i < NL * NEXP; i += gsz) P.cnt[i] = 0;
    for (int i = gtid; i < NL * 16; i += gsz) P.sched[i] = 0;
    for (int i = gtid; i < SEQ * 16; i += gsz) {
        const int n = i >> 4, j = i & 15, ax = j >> 3, fi = j & 7;
        const float ang = (float)(ax == 0 ? n / 64 : n % 64) * fexp(-9.210340371976184f * (float)fi * 0.125f);
        P.rope[n * 32 + j] = cosf(ang); P.rope[n * 32 + 16 + j] = sinf(ang);
    }
    float* sc = (float*)smem;
    SYNC();
    for (int i = tid; i < (B_ + 1) * D; i += NTHREADS) { const int r = i / D, k = i % D; const float v = r < B_ ? P.c[r * D + k] : P.c_ctx[k]; sc[i] = silu_f(v); }
    SYNC();
    float* red = sc + (B_ + 1) * D;
    for (int item = blockIdx.x; item < NL * (MODW / 64); item += gridDim.x) {
        const int l = item / (MODW / 64), n = (item % (MODW / 64)) * 64 + (tid & 63), kq = tid >> 6;
        float acc[B_ + 1];
#pragma unroll
        for (int r = 0; r <= B_; ++r) acc[r] = 0.f;
        const float* wp = P.w_ada + (size_t)l * D * MODW + (size_t)(256 * kq) * MODW + n;
        for (int k0 = 0; k0 < 256; k0 += 8) {
            float wv[8];
#pragma unroll
            for (int j = 0; j < 8; ++j) wv[j] = wp[(size_t)(k0 + j) * MODW];
#pragma unroll
            for (int j = 0; j < 8; ++j)
#pragma unroll
                for (int r = 0; r <= B_; ++r) acc[r] += sc[r * D + 256 * kq + k0 + j] * wv[j];
        }
        SYNC();
#pragma unroll
        for (int r = 0; r <= B_; ++r) red[(kq * 64 + (tid & 63)) * (B_ + 1) + r] = acc[r];
        SYNC();
        if (kq == 0) {
            const float bv = P.b_ada[l * MODW + n];
#pragma unroll
            for (int r = 0; r <= B_; ++r) {
                const int o = (tid & 63) * (B_ + 1) + r;
                P.mod[((size_t)l * (B_ + 1) + r) * MODW + n] = ((red[o] + red[64 * (B_ + 1) + o]) + (red[128 * (B_ + 1) + o] + red[192 * (B_ + 1) + o])) + bv;
            }
        }
    }
}

DEV void row_modulate_store(const f32x4 (&v)[4], const float* sh, const float* sc, half_t* hrow, int lane) {
    f32x4 s4[4], h4[4];
#pragma unroll
    for (int j = 0; j < 4; ++j) { s4[j] = *(const f32x4*)(sc + 256 * j + 4 * lane); h4[j] = *(const f32x4*)(sh + 256 * j + 4 * lane); }
    float ss = 0.f;
#pragma unroll
    for (int j = 0; j < 4; ++j) ss += v[j][0] * v[j][0] + v[j][1] * v[j][1] + v[j][2] * v[j][2] + v[j][3] * v[j][3];
    ss = wave_sum(ss);
    const float rstd = frsqrt(ss * (1.0f / D) + EPS);
#pragma unroll
    for (int j = 0; j < 4; ++j) {
        f32x4 o;
#pragma unroll
        for (int e = 0; e < 4; ++e) o[e] = v[j][e] * rstd * (1.0f + s4[j][e]) + h4[j][e];
        *(half4*)(hrow + 256 * j + 4 * lane) = to_half4(o);
    }
}
DEV void phase_prologue_b(CP& P) {
    const int lane = TID() & 63, gw = blockIdx.x * 4 + (TID() >> 6), nw = gridDim.x * 4;
    for (int t = gw; t < NT; t += nw) {
        const float* src = t < NLAT ? P.x + (size_t)t * D : P.ctx + (size_t)(t - NLAT) * D;
        f32x4 v[4];
#pragma unroll
        for (int j = 0; j < 4; ++j) v[j] = *(const f32x4*)(src + 256 * j + 4 * lane);
        const float* md = P.mod + (size_t)tok_brow(t) * MODW;
        row_modulate_store(v, md + 0, md + D, P.h + (size_t)t * D, lane);
    }
    for (int it = gw; it < NL * (B_ + 1) * 36; it += nw) {
        const int n = it % 36, lr = it / 36, l = lr / (B_ + 1);
        const float* sh = P.mod + (size_t)lr * MODW + 3 * D;
        float s = 0.f;
        for (int k = lane; k < D; k += 64) s += sh[k] * P.wr[((size_t)l * D + k) * 48 + n];
        s = wave_sum(s);
        if (lane == 0) P.cshift[lr * 48 + n] = s + (n < 4 ? P.moe_b_rg[l * 4 + n] : P.moe_b_re[l * 32 + n - 4]);
    }
}

DEV bool gemm_tile_idx(int idx, int ntm, int ntn, int& tm, int& tn) {
    if (idx >= ntm * ntn) return false;
    const int nig = 4 * ntn, gid = idx / nig, fm = gid * 4, gsz = (ntm - fm) < 4 ? (ntm - fm) : 4, rem = idx - gid * nig;
    tm = fm + rem % gsz; tn = rem / gsz; return true;
}
DEV bool gemm_tile_order(int round, int ntm, int ntn, int& tm, int& tn) {
    const int per = gridDim.x >> 3;
    const int idx = ((round << 3) + (blockIdx.x & 7)) * per + (blockIdx.x >> 3);
    if (idx >= ntm * ntn) return false;
    const int nig = 4 * ntn, gid = idx / nig, fm = gid * 4, gsz = (ntm - fm) < 4 ? (ntm - fm) : 4, rem = idx - gid * nig;
    tm = fm + rem % gsz; tn = rem / gsz; return true;
}
DEV void phase_inproj(CP& P, int l, unsigned char* smem) {
    constexpr int NTN = PPAD / 128, NTM = NT / 256;
    const int full = (NTM * NTN) / gridDim.x;
    for (int rep = 0; rep < ((PROBE & 1) ? 2 : 1); ++rep) {
        for (int round = 0; round < full; ++round) {
            int tm, tn;
            if (!gemm_tile_order(round, NTM, NTN, tm, tn)) continue;
            ARowLin ar{P.h + (size_t)tm * 256 * D, D};
            BSrcH bs{P.win16 + (size_t)l * D * PPAD + tn * 128, PPAD};
            EpiStoreH epi{P.p + (size_t)tm * 256 * PPAD + tn * 128, PPAD};
            gemm_tile<4>(ar, bs, D, epi, smem);
        }
        const int base = full * gridDim.x, left = NTM * NTN - base;
        for (int i = blockIdx.x; i < 4 * left; i += gridDim.x) {
            int tm, tn; gemm_tile_idx(base + (i >> 2), NTM, NTN, tm, tn);
            const size_t r0 = (size_t)tm * 256 + 64 * (i & 3);
            ARowLin ar{P.h + r0 * D, D};
            BSrcH bs{P.win16 + (size_t)l * D * PPAD + tn * 128, PPAD};
            EpiStoreH epi{P.p + r0 * PPAD + tn * 128, PPAD};
            gemm_tile<1>(ar, bs, D, epi, smem);
        }
    }
}

constexpr int GQ_LD = 68, GH_LD = 72, GS_LD = 24;
constexpr int G_QF = 0, G_KF = 17408, G_KH = 34816, G_VH = 44032, G_SC = 53248, G_DK = 56320, G_RED = 57344;
DEV float ret_loggamma(int h, int dir) { return log1pf(-exp2f(-5.0f - (float)(2 * h + dir))); }
template <int MIX, bool OUT, int dir>
DEV void gla_stage(CP& P, int l, int h, int tok0, float lgam, float& totsum, unsigned char* smem) {
    float* Qf = (float*)(smem + G_QF); float* Kf = (float*)(smem + G_KF); half_t* Kh = (half_t*)(smem + G_KH); half_t* Vh = (half_t*)(smem + G_VH);
    float* dk = (float*)(smem + G_DK);
    const int tid = TID(), d = tid & 63, I = tid >> 6;
    const half_t* pr = P.p + (size_t)(tok0 + 16 * I) * PPAD + h * 64 + d;
    float lf[16], kk[16], qq[16];
    half_t vv[16], rq[16], rk[16];
    float lb = 0.f;
    if (MIX == 1) lb = P.hglb[l * 256 + h * 64 + d];
#pragma unroll
    for (int i = 0; i < 16; ++i) {
        const half_t* pi = pr + (size_t)i * PPAD;
        if (MIX == 0) { rq[i] = OUT ? pi[O_RQ] : (half_t)0.f; rk[i] = pi[O_RK]; vv[i] = pi[O_RV]; }
        else { rq[i] = OUT ? pi[O_HQ] : (half_t)0.f; rk[i] = pi[dir ? O_HB : O_HF]; vv[i] = pi[O_HI]; }
    }
    SCHED_FENCE();
    float tot = 0.f;
#pragma unroll
    for (int i = 0; i < 16; ++i) {
        if (MIX == 0) {
            qq[i] = (float)rq[i]; kk[i] = (float)rk[i] * 0.125f; lf[i] = lgam;
        } else {
            qq[i] = OUT ? silu_f((float)rq[i]) : 0.f;
            const float sg = sigmoid_f((float)rk[i]), f = lb + (1.0f - lb) * sg;
            lf[i] = flog(fmaxf(f, 1e-20f)); kk[i] = (1.0f - lb) * (1.0f - sg);
        }
        tot += lf[i];
    }
    float bc = 0.f;
#pragma unroll
    for (int ii = 0; ii < 16; ++ii) {
        const int i = dir == 0 ? ii : 15 - ii;
        bc += lf[i];
        const int o = (I * 16 + i);
        if (OUT) { Qf[o * GQ_LD + d] = qq[i] * fexp(bc); Kf[o * GQ_LD + d] = kk[i] * fexp(fminf(-bc, 80.0f)); }
        Kh[o * GH_LD + d] = (half_t)(kk[i] * fexp(tot - bc));
        Vh[o * GH_LD + d] = vv[i];
    }
    dk[I * 64 + d] = fexp(tot);
    totsum += tot;
}
DEV half8 tok_frag(const half_t* img, int col0, int lane) {
    const int g = lane >> 4, li = lane & 15, q = li >> 2, p = li & 3;
    const half_t* a = img + (8 * (g & 1) + q) * GH_LD + col0 + 4 * p;
    const half4 lo = tr16(a), hi = tr16(a + 4 * GH_LD);
    half8 r;
    const bool z = g >= 2;
    r[0] = z ? (half_t)0.f : lo[0]; r[1] = z ? (half_t)0.f : lo[1]; r[2] = z ? (half_t)0.f : lo[2]; r[3] = z ? (half_t)0.f : lo[3];
    r[4] = z ? (half_t)0.f : hi[0]; r[5] = z ? (half_t)0.f : hi[1]; r[6] = z ? (half_t)0.f : hi[2]; r[7] = z ? (half_t)0.f : hi[3];
    return r;
}
DEV void gla_scores(int dir, unsigned char* smem) {
    const float* Qf = (const float*)(smem + G_QF); const float* Kf = (const float*)(smem + G_KF); half_t* sc = (half_t*)(smem + G_SC);
    const int tid = TID(), lane = tid & 63, w = tid >> 6, g = lane >> 4, li = lane & 15;
    f32x4 s0 = {0.f, 0.f, 0.f, 0.f}, s1 = {0.f, 0.f, 0.f, 0.f};
    const float* kp = Kf + (w * 16 + li) * GQ_LD + g; const float* qp = Qf + (w * 16 + li) * GQ_LD + g;
#pragma unroll
    for (int kk = 0; kk < 16; kk += 2) { s0 = mfmaf(kp[4 * kk], qp[4 * kk], s0); s1 = mfmaf(kp[4 * kk + 4], qp[4 * kk + 4], s1); }
    half4 o;
#pragma unroll
    for (int r = 0; r < 4; ++r) { const int sj = 4 * g + r; const bool keep = dir == 0 ? (sj <= li) : (sj >= li); o[r] = keep ? (half_t)(s0[r] + s1[r]) : (half_t)0.f; }
    *(half4*)(sc + (w * 16 + li) * GS_LD + 4 * g) = o;
}
template <bool OUT>
DEV void gla_main_sub(int I, f32x4 (&st)[4], f32x4& oacc, unsigned char* smem) {
    const float* Qf = (const float*)(smem + G_QF); const half_t* Kh = (const half_t*)(smem + G_KH); const half_t* Vh = (const half_t*)(smem + G_VH);
    const half_t* sc = (const half_t*)(smem + G_SC); const float* dk = (const float*)(smem + G_DK);
    const int tid = TID(), lane = tid & 63, w = tid >> 6, g = lane >> 4, li = lane & 15;
    const half8 vfr = tok_frag(Vh + I * 16 * GH_LD, 16 * w, lane);
    if (OUT) {
        const half8 sf = *(const half8*)(sc + (I * 16 + li) * GS_LD + 8 * (g & 1));
        oacc = mfma16(vfr, sf, oacc);
#pragma unroll
        for (int ks = 0; ks < 2; ++ks) {
            half8 sa, qb;
            const f32x4 q0 = *(const f32x4*)(Qf + (I * 16 + li) * GQ_LD + 32 * ks + 4 * g), q1 = *(const f32x4*)(Qf + (I * 16 + li) * GQ_LD + 32 * ks + 16 + 4 * g);
#pragma unroll
            for (int j = 0; j < 4; ++j) { sa[j] = (half_t)st[2 * ks][j]; sa[4 + j] = (half_t)st[2 * ks + 1][j]; qb[j] = (half_t)q0[j]; qb[4 + j] = (half_t)q1[j]; }
            oacc = mfma16(sa, qb, oacc);
        }
    }
#pragma unroll
    for (int dt = 0; dt < 4; ++dt) {
        const f32x4 dv = *(const f32x4*)(dk + I * 64 + 16 * dt + 4 * g);
#pragma unroll
        for (int r = 0; r < 4; ++r) st[dt][r] *= dv[r];
        st[dt] = mfma16(tok_frag(Kh + I * 16 * GH_LD, 16 * dt, lane), vfr, st[dt]);
    }
}
DEV int gla_tok0(int b, int gidx) { return gidx < CG ? NLAT + b * CTX + 64 * gidx : b * SEQ + 64 * (gidx - CG); }
DEV int gla_chainpos(int gidx, int dir) { return dir == 0 ? gidx : (gidx < CG ? CG - 1 - gidx : CG + (LG - 1 - (gidx - CG))); }
DEV size_t gla_chain(int mix, int b, int h, int dir) { return (((size_t)mix * B_ + b) * 4 + h) * 2 + dir; }
template <int MIX>
DEV void gla_step_a(CP& P, int l, int b, int h, int dir, int gidx, unsigned char* smem) {
    const int tid = TID(), lane = tid & 63, w = tid >> 6, g = lane >> 4, li = lane & 15;
    f32x4 st[4]; f32x4 od = {0.f, 0.f, 0.f, 0.f};
#pragma unroll
    for (int dt = 0; dt < 4; ++dt) st[dt] = (f32x4){0.f, 0.f, 0.f, 0.f};
    float totsum = 0.f;
    const float lgam = MIX == 0 ? ret_loggamma(h, dir) : 0.f;
    if (dir == 0) gla_stage<MIX, false, 0>(P, l, h, gla_tok0(b, gidx), lgam, totsum, smem); else gla_stage<MIX, false, 1>(P, l, h, gla_tok0(b, gidx), lgam, totsum, smem);
    SYNC();
#pragma unroll
    for (int ii = 0; ii < 4; ++ii) gla_main_sub<false>(dir == 0 ? ii : 3 - ii, st, od, smem);
    const size_t slot = gla_chain(MIX, b, h, dir) * NCH + gla_chainpos(gidx, dir);
    half_t* dst = (half_t*)P.gst + slot * 4096;
#pragma unroll
    for (int dt = 0; dt < 4; ++dt)
#pragma unroll
        for (int r = 0; r < 4; ++r) dst[(16 * dt + 4 * g + r) * 64 + 16 * w + li] = (half_t)st[dt][r];
    if (tid < 64) { const float* dk = (const float*)(smem + G_DK); P.gdec[slot * 64 + tid] = dk[tid] * dk[64 + tid] * dk[128 + tid] * dk[192 + tid]; }
    SYNC();
}
template <int MIX>
DEV void gla_step_c(CP& P, int l, int b, int h, int gidx, unsigned char* smem) {
    const int tid = TID(), lane = tid & 63, w = tid >> 6, g = lane >> 4, li = lane & 15;
    f32x4 oacc[4];
#pragma unroll
    for (int I = 0; I < 4; ++I) oacc[I] = (f32x4){0.f, 0.f, 0.f, 0.f};
    const int tok0 = gla_tok0(b, gidx);
    float totsum = 0.f;
#pragma unroll
    for (int dir = 0; dir < 2; ++dir) {
        const size_t slot = gla_chain(MIX, b, h, dir) * NCH + gla_chainpos(gidx, dir);
        const half_t* src = (const half_t*)P.gst + slot * 4096;
        f32x4 st[4];
#pragma unroll
        for (int dt = 0; dt < 4; ++dt)
#pragma unroll
            for (int r = 0; r < 4; ++r) st[dt][r] = (float)src[(16 * dt + 4 * g + r) * 64 + 16 * w + li];
        const float lgam = MIX == 0 ? ret_loggamma(h, dir) : 0.f;
        if (dir == 1) SYNC();
        if (dir == 0) gla_stage<MIX, true, 0>(P, l, h, tok0, lgam, totsum, smem); else gla_stage<MIX, true, 1>(P, l, h, tok0, lgam, totsum, smem);
        SYNC();
        gla_scores(dir, smem);
        SYNC();
#pragma unroll
        for (int ii = 0; ii < 4; ++ii) { const int I = dir == 0 ? ii : 3 - ii; gla_main_sub<true>(I, st, oacc[I], smem); }
    }
    float* red = (float*)(smem + G_RED);
#pragma unroll
    for (int I = 0; I < 4; ++I) {
        float ss = oacc[I][0] * oacc[I][0] + oacc[I][1] * oacc[I][1] + oacc[I][2] * oacc[I][2] + oacc[I][3] * oacc[I][3];
        ss += shfl_xor_f(ss, 16); ss += shfl_xor_f(ss, 32);
        if (g == 0) red[w * 64 + 16 * I + li] = ss;
    }
    SYNC();
    const float* gain = (MIX == 0 ? P.ret_g_out : P.hg_g_out) + l * 64;
    const int ycol = (MIX == 0 ? 512 : 768) + h * 64 + 16 * w + 4 * g, gcol = (MIX == 0 ? O_RG : O_HG) + h * 64 + 16 * w + 4 * g;
#pragma unroll
    for (int I = 0; I < 4; ++I) {
        const int ti = 16 * I + li, t = tok0 + ti;
        const float tot = red[ti] + red[64 + ti] + red[128 + ti] + red[192 + ti];
        const float rstd = frsqrt(tot * (1.0f / 64.0f) + EPS);
        const half4 gt = *(const half4*)(P.p + (size_t)t * PPAD + gcol);
        f32x4 o;
#pragma unroll
        for (int r = 0; r < 4; ++r) o[r] = oacc[I][r] * rstd * gain[16 * w + 4 * g + r] * silu_f((float)gt[r]);
        *(half4*)(P.y + (size_t)t * D + ycol) = to_half4(o);
    }
    SYNC();
}
DEV void gla_scan(CP& P, int item, half_t* gst, int chain_off) {
    const int chain = item >> 1, e8 = ((item & 1) << 8) + TID(), d = e8 >> 3;
    half_t* base = gst + (size_t)(chain - chain_off) * NCH * 4096 + 8 * e8;
    const float* dec = P.gdec + (size_t)chain * NCH * 64 + d;
    const float z0 = opaque0();
    float s[8];
#pragma unroll
    for (int i = 0; i < 8; ++i) s[i] = z0;
    static_assert(NCH % 17 == 0 || NCH % 4 == 0, "scan batch");
    constexpr int BT = (NCH % 17 == 0) ? 17 : 4;
    for (int pos = 0; pos < NCH; pos += BT) {
        half8 ds[BT]; float dc[BT];
#pragma unroll
        for (int j = 0; j < BT; ++j) { ds[j] = *(const half8*)(base + (size_t)(pos + j) * 4096); dc[j] = dec[(pos + j) * 64]; }
#pragma unroll
        for (int j = 0; j < BT; ++j) {
            half8 o;
#pragma unroll
            for (int i = 0; i < 8; ++i) { o[i] = (half_t)s[i]; s[i] = s[i] * dc[j] + (float)ds[j][i]; }
            *(half8*)(base + (size_t)(pos + j) * 4096) = o;
        }
    }
}

DEV void up_glaa_item(CP& P, int l, int item, unsigned char* smem) {
    constexpr int NTM = NT / 256, NQ = NTM * 3, NKV = NTM * 4;
    if (item < NQ + NKV) {
        const bool isq = item < NQ;
        const int it = isq ? item : item - NQ, nn = isq ? 3 : 4, tm = it / nn, tn = it % nn;
        const int ldo = isq ? 384 : 512, kk = isq ? 192 : 128;
        ARowLin ar{P.p + (size_t)tm * 256 * PPAD + (isq ? O_CQ : O_CKV), PPAD};
        BSrcH bs{(isq ? P.wuq16 + (size_t)l * 192 * 384 : P.wukv16 + (size_t)l * 128 * 512) + tn * 128, ldo};
        EpiStoreH epi{(isq ? P.qraw : P.kvraw) + (size_t)tm * 256 * ldo + tn * 128, ldo};
        gemm256(ar, bs, kk, epi, smem);
    } else {
        int it = item - NQ - NKV;
        const int gidx = it % NCH; it /= NCH; const int dir = it & 1; it >>= 1; const int h = it & 3; it >>= 2; const int b = it % B_; const int mix = it / B_;
        SYNC();
        if (mix == 0) gla_step_a<0>(P, l, b, h, dir, gidx, smem); else gla_step_a<1>(P, l, b, h, dir, gidx, smem);
    }
}
DEV void phase_up_glaa(CP& P, int l, unsigned char* smem) {
    constexpr int NTM = NT / 256, NQ = NTM * 3, NKV = NTM * 4, NGA = 2 * B_ * 4 * 2 * NCH;
    for (int item = blockIdx.x; item < NQ + NKV + NGA; item += gridDim.x) up_glaa_item(P, l, item, smem);
    if (PROBE & 2) for (int item = blockIdx.x; item < NQ + NKV; item += gridDim.x) up_glaa_item(P, l, item, smem);
    if (PROBE & 4) for (int item = blockIdx.x; item < NGA; item += gridDim.x) up_glaa_item(P, l, NQ + NKV + item, smem);
}

DEV float sumsq8(half8 v) { float s = 0.f;
#pragma unroll
    for (int j = 0; j < 8; ++j) s += (float)v[j] * (float)v[j];
    return s; }
DEV float group8_sum(float v) { v += shfl_xor_f(v, 1); v += shfl_xor_f(v, 2); v += shfl_xor_f(v, 4); return v; }
struct PrepRegs {
    half8 pre[3], r1, r2, r3; f32x4 ga, gb, gc, gd, cs0, cs1, sn0, sn1; const float* g2; size_t row; bool lat;
};
DEV void prep_load(CP& P, int l, int t, int c, int job, int h, PrepRegs& R) {
    const half8 zero8 = {0, 0, 0, 0, 0, 0, 0, 0};
    const int b = t < NLAT ? t / SEQ : (t - NLAT) / CTX;
    R.lat = t < NLAT;
    const int n = R.lat ? t % SEQ : 0;
    const int pos = R.lat ? n : SEQ + (t - NLAT) % CTX;
    const half_t* pr = P.p + (size_t)t * PPAD;
    R.row = (size_t)(b * 4 + h) * KEYS + pos;
    R.pre[0] = zero8; R.pre[1] = zero8; R.pre[2] = zero8; R.r1 = zero8; R.r2 = zero8; R.r3 = zero8;
    const float* g1 = P.mla_g_qn; R.g2 = P.mla_g_qr;
    if (job < 4) {
        const half_t* qr = P.qraw + (size_t)t * 384 + h * 96;
#pragma unroll
        for (int i = 0; i < 3; ++i) R.pre[i] = *(const half8*)(pr + O_CQ + 8 * (c + 8 * i));
        R.r1 = *(const half8*)(qr + 8 * c); if (c < 4) R.r2 = *(const half8*)(qr + 64 + 8 * c);
        g1 = P.mla_g_qn + l * 64; R.g2 = P.mla_g_qr + l * 32;
    } else if (job < 8) {
        const half_t* kr = P.kvraw + (size_t)t * 512 + h * 128;
#pragma unroll
        for (int i = 0; i < 2; ++i) R.pre[i] = *(const half8*)(pr + O_CKV + 8 * (c + 8 * i));
        R.r1 = *(const half8*)(kr + 8 * c); R.r3 = *(const half8*)(kr + 64 + 8 * c); if (c < 4) R.r2 = *(const half8*)(pr + O_KR + 8 * c);
        g1 = P.mla_g_kn + l * 64; R.g2 = P.mla_g_kr + l * 32;
    } else if (job < 12) {
        R.r1 = *(const half8*)(pr + O_NAQ + h * 64 + 8 * c); R.r3 = *(const half8*)(pr + O_NAK + h * 64 + 8 * c);
        g1 = P.na_g_q + l * 64; R.g2 = P.na_g_k + l * 64;
    } else {
        R.r1 = *(const half8*)(pr + O_NAV + h * 64 + 8 * c);
    }
    R.ga = *(const f32x4*)(g1 + 8 * c); R.gb = *(const f32x4*)(g1 + 8 * c + 4);
    const int c2 = (job >= 8 && job < 12) ? c : (c & 3);
    R.gc = *(const f32x4*)(R.g2 + 8 * c2); R.gd = *(const f32x4*)(R.g2 + 8 * c2 + 4);
    R.cs0 = (f32x4){1.f, 1.f, 1.f, 1.f}; R.cs1 = R.cs0; R.sn0 = (f32x4){0.f, 0.f, 0.f, 0.f}; R.sn1 = R.sn0;
    if (R.lat && job < 8) { const float* cst = P.rope + (size_t)n * 32 + 8 * ((c >> 1) & 1); R.cs0 = *(const f32x4*)cst; R.cs1 = *(const f32x4*)(cst + 4); R.sn0 = *(const f32x4*)(cst + 16); R.sn1 = *(const f32x4*)(cst + 20); }
}
DEV void prep_finish(CP& P, int c, int job, PrepRegs& R) {
    const half8& r1 = R.r1; const half8& r2 = R.r2; const half8& r3 = R.r3;
    const f32x4 ga = R.ga, gb = R.gb, gc = R.gc, gd = R.gd, cs0 = R.cs0, cs1 = R.cs1, sn0 = R.sn0, sn1 = R.sn1;
    const float* g2 = R.g2; const size_t row = R.row;
    const float spre = group8_sum(sumsq8(R.pre[0]) + sumsq8(R.pre[1]) + sumsq8(R.pre[2]));
    const float s1 = group8_sum(sumsq8(r1)), s2 = group8_sum(sumsq8(r2)), s3 = group8_sum(sumsq8(r3));
    float part[8];
#pragma unroll
    for (int j = 0; j < 8; ++j) part[j] = shfl_xor_f((float)r2[j], 1);
    const float rpre = job < 4 ? frsqrt(spre * (1.0f / 192.0f) + EPS) : (job < 8 ? frsqrt(spre * (1.0f / 128.0f) + EPS) : 1.0f);
    if (job < 8) {
        const float qs = job < 4 ? 0.10206207261596575f * LOG2E : 1.0f;
        const float pre1 = rpre;
        const float rn = frsqrt(s1 * pre1 * pre1 * (1.0f / 64.0f) + EPS) * pre1 * qs;
        half8 o1;
#pragma unroll
        for (int j = 0; j < 4; ++j) { o1[j] = (half_t)((float)r1[j] * rn * ga[j]); o1[4 + j] = (half_t)((float)r1[4 + j] * rn * gb[j]); }
        half_t* d1 = (job < 4 ? P.mq : P.mk) + row * 96;
        *(half8*)(d1 + 8 * c) = o1;
        const float pre2 = job < 4 ? rpre : 1.0f;
        const float rr = frsqrt(s2 * pre2 * pre2 * (1.0f / 32.0f) + EPS) * pre2;
        half8 o2;
        const f32x4 pc = *(const f32x4*)(g2 + 8 * ((c & 3) ^ 1)), pd = *(const f32x4*)(g2 + 8 * ((c & 3) ^ 1) + 4);
        const float sgn = (c & 1) ? 1.f : -1.f;
#pragma unroll
        for (int j = 0; j < 8; ++j) {
            const float gown = j < 4 ? gc[j] : gd[j - 4], gp = j < 4 ? pc[j] : pd[j - 4];
            const float own = (float)r2[j] * rr * gown, oth = part[j] * rr * gp;
            const float cj = j < 4 ? cs0[j] : cs1[j - 4], sj = j < 4 ? sn0[j] : sn1[j - 4];
            o2[j] = (half_t)((own * cj + sgn * oth * sj) * qs);
        }
        if (c < 4) *(half8*)(d1 + 64 + 8 * c) = o2;
        if (job >= 4) {
            half8 o3;
#pragma unroll
            for (int j = 0; j < 8; ++j) o3[j] = (half_t)((float)r3[j] * rpre);
            *(half8*)(P.mv + row * 64 + 8 * c) = o3;
        }
    } else if (job < 12) {
        const float rq = frsqrt(s1 * (1.0f / 64.0f) + EPS) * (0.125f * LOG2E), rk = frsqrt(s3 * (1.0f / 64.0f) + EPS);
        half8 o1, o3;
#pragma unroll
        for (int j = 0; j < 4; ++j) {
            o1[j] = (half_t)((float)r1[j] * rq * ga[j]); o1[4 + j] = (half_t)((float)r1[4 + j] * rq * gb[j]);
            o3[j] = (half_t)((float)r3[j] * rk * gc[j]); o3[4 + j] = (half_t)((float)r3[4 + j] * rk * gd[j]);
        }
        *(half8*)(P.nq + row * 64 + 8 * c) = o1; *(half8*)(P.nk + row * 64 + 8 * c) = o3;
    } else {
        *(half8*)(P.nv + row * 64 + 8 * c) = r1;
    }
}
DEV void mixer_prep_item(CP& P, int l, int item) {
    const int tid = TID(), c = tid & 7, grp = tid >> 3, job = grp & 15, h = job & 3;
    for (int pass = 0; pass < 8; pass += 2) {
        PrepRegs Ra, Rb;
        prep_load(P, l, item * 16 + pass * 2 + (grp >> 4), c, job, h, Ra);
        prep_load(P, l, item * 16 + (pass + 1) * 2 + (grp >> 4), c, job, h, Rb);
        SCHED_FENCE();
        prep_finish(P, c, job, Ra);
        prep_finish(P, c, job, Rb);
    }
}
DEV void phase_prep_scan(CP& P, int l, int rep) {
    constexpr int NSCAN = 2 * B_ * 4 * 2 * 2;
    constexpr int NPREP = NT / 16;
    for (int item = blockIdx.x; item < NSCAN + NPREP; item += gridDim.x) {
        if (item < NSCAN) {
            if (!rep) gla_scan(P, item, (half_t*)P.gst, 0);
            else gla_scan(P, item, P.y, 0);
        }
        else mixer_prep_item(P, l, item - NSCAN);
    }
    if (PROBE & 8) for (int item = blockIdx.x; item < NPREP; item += gridDim.x) mixer_prep_item(P, l, item);
}

DEV half8 vt_frag(const half_t* Vs, int ldv, int kbase, int dv0, int lane) {
    const int grp = lane >> 4, hh = lane >> 5, i = lane & 15, q = i >> 2, pp = i & 3;
    const half_t* a = Vs + (kbase + 4 * hh + q) * ldv + dv0 + 16 * (grp & 1) + 4 * pp;
    const half4 lo = tr16(a), hi = tr16(a + 8 * ldv);
    half8 r; r[0] = lo[0]; r[1] = lo[1]; r[2] = lo[2]; r[3] = lo[3]; r[4] = hi[0]; r[5] = hi[1]; r[6] = hi[2]; r[7] = hi[3]; return r;
}
DEV void softmax_pv_step(const f32x16& s, float& m, float& lsum, f32x16 (&o)[2], const half_t* Vs, int ldv, int lane) {
    float mx = s[0];
#pragma unroll
    for (int r = 1; r < 16; ++r) mx = fmaxf(mx, s[r]);
    mx = fmaxf(mx, shfl_xor_f(mx, 32));
    const float mn = fmaxf(m, mx);
    const float alpha = fexp2(m - mn);
    m = mn;
    float ps = 0.f; half8 pf[2];
#pragma unroll
    for (int r = 0; r < 16; ++r) { const float pv = fexp2(s[r] - mn); ps += pv; pf[r >> 3][r & 7] = (half_t)pv; }
    lsum = lsum * alpha + ps;
#pragma unroll
    for (int dt = 0; dt < 2; ++dt)
#pragma unroll
        for (int r = 0; r < 16; ++r) o[dt][r] *= alpha;
#pragma unroll
    for (int s2 = 0; s2 < 2; ++s2)
#pragma unroll
        for (int dt = 0; dt < 2; ++dt) o[dt] = mfma32(vt_frag(Vs, ldv, 16 * s2, 32 * dt, lane), pf[s2], o[dt]);
}
DEV void softmax_pv_step2(const f32x16& s0, const f32x16& s1, float& m, float& lsum, f32x16 (&o)[2], const half_t* Vs, int ldv, int lane) {
    float mx = fmaxf(s0[0], s1[0]);
#pragma unroll
    for (int r = 1; r < 16; ++r) mx = fmaxf(mx, fmaxf(s0[r], s1[r]));
    mx = fmaxf(mx, shfl_xor_f(mx, 32));
    const float mn = fmaxf(m, mx);
    if (wave_any(mn != m)) {
        const float alpha = fexp2(m - mn);
        lsum *= alpha;
#pragma unroll
        for (int dt = 0; dt < 2; ++dt)
#pragma unroll
            for (int r = 0; r < 16; ++r) o[dt][r] *= alpha;
        m = mn;
    }
    float ps = 0.f; half8 pf[4];
#pragma unroll
    for (int r = 0; r < 16; ++r) { const float pa = fexp2(s0[r] - m), pb = fexp2(s1[r] - m); ps += pa + pb; pf[r >> 3][r & 7] = (half_t)pa; pf[2 + (r >> 3)][r & 7] = (half_t)pb; }
    lsum += ps;
#pragma unroll
    for (int kt2 = 0; kt2 < 2; ++kt2)
#pragma unroll
        for (int s2 = 0; s2 < 2; ++s2)
#pragma unroll
            for (int dt = 0; dt < 2; ++dt) o[dt] = mfma32(vt_frag(Vs + 32 * kt2 * ldv, ldv, 16 * s2, 32 * dt, lane), pf[2 * kt2 + s2], o[dt]);
}
DEV void attn_store(const f32x16 (&o)[2], float lsum, half_t* yrow, int lane) {
    const float inv = 1.0f / (lsum + shfl_xor_f(lsum, 32));
    const int hh = lane >> 5;
#pragma unroll
    for (int dt = 0; dt < 2; ++dt)
#pragma unroll
        for (int rq = 0; rq < 4; ++rq) {
            half4 v;
#pragma unroll
            for (int e = 0; e < 4; ++e) v[e] = (half_t)(o[dt][4 * rq + e] * inv);
            *(half4*)(yrow + 32 * dt + 8 * rq + 4 * hh) = v;
        }
}
DEV int attn_qtoken(int b, int qpos) { return qpos < SEQ ? b * SEQ + qpos : NLAT + b * CTX + (qpos - SEQ); }

constexpr int MS_K = 64 * 96, MS_V = 64 * 64, MS_STAGE = MS_K + MS_V;
DEV half8 vt_frag_swz(const half_t* Vs, int kbase, int dv0, int lane) {
    const int grp = lane >> 4, hh = lane >> 5, i = lane & 15, q = i >> 2, pp = i & 3;
    const int r0 = kbase + 4 * hh + q, col = dv0 + 16 * (grp & 1) + 4 * pp;
    const int ch = (col >> 3) ^ (4 * ((r0 >> 1) & 1));
    const half_t* a = Vs + r0 * 64 + ch * 8 + (col & 7);
    const half4 lo = tr16_nowait<0>(a), hi = tr16_nowait<8 * 64 * 2>(a);
    half8 r; r[0] = lo[0]; r[1] = lo[1]; r[2] = lo[2]; r[3] = lo[3]; r[4] = hi[0]; r[5] = hi[1]; r[6] = hi[2]; r[7] = hi[3]; return r;
}
#define MLA_ISSUE(ST, KT)                                                                                                         \
    {                                                                                                                             \
        half_t* sk_ = mring + (ST) * MS_STAGE; half_t* sv_ = sk_ + MS_K;                                                          \
        const half_t* kg_ = kg + (size_t)(KT) * 64 * 96; const half_t* vg_ = vg + (size_t)(KT) * 64 * 64;                         \
        _Pragma("unroll") for (int j = 0; j < 3; ++j) glds16(kg_ + ksrc[j], sk_ + (3 * w + j) * 512);                             \
        _Pragma("unroll") for (int j = 0; j < 2; ++j) glds16(vg_ + vsrc[j], sv_ + (2 * w + j) * 512);                             \
    }
#define MLA_COMPUTE(ST)                                                                                                           \
    {                                                                                                                             \
        const half_t* Ks = mring + (ST) * MS_STAGE; const half_t* Vs = Ks + MS_K;                                                 \
        f32x16 s0, s1;                                                                                                            \
        _Pragma("unroll") for (int r = 0; r < 16; ++r) { s0[r] = 0.f; s1[r] = 0.f; }                                              \
        half8 kf0[6], kf1[6];                                                                                                     \
        _Pragma("unroll") for (int ks = 0; ks < 6; ++ks) {                                                                        \
            const int p = 2 * ks + hh, pz = (p & ~3) | ((p & 3) ^ ((ql >> 2) & 3));      \
            kf0[ks] = *(const half8*)(Ks + ql * 96 + pz * 8); kf1[ks] = *(const half8*)(Ks + (32 + ql) * 96 + pz * 8);            \
        }                                                                                                                         \
        SCHED_FENCE();                                                \
        _Pragma("unroll") for (int ks = 0; ks < 6; ++ks) { s0 = mfma32(kf0[ks], qf[ks], s0); s1 = mfma32(kf1[ks], qf[ks], s1); }  \
        softmax_pv_step2s(s0, s1, m, lsum, o, Vs, lane);                                                                          \
    }
#define MLA_STEP(ST, ST2, ktv)                                                                                                    \
    {                                                                                                                             \
        const int kt_ = (ktv);                                                                                                    \
        if (kt_ + 1 < nkt) { WAIT_VM(5); } else { WAIT_VM(0); }                                                                   \
        RAW_BARRIER();                                                                                                            \
        if (kt_ + 2 < nkt) MLA_ISSUE(ST2, kt_ + 2)                                                                                \
        MLA_COMPUTE(ST)                                                                                                           \
    }
DEV void softmax_pv_step2s(const f32x16& s0, const f32x16& s1, float& m, float& lsum, f32x16 (&o)[2], const half_t* Vs, int lane) {
    float mx = fmaxf(s0[0], s1[0]);
#pragma unroll
    for (int r = 1; r < 16; ++r) mx = fmaxf(mx, fmaxf(s0[r], s1[r]));
    mx = fmaxf(mx, shfl_xor_f(mx, 32));
    const float mn = fmaxf(m, mx);
    if (wave_any(mn != m)) {
        const float alpha = fexp2(m - mn);
        lsum *= alpha;
#pragma unroll
        for (int dt = 0; dt < 2; ++dt)
#pragma unroll
            for (int r = 0; r < 16; ++r) o[dt][r] *= alpha;
        m = mn;
    }
    half8 vf[8];
#pragma unroll
    for (int kt2 = 0; kt2 < 2; ++kt2)
#pragma unroll
        for (int s2 = 0; s2 < 2; ++s2)
#pragma unroll
            for (int dt = 0; dt < 2; ++dt) vf[4 * kt2 + 2 * s2 + dt] = vt_frag_swz(Vs, 32 * kt2 + 16 * s2, 32 * dt, lane);
    float ps = 0.f; half8 pf[4];
#pragma unroll
    for (int r = 0; r < 16; ++r) { const float pa = fexp2(s0[r] - m), pb = fexp2(s1[r] - m); ps += pa + pb; pf[r >> 3][r & 7] = (half_t)pa; pf[2 + (r >> 3)][r & 7] = (half_t)pb; }
    lsum += ps;
    TR_WAIT();
#pragma unroll
    for (int kt2 = 0; kt2 < 2; ++kt2)
#pragma unroll
        for (int s2 = 0; s2 < 2; ++s2)
#pragma unroll
            for (int dt = 0; dt < 2; ++dt) o[dt] = mfma32(vf[4 * kt2 + 2 * s2 + dt], pf[2 * kt2 + s2], o[dt]);
}
DEV void mla_attn_item(CP& P, int b, int h, int qt, unsigned char* smem) {
    half_t* mring = (half_t*)smem;
    const int tid = TID(), lane = tid & 63, w = WID(tid), hh = lane >> 5, ql = lane & 31;
    const size_t bh = (size_t)(b * 4 + h) * KEYS;
    const int q0 = qt * 128 + 32 * w;
    const bool ctxq = q0 >= SEQ;
    const int kbeg = ctxq ? SEQ : 0, nkt = (ctxq ? CTX : KEYS) / 64;
    half8 qf[6];
#pragma unroll
    for (int ks = 0; ks < 6; ++ks) qf[ks] = *(const half8*)(P.mq + (bh + q0 + ql) * 96 + 16 * ks + 8 * hh);
    f32x16 o[2]; float m = -1e30f, lsum = 0.f;
#pragma unroll
    for (int dt = 0; dt < 2; ++dt)
#pragma unroll
        for (int r = 0; r < 16; ++r) o[dt][r] = 0.f;
    const half_t* kg = P.mk + (bh + kbeg) * 96; const half_t* vg = P.mv + (bh + kbeg) * 64;
    int ksrc[3], vsrc[2];
#pragma unroll
    for (int j = 0; j < 3; ++j) { const int L = (3 * w + j) * 64 + lane, r = L / 12, p = L % 12; ksrc[j] = r * 96 + 8 * ((p & ~3) | ((p & 3) ^ ((r >> 2) & 3))); }
#pragma unroll
    for (int j = 0; j < 2; ++j) { const int L = (2 * w + j) * 64 + lane, r = L >> 3, p = L & 7; vsrc[j] = r * 64 + 8 * (p ^ (4 * ((r >> 1) & 1))); }
    SYNC();
    MLA_ISSUE(0, 0)
    MLA_ISSUE(1, 1)
#pragma clang loop unroll(disable)
    for (int kt = 0; kt < nkt; kt += 3) {
        MLA_STEP(0, 2, kt)
        if (kt + 1 < nkt) MLA_STEP(1, 0, kt + 1)
        if (kt + 2 < nkt) MLA_STEP(2, 1, kt + 2)
    }
    attn_store(o, lsum, P.y + (size_t)attn_qtoken(b, q0 + ql) * D + 0 + h * 64, lane);
}

constexpr int NV_LD = 72, NA_WAVE_LDS = 32 * NV_LD * 2 + 15 * 32 * 4;
DEV void na_attn_unit(CP& P, int l, int unit, unsigned char* wlds, int lane) {
    constexpr int NLATU = B_ * 4 * ROWS * 2;
    half_t* Vw = (half_t*)wlds; float* bt = (float*)(wlds + 32 * NV_LD * 2);
    const int hh = lane >> 5, ql = lane & 31;
    int b, h, q0, ntile, R0 = 0, r = 0, hf = 0; bool lat;
    if (unit < NLATU) { lat = true; hf = unit & 1; r = (unit >> 1) % ROWS; const int bh = unit / (2 * ROWS); h = bh & 3; b = bh >> 2; q0 = r * 64 + 32 * hf; ntile = 16 + CTX / 32;
        R0 = r - 4 < 0 ? 0 : (r - 4 > ROWS - 8 ? ROWS - 8 : r - 4); }
    else { lat = false; const int u = unit - NLATU; const int cb = u % (CTX / 32); const int bh = u / (CTX / 32); h = bh & 3; b = bh >> 2; q0 = SEQ + 32 * cb; ntile = CTX / 32; }
    const size_t bhk = (size_t)(b * 4 + h) * KEYS;
    WAVE_BARRIER();
    if (lat) {
        const float* rp = P.na_rpb + (size_t)(l * 4 + h) * 15 * 31;
        for (int i = lane; i < 15 * 32; i += 64) { const int dr = i >> 5, dc = i & 31; bt[i] = dc < 31 ? rp[dr * 31 + dc] * LOG2E : 0.f; }
    }
    half8 qf[4];
#pragma unroll
    for (int ks = 0; ks < 4; ++ks) qf[ks] = *(const half8*)(P.nq + (bhk + q0 + ql) * 64 + 16 * ks + 8 * hh);
    f32x16 o[2]; float m = -1e30f, lsum = 0.f;
#pragma unroll
    for (int dt = 0; dt < 2; ++dt)
#pragma unroll
        for (int rr = 0; rr < 16; ++rr) o[dt][rr] = 0.f;
    const int wq = 32 * hf + ql;
    const int cs = wq - 8 < 0 ? 0 : (wq - 8 > 48 ? 48 : wq - 8);
    auto tile_kpos = [&](int tile) { return (lat && tile < 16) ? (R0 + (tile >> 1)) * 64 + 32 * (tile & 1) : SEQ + 32 * (lat ? tile - 16 : tile); };
    half8 kf[4], vf[4];
    {
        const int kp = tile_kpos(0);
#pragma unroll
        for (int ks = 0; ks < 4; ++ks) kf[ks] = *(const half8*)(P.nk + (bhk + kp + ql) * 64 + 16 * ks + 8 * hh);
#pragma unroll
        for (int i = 0; i < 4; ++i) { const int c = lane + 64 * i; vf[i] = *(const half8*)(P.nv + (bhk + kp + (c >> 3)) * 64 + (c & 7) * 8); }
    }
    for (int tile = 0; tile < ntile; ++tile) {
        const bool win = lat && tile < 16;
        const int krow = R0 + (tile >> 1), kh2 = tile & 1;
        f32x16 s;
#pragma unroll
        for (int rr = 0; rr < 16; ++rr) s[rr] = 0.f;
#pragma unroll
        for (int ks = 0; ks < 4; ++ks) s = mfma32(kf[ks], qf[ks], s);
        WAVE_BARRIER();
#pragma unroll
        for (int i = 0; i < 4; ++i) { const int c = lane + 64 * i; *(half8*)(Vw + (c >> 3) * NV_LD + (c & 7) * 8) = vf[i]; }
        if (tile + 1 < ntile) {
            const int kp = tile_kpos(tile + 1);
#pragma unroll
            for (int ks = 0; ks < 4; ++ks) kf[ks] = *(const half8*)(P.nk + (bhk + kp + ql) * 64 + 16 * ks + 8 * hh);
#pragma unroll
            for (int i = 0; i < 4; ++i) { const int c = lane + 64 * i; vf[i] = *(const half8*)(P.nv + (bhk + kp + (c >> 3)) * 64 + (c & 7) * 8); }
        }
        SCHED_FENCE();
        if (win) {
            const float* brow = bt + (krow - r + 7) * 32;
            float bv[16];
#pragma unroll
            for (int rr = 0; rr < 16; ++rr) {
                const int wk = 32 * kh2 + (rr & 3) + 8 * (rr >> 2) + 4 * hh;
                int dc = wk - wq + 15; dc = dc < 0 ? 0 : (dc > 30 ? 30 : dc);
                bv[rr] = brow[dc];
            }
#pragma unroll
            for (int rr = 0; rr < 16; ++rr) {
                const int wk = 32 * kh2 + (rr & 3) + 8 * (rr >> 2) + 4 * hh;
                const bool valid = wk >= cs && wk < cs + 16;
                s[rr] = valid ? s[rr] + bv[rr] : -INFINITY;
            }
        }
        WAVE_BARRIER();
        softmax_pv_step(s, m, lsum, o, Vw, NV_LD, lane);
    }
    attn_store(o, lsum, P.y + (size_t)attn_qtoken(b, q0 + ql) * D + 256 + h * 64, lane);
}

DEV void mixers_item(CP& P, int l, int item, unsigned char* smem) {
    const bool last = l == NL - 1;
    const int QT = (last ? SEQ : KEYS) / 128;
    const int NMLA = B_ * 4 * QT;
    const int NNA = (B_ * 4 * ROWS * 2 + (last ? 0 : B_ * 4 * (CTX / 32))) / 4;
    const int NGRP = last ? LG : NCH;
    const int lane = TID() & 63, w = TID() >> 6;
    if (item < NMLA) {
        const int qt = item % QT, bh = item / QT;
        mla_attn_item(P, bh >> 2, bh & 3, qt, smem);
    } else if (item < NMLA + NNA) {
        SYNC();
        na_attn_unit(P, l, (item - NMLA) * 4 + w, smem + w * NA_WAVE_LDS, lane);
    } else {
        int it = item - NMLA - NNA;
        const int gi = it % NGRP; it /= NGRP; const int h = it & 3; it >>= 2; const int b = it % B_; const int mix = it / B_;
        const int gidx = last ? gi + CG : gi;
        SYNC();
        if (mix == 0) gla_step_c<0>(P, l, b, h, gidx, smem); else gla_step_c<1>(P, l, b, h, gidx, smem);
    }
}
DEV int sched_next(int* ctr, unsigned char* smem) {
    int* slot = (int*)(smem + SMEM_BYTES - 16);
    SYNC();
    if (TID() == 0) *slot = atomic_add_i(ctr, 1);
    SYNC();
    return *slot;
}
constexpr int NCONV = 1024;
constexpr int CV_W13 = NEXP * D * 1024 / 8, CV_W2 = NEXP * 512 * D / 8;
DEV void moe_convert_unit(CP& P, int l, int u) {
    constexpr int PER = (CV_W13 + CV_W2) / NCONV;
    static_assert((CV_W13 + CV_W2) % NCONV == 0 && PER % NTHREADS == 0, "conversion split");
    const int tid = TID();
    for (int i0 = 0; i0 < PER; i0 += 4 * NTHREADS) {
        RawF r[4]; int c[4];
#pragma unroll
        for (int j = 0; j < 4; ++j) {
            c[j] = u * PER + i0 + j * NTHREADS + tid;
            const float* src;
            if (c[j] < CV_W13) {
                const int v = (c[j] & 127) * 8, k = (c[j] >> 7) & 1023, e = c[j] >> 17;
                const int tn = v >> 7, half = (v >> 6) & 1, col = 64 * tn + (v & 63);
                src = (half ? P.moe_w3 : P.moe_w1) + (((size_t)l * NEXP + e) * D + k) * 512 + col;
            } else { src = P.moe_w2 + (size_t)l * NEXP * 512 * D + (size_t)(c[j] - CV_W13) * 8; }
            r[j].a = *(const f32x4*)src; r[j].b = *(const f32x4*)(src + 4);
        }
        SCHED_FENCE();
#pragma unroll
        for (int j = 0; j < 4; ++j) {
            half_t* dst = c[j] < CV_W13 ? P.w13h + (size_t)c[j] * 8 : P.w2h + (size_t)(c[j] - CV_W13) * 8;
            *(half8*)dst = cvt_rawf(r[j]);
        }
    }
}
DEV void phase_mixers(CP& P, int l, unsigned char* smem, int rep) {
    const bool last = l == NL - 1;
    const int QT = (last ? SEQ : KEYS) / 128;
    const int NMLA = B_ * 4 * QT;
    const int NNA = (B_ * 4 * ROWS * 2 + (last ? 0 : B_ * 4 * (CTX / 32))) / 4;
    const int NGC = 2 * B_ * 4 * (last ? LG : NCH);
    const int NCV = rep ? 0 : NCONV;
    const int NIL = NMLA < NCV ? NMLA : NCV;
    const int NU = NMLA + NCV + NNA + NGC / 4;
    int* ctr = P.sched + l * 16 + rep;
    for (int u = sched_next(ctr, smem); u < NU; u = sched_next(ctr, smem)) {
        if (u < 2 * NIL) { if (u & 1) moe_convert_unit(P, l, u >> 1); else mixers_item(P, l, u >> 1, smem); }
        else if (u < NMLA + NCV) { const int v = u - 2 * NIL; if (NMLA > NCV) mixers_item(P, l, NIL + v, smem); else moe_convert_unit(P, l, NIL + v); }
        else if (u < NMLA + NCV + NNA) mixers_item(P, l, u - NCV, smem);
        else { const int g0 = NMLA + NNA + (u - NMLA - NCV - NNA) * 4; for (int j = 0; j < 4; ++j) mixers_item(P, l, g0 + j, smem); }
    }
    if (PROBE & 16) for (int item = blockIdx.x; item < NMLA; item += gridDim.x) mixers_item(P, l, item, smem);
    if (PROBE & 32) for (int item = blockIdx.x; item < NNA; item += gridDim.x) mixers_item(P, l, NMLA + item, smem);
    if (PROBE & 64) for (int item = blockIdx.x; item < NGC; item += gridDim.x) mixers_item(P, l, NMLA + NNA + item, smem);
}

DEV void phase_outproj(CP& P, int l, unsigned char* smem, int rep0) {
    const bool last = l == NL - 1;
    const int NTM = (last ? NLAT : NT) / 256;
    const int full = (NTM * 8) / gridDim.x;
    for (int rep = rep0; rep < ((PROBE & 512) ? 2 : rep0 + 1); ++rep) {
        for (int round = 0; round < full; ++round) {
            int tm, tn;
            if (!gemm_tile_order(round, NTM, 8, tm, tn)) continue;
            const int t0 = tm * 256;
            ARowLin ar{P.y + (size_t)t0 * D, D};
            BSrcH bs{P.wout16 + (size_t)l * D * D + tn * 128, D};
            EpiResid epi{(rep ? P.gst + (size_t)t0 * D : xrow_ptr(P, t0)) + tn * 128, (l == 0 ? xin_ptr(P, t0) : (const float*)xrow_ptr(P, t0)) + tn * 128, P.mod + ((size_t)l * (B_ + 1) + tok_brow(t0)) * MODW + 2 * D + tn * 128};
            gemm_tile<4>(ar, bs, D, epi, smem);
        }
        const int base = full * gridDim.x, left = NTM * 8 - base;
        for (int i = blockIdx.x; i < 4 * left; i += gridDim.x) {
            int tm, tn; gemm_tile_idx(base + (i >> 2), NTM, 8, tm, tn);
            const int t0 = tm * 256 + 64 * (i & 3);
            ARowLin ar{P.y + (size_t)t0 * D, D};
            BSrcH bs{P.wout16 + (size_t)l * D * D + tn * 128, D};
            EpiResid epi{(rep ? P.gst + (size_t)t0 * D : xrow_ptr(P, t0)) + tn * 128, (l == 0 ? xin_ptr(P, t0) : (const float*)xrow_ptr(P, t0)) + tn * 128, P.mod + ((size_t)l * (B_ + 1) + tok_brow(t0)) * MODW + 2 * D + tn * 128};
            gemm_tile<1>(ar, bs, D, epi, smem);
        }
    }
}

template <bool DRY> DEV void phase_router_t(CP& P, int l, unsigned char* smem) {
    const bool last = l == NL - 1;
    const int NU = (last ? NLAT : NT) / 16;
    const int tid = TID(), lane = tid & 63, w = WID(tid), g = lane >> 4, li = lane & 15;
    float* wrs = (float*)smem + w * 64 * 52;
    float* red = (float*)(smem + 4 * 64 * 52 * 4);
    float* lg = red + 4 * 64 * 13;
    const float* wr = P.wr + (size_t)l * D * 48;
    for (int unit = blockIdx.x; unit < NU; unit += gridDim.x) {
        const int tok0 = unit * 16, br = tok_brow(tok0);
        const float* xr = xrow_ptr(P, tok0 + li);
        const float* md = P.mod + ((size_t)l * (B_ + 1) + br) * MODW;
        const float* sh = md + 3 * D; const float* sc = md + 4 * D;
        const int kbase = 256 * w;
        f32x4 acc[3];
#pragma unroll
        for (int nt = 0; nt < 3; ++nt) acc[nt] = (f32x4){0.f, 0.f, 0.f, 0.f};
        float ssq = 0.f;
        f32x4 wv[6], xv[2], sv[2];
#pragma unroll
        for (int i = 0; i < 6; ++i) { const int idx = lane + 64 * i; wv[i] = *(const f32x4*)(wr + (size_t)(kbase + idx / 12) * 48 + (idx % 12) * 4); }
#pragma unroll
        for (int j = 0; j < 2; ++j) { xv[j] = *(const f32x4*)(xr + kbase + 16 * j + 4 * g); sv[j] = *(const f32x4*)(sc + kbase + 16 * j + 4 * g); }
        for (int ch = 0; ch < 8; ++ch) {
            WAVE_BARRIER();
#pragma unroll
            for (int i = 0; i < 6; ++i) { const int idx = lane + 64 * i; *(f32x4*)(wrs + (idx / 12) * 52 + (idx % 12) * 4) = wv[i]; }
            WAVE_BARRIER();
            f32x4 xc[2], sk[2];
#pragma unroll
            for (int j = 0; j < 2; ++j) { xc[j] = xv[j]; sk[j] = sv[j]; }
            if (ch + 1 < 8) {
                const int k1 = kbase + 32 * (ch + 1);
#pragma unroll
                for (int i = 0; i < 6; ++i) { const int idx = lane + 64 * i; wv[i] = *(const f32x4*)(wr + (size_t)(k1 + idx / 12) * 48 + (idx % 12) * 4); }
#pragma unroll
                for (int j = 0; j < 2; ++j) { xv[j] = *(const f32x4*)(xr + k1 + 16 * j + 4 * g); sv[j] = *(const f32x4*)(sc + k1 + 16 * j + 4 * g); }
            }
            SCHED_FENCE();
#pragma unroll
            for (int j = 0; j < 2; ++j) {
                ssq += xc[j][0] * xc[j][0] + xc[j][1] * xc[j][1] + xc[j][2] * xc[j][2] + xc[j][3] * xc[j][3];
#pragma unroll
                for (int c = 0; c < 4; ++c) {
                    const float a = xc[j][c] * (1.0f + sk[j][c]);
                    const float* wrow_l = wrs + (16 * j + 4 * g + c) * 52 + li;
#pragma unroll
                    for (int nt = 0; nt < 3; ++nt) acc[nt] = mfmaf(a, wrow_l[16 * nt], acc[nt]);
                }
            }
        }
        SYNC();
        {
            float* rp = red + (w * 64 + lane) * 13;
#pragma unroll
            for (int nt = 0; nt < 3; ++nt)
#pragma unroll
                for (int r = 0; r < 4; ++r) rp[4 * nt + r] = acc[nt][r];
            rp[12] = ssq;
        }
        SYNC();
        float tot[13];
#pragma unroll
        for (int i = 0; i < 13; ++i) tot[i] = (red[lane * 13 + i] + red[(64 + lane) * 13 + i]) + (red[(128 + lane) * 13 + i] + red[(192 + lane) * 13 + i]);
        float sq = tot[12];
        sq += shfl_xor_f(sq, 16); sq += shfl_xor_f(sq, 32);
        const float rstd = frsqrt(sq * (1.0f / D) + EPS);
        const float* csh = P.cshift + ((size_t)l * (B_ + 1) + br) * 48;
        if (w == 0) {
#pragma unroll
            for (int r = 0; r < 4; ++r) {
                const float rs = shfl_f(rstd, 4 * g + r);
#pragma unroll
                for (int nt = 0; nt < 3; ++nt) lg[(4 * g + r) * 48 + 16 * nt + li] = tot[4 * nt + r] * rs + csh[16 * nt + li];
            }
            WAVE_BARRIER();
            if (lane < 16) {
                const float* lt = lg + lane * 48;
                int gi = 0; float gm = lt[0];
                for (int j = 1; j < 4; ++j) if (lt[j] > gm) { gm = lt[j]; gi = j; }
                float gden = 0.f; for (int j = 0; j < 4; ++j) gden += fexp(lt[j] - gm);
                const float pg = 1.0f / gden;
                const float* ft = lt + 4 + gi * 8;
                int e0 = 0; float f0 = ft[0];
                for (int j = 1; j < 8; ++j) if (ft[j] > f0) { f0 = ft[j]; e0 = j; }
                int e1 = -1; float f1 = -3.0e38f;
                for (int j = 0; j < 8; ++j) if (j != e0 && ft[j] > f1) { f1 = ft[j]; e1 = j; }
                const float p1 = fexp(f1 - f0);
                const float g0 = pg / (1.0f + p1), g1 = pg * p1 / (1.0f + p1);
                const int t = tok0 + lane, x0 = gi * 8 + e0, x1 = gi * 8 + e1;
                if (DRY) { float* dd = (float*)P.act + (size_t)t * 4; dd[0] = g0; dd[1] = g1; dd[2] = (float)x0; dd[3] = (float)x1; }
                else {
                const int s0 = atomic_add_i(P.cnt + l * NEXP + x0, 1), s1 = atomic_add_i(P.cnt + l * NEXP + x1, 1);
                P.list_tok[(size_t)x0 * NT + s0] = t; P.list_gate[(size_t)x0 * NT + s0] = g0;
                P.list_tok[(size_t)x1 * NT + s1] = t; P.list_gate[(size_t)x1 * NT + s1] = g1;
                P.tokslot[2 * t] = (x0 << 20) | s0; P.tokslot[2 * t + 1] = (x1 << 20) | s1;
                }
            }
        }
        half_t* hr = (DRY ? P.y : P.h) + (size_t)(tok0 + li) * D + kbase;
        for (int k4 = 0; k4 < 16; k4 += 4) {
            f32x4 xq[4], sq4[4], hq[4];
#pragma unroll
            for (int j = 0; j < 4; ++j) { const int col = 16 * (k4 + j) + 4 * g; xq[j] = *(const f32x4*)(xr + kbase + col); sq4[j] = *(const f32x4*)(sc + kbase + col); hq[j] = *(const f32x4*)(sh + kbase + col); }
            SCHED_FENCE();
#pragma unroll
            for (int j = 0; j < 4; ++j) {
                f32x4 o;
#pragma unroll
                for (int c = 0; c < 4; ++c) o[c] = xq[j][c] * rstd * (1.0f + sq4[j][c]) + hq[j][c];
                *(half4*)(hr + 16 * (k4 + j) + 4 * g) = to_half4(o);
            }
        }
    }
}

DEV void phase_router(CP& P, int l, unsigned char* smem, int rep) {
    if (rep) { phase_router_t<true>(P, l, smem); return; }
    phase_router_t<false>(P, l, smem);
    if (PROBE & 1024) phase_router_t<true>(P, l, smem);
}
DEV void moe_tables(CP& P, int l, int* ab, int* tb) {
    if (TID() == 0) {
        int a = 0, t = 0;
        for (int e = 0; e < NEXP; ++e) { const int c = P.cnt[l * NEXP + e], nt = (c + 255) >> 8; ab[e] = a; tb[e] = t; a += nt * 256; t += nt; }
        ab[NEXP] = a; tb[NEXP] = t;
    }
    SYNC();
}
DEV int moe_find(const int* tb, int tile) { int e = 0; while (e < NEXP - 1 && tile >= tb[e + 1]) ++e; return e; }
DEV bool moe_item(const int* tb, int idx, int& e, int& mt, int& tn) {
    const int x = blockIdx.x & 7;
#pragma unroll
    for (int eg = 0; eg < 4; ++eg) {
        e = x + 8 * eg; const int n = (tb[e + 1] - tb[e]) * 8;
        if (idx < n) { mt = idx >> 3; tn = idx & 7; return true; }
        idx -= n;
    }
    return false;
}

DEV void phase_moe1(CP& P, int l, unsigned char* smem) {
    int* ab = (int*)(smem + SMEM_BYTES - 512); int* tb = ab + 40;
    moe_tables(P, l, ab, tb);
    for (int rep = 0; rep < ((PROBE & 128) ? 2 : 1); ++rep)
    for (int idx = blockIdx.x >> 3;; idx += gridDim.x >> 3) {
        int e, mt, tn; if (!moe_item(tb, idx, e, mt, tn)) break;
        const int cnt = P.cnt[l * NEXP + e], nvalid = cnt - mt * 256 < 256 ? cnt - mt * 256 : 256;
        ARowGather ar{P.h, D, P.list_tok + (size_t)e * NT + mt * 256, nvalid};
        BSrcH bs{P.w13h + (size_t)e * D * 1024 + tn * 128, 1024};
        EpiGlu epi{P.act + (size_t)(ab[e] + mt * 256) * 512 + tn * 64, 512};
        gemm256(ar, bs, D, epi, smem);
    }
}
DEV void phase_moe2(CP& P, int l, unsigned char* smem) {
    int* ab = (int*)(smem + SMEM_BYTES - 512); int* tb = ab + 40;
    moe_tables(P, l, ab, tb);
    for (int rep = 0; rep < ((PROBE & 256) ? 2 : 1); ++rep)
    for (int idx = blockIdx.x >> 3;; idx += gridDim.x >> 3) {
        int e, mt, tn; if (!moe_item(tb, idx, e, mt, tn)) break;
        const int cnt = P.cnt[l * NEXP + e], nvalid = cnt - mt * 256 < 256 ? cnt - mt * 256 : 256;
        const size_t r0 = (size_t)ab[e] + mt * 256;
        ARowLin ar{P.act + r0 * 512, 512};
        BSrcH bs{P.w2h + (size_t)e * 512 * D + tn * 128, D};
        EpiRowsGate epi{P.yrows + r0 * D + tn * 128, P.list_gate + (size_t)e * NT + mt * 256, nvalid};
        gemm256(ar, bs, 512, epi, smem);
    }
}
template <bool DRY> DEV void phase_combine_t(CP& P, int l, unsigned char* smem) {
    int* ab = (int*)(smem + SMEM_BYTES - 512); int* tb = ab + 40;
    moe_tables(P, l, ab, tb);
    const bool last = l == NL - 1;
    const int NTK = last ? NLAT : NT;
    const int lane = TID() & 63, gw = blockIdx.x * 4 + (TID() >> 6), nw = gridDim.x * 4;
    for (int t = gw; t < NTK; t += nw) {
        const int ts0 = P.tokslot[2 * t], ts1 = P.tokslot[2 * t + 1];
        const half_t* y0 = P.yrows + (size_t)(ab[ts0 >> 20] + (ts0 & 0xFFFFF)) * D;
        const half_t* y1 = P.yrows + (size_t)(ab[ts1 >> 20] + (ts1 & 0xFFFFF)) * D;
        float* xr = xrow_ptr(P, t);
        float* xw = DRY ? P.gst + (size_t)t * D : xr;
        const float* md = P.mod + ((size_t)l * (B_ + 1) + tok_brow(t)) * MODW;
        f32x4 v[4], xv[4], gt[4]; half4 ya[4], yb[4];
#pragma unroll
        for (int j = 0; j < 4; ++j) {
            const int col = 256 * j + 4 * lane;
            xv[j] = *(const f32x4*)(xr + col); gt[j] = *(const f32x4*)(md + 5 * D + col); ya[j] = *(const half4*)(y0 + col); yb[j] = *(const half4*)(y1 + col);
        }
        SCHED_FENCE();
#pragma unroll
        for (int j = 0; j < 4; ++j) {
            const int col = 256 * j + 4 * lane;
#pragma unroll
            for (int e = 0; e < 4; ++e) v[j][e] = xv[j][e] + gt[j][e] * ((float)ya[j][e] + (float)yb[j][e]);
            *(f32x4*)(xw + col) = v[j];
        }
        if (!last) { const float* mn = md + (size_t)(B_ + 1) * MODW; row_modulate_store(v, mn + 0, mn + D, (DRY ? P.y : P.h) + (size_t)t * D, lane); }
    }
}

DEV void phase_combine(CP& P, int l, unsigned char* smem, int rep) {
    if (rep) { phase_combine_t<true>(P, l, smem); return; }
    if (PROBE & 2048) phase_combine_t<true>(P, l, smem);
    phase_combine_t<false>(P, l, smem);
}
template <int PH> DEV void run_phase(CP& P, int l, unsigned char* smem, int rep = 0) {
    if (PH == 0) { phase_prologue_a(P, smem); if (PROBE & 4096) { SYNC(); phase_prologue_a(P, smem); } }
    if (PH == 1) { phase_prologue_b(P); if (PROBE & 4096) phase_prologue_b(P); }
    if (PH == 2) phase_inproj(P, l, smem);
    if (PH == 3) phase_up_glaa(P, l, smem);
    if (PH == 4) phase_prep_scan(P, l, rep);
    if (PH == 5) phase_mixers(P, l, smem, rep);
    if (PH == 6) phase_outproj(P, l, smem, rep);
    if (PH == 7) phase_router(P, l, smem, rep);
    if (PH == 8) phase_moe1(P, l, smem);
    if (PH == 9) phase_moe2(P, l, smem);
    if (PH == 10) phase_combine(P, l, smem, rep);
}

#ifndef CPU_EMU
#define XB_TMO      128
#define XB_XCNT(j)  (256  + 64 * (j))
#define XB_XSUB(j)  (1280 + 64 * (j))
#define XB_XGEN(j)  (2304 + 64 * (j))
#define XB_TOP      3328
#define XB_TOPGEN   3392
#define XCD_BAR_WORDS 3456
#define XB_SPIN_CAP (1u << 24)
__device__ __forceinline__ unsigned xb_ld(unsigned* p)              { return __hip_atomic_load(p, __ATOMIC_RELAXED, __HIP_MEMORY_SCOPE_AGENT); }
__device__ __forceinline__ unsigned xb_add(unsigned* p, unsigned v) { return __hip_atomic_fetch_add(p, v, __ATOMIC_RELAXED, __HIP_MEMORY_SCOPE_AGENT); }
__device__ __forceinline__ unsigned xb_xcc_id() { return (unsigned)__builtin_amdgcn_s_getreg((3 << 11) | 20) & 0xFu; }
#define XB_SPIN(cond, bar) do { unsigned _sp = 0; while (cond) { __builtin_amdgcn_s_sleep(1); \
    if ((++_sp & 255u) == 0u) { if (xb_ld(&(bar)[XB_TMO])) break; if (_sp > XB_SPIN_CAP) { atomicAdd(&(bar)[XB_TMO], 1u); break; } } } } while (0)
struct XcdBarrier { unsigned* bar; unsigned x; volatile LDSP unsigned* st; };
__device__ __forceinline__ XcdBarrier xcd_barrier_post(unsigned* bar, volatile LDSP unsigned* st) {
    XcdBarrier b; b.bar = bar; b.x = xb_xcc_id(); b.st = st;
    if (threadIdx.x == 0) (void)xb_add(&bar[XB_XCNT(b.x)], 1u);
    return b;
}
__device__ __forceinline__ void xcd_barrier_complete(unsigned* bar, unsigned x, unsigned& nloc, unsigned& nx) {
    const unsigned G = gridDim.x * gridDim.y * gridDim.z;
    unsigned sum, cnt, mine, sp = 0u;
    for (;;) {
        sum = 0u; cnt = 0u; mine = 0u;
#pragma unroll
        for (unsigned j = 0; j < 16; ++j) { const unsigned c = xb_ld(&bar[XB_XCNT(j)]); sum += c; cnt += (c > 0u) ? 1u : 0u; mine = (j == x) ? c : mine; }
        if (sum == G) break;
        __builtin_amdgcn_s_sleep(1);
        if ((++sp & 255u) == 0u) { if (xb_ld(&bar[XB_TMO])) break; if (sp > XB_SPIN_CAP) { atomicAdd(&bar[XB_TMO], 1u); break; } }
    }
    nloc = mine > 0u ? mine : 1u; nx = cnt > 0u ? cnt : 1u;
}
__device__ __forceinline__ void xcd_barrier1(const XcdBarrier& b) {
    asm volatile("s_waitcnt vmcnt(0)" ::: "memory");
    __syncthreads();
    if (threadIdx.x == 0) {
        unsigned* bar = b.bar;
        __builtin_amdgcn_s_waitcnt(0);
        unsigned nloc = b.st[0], nx = b.st[1];
        if (nloc == 0u) { xcd_barrier_complete(bar, b.x, nloc, nx); b.st[0] = nloc; b.st[1] = nx; }
        const unsigned old = xb_add(&bar[XB_XSUB(b.x)], 1u);
        const unsigned gen = old / nloc;
        if (old + 1u == (gen + 1u) * nloc) {
            __builtin_amdgcn_fence(__ATOMIC_RELEASE, "agent");
            asm volatile("s_waitcnt vmcnt(0)" ::: "memory");
            const unsigned og = xb_add(&bar[XB_TOP], 1u);
            const unsigned tg = og / nx;
            if (og + 1u == (tg + 1u) * nx) xb_add(&bar[XB_TOPGEN], 1u);
            else XB_SPIN(xb_ld(&bar[XB_TOPGEN]) == tg, bar);
            __builtin_amdgcn_fence(__ATOMIC_ACQUIRE, "agent");
            xb_add(&bar[XB_XGEN(b.x)], 1u);
            asm volatile("s_waitcnt vmcnt(0)" ::: "memory");
        } else {
            XB_SPIN(xb_ld(&bar[XB_XGEN(b.x)]) == gen, bar);
            __builtin_amdgcn_fence(__ATOMIC_ACQUIRE, "agent");
            asm volatile("s_waitcnt vmcnt(0)" ::: "memory");
        }
    }
    __syncthreads();
}

#ifndef MK_MULTI
#define MK_MULTI 0
#endif
__device__ __forceinline__ void xcd_barrier(const XcdBarrier& b) { xcd_barrier1(b); if (PROBE & 8192) xcd_barrier1(b); }
#if MK_MULTI
template <int PH> __global__ void __launch_bounds__(NTHREADS, 2) k_phase(Params Pv, int l) {
    extern __shared__ __attribute__((aligned(16))) unsigned char smem[];
    CP& P = *(CP*)__builtin_amdgcn_kernarg_segment_ptr();
    run_phase<PH>(P, l, smem);
}
#else
template <int PH> static __device__ __forceinline__ void phase_ni(int l, int rep = 0) {
    extern __shared__ __attribute__((aligned(16))) unsigned char smem[];
    CP& P = *(CP*)__builtin_amdgcn_kernarg_segment_ptr();
    run_phase<PH>(P, l, smem, rep);
}
__global__ void __launch_bounds__(NTHREADS, 2) k_mega(Params Pv) {
    extern __shared__ __attribute__((aligned(16))) unsigned char smem[];
    CP& P = *(CP*)__builtin_amdgcn_kernarg_segment_ptr();
    volatile LDSP unsigned* xbw = (volatile LDSP unsigned*)(smem + SMEM_BYTES);
    if (threadIdx.x == 0) { xbw[0] = 0u; xbw[1] = 0u; xbw[2] = 0u; xbw[3] = 0u; }
    __syncthreads();
    XcdBarrier bar = xcd_barrier_post(P.bar, xbw);
    phase_ni<0>(0); xcd_barrier(bar);
    phase_ni<1>(0); xcd_barrier(bar);
#pragma clang loop unroll(disable)
    for (int l = 0; l < NL; ++l) {
        phase_ni<2>(l); xcd_barrier(bar); if (WPROBE == 2) { phase_ni<2>(l, 1); xcd_barrier(bar); }
        phase_ni<3>(l); xcd_barrier(bar); if (WPROBE == 3) { phase_ni<3>(l, 1); xcd_barrier(bar); }
        phase_ni<4>(l); xcd_barrier(bar); if (WPROBE == 4) { phase_ni<4>(l, 1); xcd_barrier(bar); }
        phase_ni<5>(l); xcd_barrier(bar); if (WPROBE == 5) { phase_ni<5>(l, 1); xcd_barrier(bar); }
        phase_ni<6>(l); xcd_barrier(bar); if (WPROBE == 6) { phase_ni<6>(l, 1); xcd_barrier(bar); }
        phase_ni<7>(l); xcd_barrier(bar); if (WPROBE == 7) { phase_ni<7>(l, 1); xcd_barrier(bar); }
        phase_ni<8>(l); xcd_barrier(bar); if (WPROBE == 8) { phase_ni<8>(l, 1); xcd_barrier(bar); }
        phase_ni<9>(l); xcd_barrier(bar); if (WPROBE == 9) { phase_ni<9>(l, 1); xcd_barrier(bar); }
        phase_ni<10>(l); if (WPROBE == 10) { xcd_barrier(bar); phase_ni<10>(l, 1); } if (l + 1 < NL) xcd_barrier(bar);
    }
}
#endif
#endif

struct Carver { unsigned char* base; size_t off; template <class T> T* take(size_t n) { off = (off + 255) & ~(size_t)255; T* p = (T*)(base + off); off += n * sizeof(T); return p; } };
static inline size_t carve_ws(Params& P, void* d_ws) {
    Carver c{(unsigned char*)d_ws, 0};
    P.bar = c.take<unsigned>(4096);
    P.xc = c.take<float>((size_t)NCTX * D);
    P.mod = c.take<float>((size_t)NL * (B_ + 1) * MODW);
    P.hglb = c.take<float>(NL * 256);
    P.rope = c.take<float>((size_t)SEQ * 32);
    P.wr = c.take<float>((size_t)NL * D * 48);
    P.cshift = c.take<float>(NL * (B_ + 1) * 48);
    P.cnt = c.take<int>(NL * NEXP);
    P.sched = c.take<int>(NL * 16);
    P.list_tok = c.take<int>((size_t)NEXP * NT);
    P.list_gate = c.take<float>((size_t)NEXP * NT);
    P.tokslot = c.take<int>((size_t)NT * 2);
    P.gst = c.take<float>((size_t)2 * B_ * 4 * 2 * NCH * 4096);
    P.gdec = c.take<float>((size_t)2 * B_ * 4 * 2 * NCH * 64);
    P.win16 = c.take<half_t>((size_t)NL * D * PPAD);
    P.wout16 = c.take<half_t>((size_t)NL * D * D);
    P.wuq16 = c.take<half_t>((size_t)NL * 192 * 384);
    P.wukv16 = c.take<half_t>((size_t)NL * 128 * 512);
    P.h = c.take<half_t>((size_t)NT * D);
    P.p = c.take<half_t>((size_t)NT * PPAD);
    P.yrows = P.p;
    P.y = c.take<half_t>((size_t)NT * D);
    P.qraw = c.take<half_t>((size_t)NT * 384);
    P.kvraw = c.take<half_t>((size_t)NT * 512);
    P.mq = c.take<half_t>((size_t)B_ * 4 * KEYS * 96);
    P.mk = c.take<half_t>((size_t)B_ * 4 * KEYS * 96);
    P.mv = c.take<half_t>((size_t)B_ * 4 * KEYS * 64);
    P.nq = c.take<half_t>((size_t)B_ * 4 * KEYS * 64);
    P.nk = c.take<half_t>((size_t)B_ * 4 * KEYS * 64);
    P.nv = c.take<half_t>((size_t)B_ * 4 * KEYS * 64);
    P.act = c.take<half_t>((size_t)ACT_ROWS * 512);
    P.w13h = c.take<half_t>((size_t)NEXP * D * 1024);
    P.w2h = c.take<half_t>((size_t)NEXP * 512 * D);
    return c.off;
}
static inline void fill_inputs(Params& P, void* const* d_in, void* d_out) {
    const float* const* in = (const float* const*)d_in;
    P.x = in[0]; P.c = in[1]; P.ctx = in[2]; P.c_ctx = in[3]; P.w_ada = in[4]; P.b_ada = in[5]; P.w_in = in[6]; P.w_out = in[7];
    P.mla_g_cq = in[8]; P.mla_g_ckv = in[9]; P.mla_w_uq = in[10]; P.mla_w_ukv = in[11]; P.mla_g_qn = in[12]; P.mla_g_qr = in[13];
    P.mla_g_kn = in[14]; P.mla_g_kr = in[15]; P.na_g_q = in[16]; P.na_g_k = in[17]; P.na_rpb = in[18]; P.ret_g_out = in[19];
    P.hg_lb_raw = in[20]; P.hg_g_out = in[21]; P.moe_w_rg = in[22]; P.moe_b_rg = in[23]; P.moe_w_re = in[24]; P.moe_b_re = in[25];
    P.moe_w1 = in[26]; P.moe_w3 = in[27]; P.moe_w2 = in[28];
    P.out = (float*)d_out;
}

#ifndef CPU_EMU
extern "C" void kernel_launch(void* const* d_in, const int* in_sizes, int n_in, void* d_out, int out_size, void* d_ws, size_t ws_size, hipStream_t stream) {
    Params P{};
    fill_inputs(P, d_in, d_out);
    carve_ws(P, d_ws);
    constexpr size_t kDynLds = SMEM_BYTES + 16;
    static int grid = 0;
    if (!grid) {
        int dev = 0, cus = 0, per_cu = 0;
        (void)hipGetDevice(&dev);
        (void)hipDeviceGetAttribute(&cus, hipDeviceAttributeMultiprocessorCount, dev);
        #if MK_MULTI
        (void)hipOccupancyMaxActiveBlocksPerMultiprocessor(&per_cu, k_phase<5>, NTHREADS, kDynLds);
#else
        (void)hipFuncSetAttribute((const void*)k_mega, hipFuncAttributeMaxDynamicSharedMemorySize, (int)kDynLds);
        (void)hipOccupancyMaxActiveBlocksPerMultiprocessor(&per_cu, k_mega, NTHREADS, kDynLds);
#endif
        if (per_cu < 1) per_cu = 1;
        grid = cus * (per_cu < 2 ? per_cu : 2);
    }
#if MK_MULTI
    k_phase<0><<<grid, NTHREADS, kDynLds, stream>>>(P, 0);
    k_phase<1><<<grid, NTHREADS, kDynLds, stream>>>(P, 0);
    for (int l = 0; l < NL; ++l) {
        k_phase<2><<<grid, NTHREADS, kDynLds, stream>>>(P, l);
        k_phase<3><<<grid, NTHREADS, kDynLds, stream>>>(P, l);
        k_phase<4><<<grid, NTHREADS, kDynLds, stream>>>(P, l);
        k_phase<5><<<grid, NTHREADS, kDynLds, stream>>>(P, l);
        k_phase<6><<<grid, NTHREADS, kDynLds, stream>>>(P, l);
        k_phase<7><<<grid, NTHREADS, kDynLds, stream>>>(P, l);
        k_phase<8><<<grid, NTHREADS, kDynLds, stream>>>(P, l);
        k_phase<9><<<grid, NTHREADS, kDynLds, stream>>>(P, l);
        k_phase<10><<<grid, NTHREADS, kDynLds, stream>>>(P, l);
    }
#else
    (void)hipMemsetAsync(P.bar, 0, XCD_BAR_WORDS * sizeof(unsigned), stream);
    k_mega<<<grid, NTHREADS, kDynLds, stream>>>(P);
#endif
}
#endif
```

```cpp
#ifndef CPU_EMU
#include <hip/hip_runtime.h>
#endif
#include <stdint.h>
#include <stddef.h>

#ifndef PROBE
#define PROBE 0
#endif
#ifndef WPROBE
#define WPROBE 0
#endif
#ifndef CFG_B
#define CFG_B 8
#define CFG_SEQ 4096
#define CFG_L 4
#define CFG_CTX 256
#endif

typedef _Float16 half_t;
typedef _Float16 half8 __attribute__((ext_vector_type(8)));
typedef _Float16 half4 __attribute__((ext_vector_type(4)));
typedef short s16x4 __attribute__((ext_vector_type(4)));
typedef float f32x4 __attribute__((ext_vector_type(4)));
typedef float f32x16 __attribute__((ext_vector_type(16)));

#ifdef CPU_EMU
#define DEV inline
#define SYNC() emu::block_sync()
#define WAVE_BARRIER() emu::wave_sync()
#define SCHED_FENCE() do {} while (0)
#define WAIT_VM(n) do {} while (0)
#define RAW_BARRIER() emu::block_sync()
inline void glds16(const void* g, void* lds_wave_base) { memcpy((unsigned char*)lds_wave_base + (threadIdx.x & 63) * 16, g, 16); }
inline int WID(int tid) { return tid >> 6; }
DEV f32x4 mfma16(half8 a, half8 b, f32x4 c) { return emu::mfma_16x16x32<half8, f32x4>(a, b, c); }
DEV f32x16 mfma32(half8 a, half8 b, f32x16 c) { return emu::mfma_32x32x16<half8, f32x16>(a, b, c); }
DEV f32x4 mfmaf(float a, float b, f32x4 c) { return emu::mfma_16x16x4_f32<f32x4>(a, b, c); }
DEV half4 tr16(const half_t* p) { return emu::ds_read_tr16<half4>((const void*)p); }
template <int OFF> DEV half4 tr16_nowait(const half_t* p) { return emu::ds_read_tr16<half4>((const void*)((const unsigned char*)p + OFF)); }
#define TR_WAIT() do {} while (0)
DEV float shfl_xor_f(float v, int m) { return emu::shfl_xor<float>(v, m); }
DEV float shfl_f(float v, int src) { return emu::shfl<float>(v, src); }
DEV float xor1_f(float v) { return emu::shfl_xor<float>(v, 1); }
DEV float sum_x32(float v) { return v + emu::shfl_xor<float>(v, 32); }
DEV float max_x32(float v) { return fmaxf(v, emu::shfl_xor<float>(v, 32)); }
DEV float sum_x16(float v) { return v + emu::shfl_xor<float>(v, 16); }
DEV float group8_sum(float v) { v += shfl_xor_f(v, 1); v += shfl_xor_f(v, 2); v += shfl_xor_f(v, 4); return v; }
DEV float group16_sum(float v) { v = group8_sum(v); return v + shfl_xor_f(v, 8); }
DEV int atomic_add_i(int* p, int v) { return __atomic_fetch_add(p, v, __ATOMIC_RELAXED); }
DEV bool wave_any(bool p) { float f = p ? 1.f : 0.f; for (int m = 1; m < 64; m <<= 1) f = fmaxf(f, emu::shfl_xor<float>(f, m)); return f > 0.f; }
DEV float fexp2(float x) { return exp2f(x); }
DEV float fexp(float x) { return expf(x); }
DEV float flog(float x) { return logf(x); }
DEV float frsqrt(float x) { return 1.0f / sqrtf(x); }
DEV float frcp(float x) { return 1.0f / x; }
#else
#define DEV __device__ __forceinline__
#define SYNC() __syncthreads()
#define WAVE_BARRIER() __builtin_amdgcn_wave_barrier()
#define SCHED_FENCE() __builtin_amdgcn_sched_barrier(0)
#define WAIT_VM(n) asm volatile("s_waitcnt vmcnt(" #n ")" ::: "memory")
#define RAW_BARRIER() __builtin_amdgcn_s_barrier()
__device__ __forceinline__ void glds16(const void* g, void* lds_wave_base) {
    __builtin_amdgcn_global_load_lds((const __attribute__((address_space(1))) void*)g, (__attribute__((address_space(3))) void*)lds_wave_base, 16, 0, 0);
}
__device__ __forceinline__ int WID(int tid) { return __builtin_amdgcn_readfirstlane(tid >> 6); }
#define LDSP __attribute__((address_space(3)))
DEV f32x4 mfma16(half8 a, half8 b, f32x4 c) { return __builtin_amdgcn_mfma_f32_16x16x32_f16(a, b, c, 0, 0, 0); }
DEV f32x16 mfma32(half8 a, half8 b, f32x16 c) { return __builtin_amdgcn_mfma_f32_32x32x16_f16(a, b, c, 0, 0, 0); }
DEV f32x4 mfmaf(float a, float b, f32x4 c) { return __builtin_amdgcn_mfma_f32_16x16x4f32(a, b, c, 0, 0, 0); }
DEV half4 tr16(const half_t* p) { s16x4 t = __builtin_amdgcn_ds_read_tr16_b64_v4i16((LDSP s16x4*)p); return __builtin_bit_cast(half4, t); }
template <int OFF> DEV half4 tr16_nowait(const half_t* p) { s16x4 t; const unsigned a = (unsigned)(size_t)(LDSP const half_t*)p; asm volatile("ds_read_b64_tr_b16 %0, %1 offset:%2" : "=v"(t) : "v"(a), "i"(OFF) : "memory"); return __builtin_bit_cast(half4, t); }
#define TR_WAIT() do { asm volatile("s_waitcnt lgkmcnt(0)" ::: "memory"); __builtin_amdgcn_sched_barrier(0); } while (0)
DEV float shfl_xor_f(float v, int m) { return __shfl_xor(v, m, 64); }
DEV float shfl_f(float v, int src) { return __shfl(v, src, 64); }
template <int CTRL> DEV float dpp_f(float v) { return __uint_as_float(__builtin_amdgcn_update_dpp(0u, __float_as_uint(v), CTRL, 0xF, 0xF, true)); }
DEV float xor1_f(float v) { return dpp_f<0xB1>(v); }
DEV float sum_x32(float v) { auto r = __builtin_amdgcn_permlane32_swap(__float_as_uint(v), __float_as_uint(v), false, false); return __uint_as_float(r[0]) + __uint_as_float(r[1]); }
DEV float max_x32(float v) { auto r = __builtin_amdgcn_permlane32_swap(__float_as_uint(v), __float_as_uint(v), false, false); return fmaxf(__uint_as_float(r[0]), __uint_as_float(r[1])); }
DEV float sum_x16(float v) { auto r = __builtin_amdgcn_permlane16_swap(__float_as_uint(v), __float_as_uint(v), false, false); return __uint_as_float(r[0]) + __uint_as_float(r[1]); }
DEV float group8_sum(float v) { v += dpp_f<0xB1>(v); v += dpp_f<0x4E>(v); v += dpp_f<0x141>(v); return v; }
DEV float group16_sum(float v) { v = group8_sum(v); return v + dpp_f<0x140>(v); }
DEV int atomic_add_i(int* p, int v) { return atomicAdd(p, v); }
DEV bool wave_any(bool p) { return __any(p) != 0; }
DEV float fexp2(float x) { return __builtin_amdgcn_exp2f(x); }
DEV float fexp(float x) { return __expf(x); }
DEV float flog(float x) { return __logf(x); }
DEV float frsqrt(float x) { return __builtin_amdgcn_rsqf(x); }
DEV float frcp(float x) { return __builtin_amdgcn_rcpf(x); }
#endif

#ifdef CPU_EMU
DEV float opaque0() { return 0.f; }
DEV int TID() { return (int)threadIdx.x; }
#else
DEV int TID() { int t = (int)threadIdx.x; asm volatile("" : "+v"(t)); return t; }
DEV float opaque0() { float z = 0.f; asm volatile("" : "+v"(z)); return z; }
#endif
constexpr int B_ = CFG_B, SEQ = CFG_SEQ, NL = CFG_L, CTX = CFG_CTX, D = 1024;
constexpr int NLAT = B_ * SEQ, NCTX = B_ * CTX, NT = NLAT + NCTX;
constexpr int ROWS = SEQ / 64;
constexpr int KEYS = SEQ + CTX;
constexpr int PTOT = 3424, PPAD = 3456;
constexpr int P_GAP = 352, P_SHIFT = 32;
constexpr int O_CQ = 0, O_CKV = 192, O_KR = 320, O_NAQ = 384, O_NAK = 640, O_NAV = 896, O_RQ = 1152, O_RK = 1408, O_RV = 1664, O_RG = 1920,
              O_HQ = 2176, O_HF = 2432, O_HB = 2688, O_HI = 2944, O_HG = 3200;
static_assert(PTOT + P_SHIFT == PPAD && O_HG + 256 == PPAD, "p layout");
constexpr int NCH = KEYS / 64, CG = CTX / 64, LG = SEQ / 64;
constexpr int NEXP = 32, ACT_ROWS = 2 * NT + NEXP * 256;
constexpr float EPS = 1e-6f;
constexpr float LOG2E = 1.4426950408889634f;
constexpr int MODW = 6 * D;
constexpr int NTHREADS = 256;
constexpr int SMEM_BYTES = 74240;

struct Params {
    const float *x, *c, *ctx, *c_ctx, *w_ada, *b_ada, *w_in, *w_out, *mla_g_cq, *mla_g_ckv, *mla_w_uq, *mla_w_ukv, *mla_g_qn, *mla_g_qr, *mla_g_kn,
        *mla_g_kr, *na_g_q, *na_g_k, *na_rpb, *ret_g_out, *hg_lb_raw, *hg_g_out, *moe_w_rg, *moe_b_rg, *moe_w_re, *moe_b_re, *moe_w1, *moe_w3, *moe_w2;
    float* out;
    unsigned* bar;
    float *mod, *hglb, *wr, *cshift, *list_gate, *gst, *gdec, *rope;
    int *cnt, *list_tok, *tokslot, *sched;
    half_t *xs, *win16, *wout16, *wuq16, *wukv16, *h, *p, *y, *qraw, *kvraw, *mq, *mk, *mv, *nq, *nk, *nv, *act, *yrows, *w13h, *w2h;
};

#ifdef CPU_EMU
typedef const Params CP;
#else
typedef const __attribute__((address_space(4))) Params CP;
#endif
DEV int tok_brow(int t) { return t < NLAT ? t / SEQ : B_; }
DEV half_t* xrow_ptr(CP& P, int t) { return P.xs + (size_t)t * D; }
DEV const float* xin_ptr(CP& P, int t) { return t < NLAT ? P.x + (size_t)t * D : P.ctx + (size_t)(t - NLAT) * D; }
DEV float silu_f(float x) { return x * frcp(1.0f + fexp(-x)); }
DEV float sigmoid_f(float x) { return frcp(1.0f + fexp(-x)); }
DEV float wave_sum(float v) {
    return sum_x32(sum_x16(group16_sum(v)));
}
DEV f32x4 h4f(half4 v) { f32x4 r; r[0] = (float)v[0]; r[1] = (float)v[1]; r[2] = (float)v[2]; r[3] = (float)v[3]; return r; }
DEV half4 to_half4(f32x4 v) { half4 r; r[0] = (half_t)v[0]; r[1] = (half_t)v[1]; r[2] = (half_t)v[2]; r[3] = (half_t)v[3]; return r; }

constexpr int LDB_S = 136, G_BBUF = 32 * LDB_S;
struct BSrcH {
    const half_t* base; int ld;
    typedef half8 Raw;
    DEV Raw load(int k, int n) const { return *(const half8*)(base + (size_t)k * ld + n); }
    DEV half8 cvt(const Raw& r) const { return r; }
};
struct RawF { f32x4 a, b; };
DEV half8 cvt_rawf(const RawF& r) {
    half8 h; h[0] = (half_t)r.a[0]; h[1] = (half_t)r.a[1]; h[2] = (half_t)r.a[2]; h[3] = (half_t)r.a[3];
    h[4] = (half_t)r.b[0]; h[5] = (half_t)r.b[1]; h[6] = (half_t)r.b[2]; h[7] = (half_t)r.b[3]; return h;
}
struct BSrcF {
    const float* base; int ld;
    typedef RawF Raw;
    DEV Raw load(int k, int n) const { const float* s = base + (size_t)k * ld + n; RawF r; r.a = *(const f32x4*)s; r.b = *(const f32x4*)(s + 4); return r; }
    DEV half8 cvt(const Raw& r) const { return cvt_rawf(r); }
};
struct BSrcF2 {
    const float* b0; ptrdiff_t d10; int ld;
    typedef RawF Raw;
    DEV Raw load(int k, int n) const { const float* s = b0 + (ptrdiff_t)(n >> 6) * d10 + (n & 63) + (size_t)k * ld; RawF r; r.a = *(const f32x4*)s; r.b = *(const f32x4*)(s + 4); return r; }
    DEV half8 cvt(const Raw& r) const { return cvt_rawf(r); }
};
DEV int swzB(int k, int ch) { return k * LDB_S + (ch << 3); }
constexpr int GS_B = 32 * 128;
DEV int fswzB(int k) { return 2 * ((k & 3) | (((k >> 3) & 1) << 2)); }
#define GEMM_ISSUE(ST, KT)                                                                                                   \
    {                                                                                                                        \
        half_t* sa_ = ring + (ST) * GS_STAGE + (16 * MT * w) * 32;                                                           \
        half_t* sb_ = ring + (ST) * GS_STAGE + GS_A + (8 * w) * 128;                                                          \
        _Pragma("unroll") for (int j = 0; j < MT; ++j) glds16(asrc[j] + (KT) * ARow::KSTEP, sa_ + 16 * j * 32);                       \
        _Pragma("unroll") for (int j = 0; j < 2; ++j) glds16(bsrc[j] + (size_t)(KT) * 32 * ldb, sb_ + 4 * j * 128);          \
    }
#define GEMM_COMPUTE(ST)                                                                                                     \
    {                                                                                                                        \
        const half_t* sa_ = ring + (ST) * GS_STAGE; const half_t* sb_ = sa_ + GS_A;                                          \
        half8 af[MT];                                                                                                        \
        _Pragma("unroll") for (int mt = 0; mt < MT; ++mt) af[mt] = *(const half8*)(sa_ + aoff + mt * 16 * 32);               \
        _Pragma("unroll") for (int nh = 0; nh < 2; ++nh) {                                                                   \
            half8 bf[4];                                                                                                     \
            _Pragma("unroll") for (int n4 = 0; n4 < 4; ++n4) {                                                               \
                const half_t* ba = sb_ + bk0 * 128 + (((2 * (4 * nh + n4) + (pp >> 1)) ^ bfz) << 3) + 4 * (pp & 1);          \
                const half4 lo = tr16_nowait<0>(ba), hi = tr16_nowait<1024>(ba);                                             \
                bf[n4][0] = lo[0]; bf[n4][1] = lo[1]; bf[n4][2] = lo[2]; bf[n4][3] = lo[3]; bf[n4][4] = hi[0]; bf[n4][5] = hi[1]; bf[n4][6] = hi[2]; bf[n4][7] = hi[3]; \
            }                                                                                                                \
            TR_WAIT();                                                                                                       \
            _Pragma("unroll") for (int n4 = 0; n4 < 4; ++n4)                                                                 \
                _Pragma("unroll") for (int mt = 0; mt < MT; ++mt) acc[mt][4 * nh + n4] = mfma16(bf[n4], af[mt], acc[mt][4 * nh + n4]); \
        }                                                                                                                    \
    }
#define GEMM_STEP(ST, ST2, itv)                                                                                              \
    {                                                                                                                        \
        const int it_ = (itv);                                                                                               \
        if (it_ + 1 < nk) { if (MT == 4) { WAIT_VM(6); } else if (MT == 2) { WAIT_VM(4); } else { WAIT_VM(3); } } else { WAIT_VM(0); } \
        RAW_BARRIER();                                                                                                       \
        if (it_ + 2 < nk) GEMM_ISSUE(ST2, it_ + 2)                                                                           \
        GEMM_COMPUTE(ST)                                                                                                     \
    }
template <int MT, class ARow, class BS, class Epi>
DEV void gemm_tile(const ARow& arow, const BS& bs, int K, Epi& epi, unsigned char* smem) {
    constexpr int GS_A = 64 * MT * 32, GS_STAGE = GS_A + GS_B;
    half_t* ring = (half_t*)smem;
    const int tid = TID(), lane = tid & 63, w = WID(tid), g = lane >> 4, li = lane & 15;
    const int q = li >> 2, pp = li & 3;
    const int nk = K >> 5;
    const int ldb = bs.ld;
    const half_t* asrc[MT];
#pragma unroll
    for (int j = 0; j < MT; ++j) asrc[j] = arow(16 * MT * w + 16 * j + (lane >> 2)) + 8 * ((lane & 3) ^ (lane >> 4));
    const half_t* bsrc[2];
#pragma unroll
    for (int j = 0; j < 2; ++j) { const int k = 8 * w + 4 * j + (lane >> 4); bsrc[j] = bs.base + (size_t)k * ldb + 8 * ((lane & 15) ^ fswzB(k)); }
    const int aoff = (16 * MT * w + li) * 32 + ((g ^ (li >> 2)) << 3);
    const int bk0 = 8 * g + q, bfz = fswzB(bk0);
    f32x4 acc[MT][8];
#pragma unroll
    for (int mt = 0; mt < MT; ++mt)
#pragma unroll
        for (int nt = 0; nt < 8; ++nt) acc[mt][nt] = (f32x4){0.f, 0.f, 0.f, 0.f};
    SYNC();
    GEMM_ISSUE(0, 0)
    GEMM_ISSUE(1, 1)
#pragma clang loop unroll(disable)
    for (int it = 0; it < nk; it += 3) {
        GEMM_STEP(0, 2, it)
        if (it + 1 < nk) GEMM_STEP(1, 0, it + 1)
        if (it + 2 < nk) GEMM_STEP(2, 1, it + 2)
    }
    SYNC();
    epi.template run<MT>(acc, w, g, li, smem);
}
template <class ARow, class BS, class Epi>
DEV void gemm256(const ARow& arow, const BS& bs, int K, Epi& epi, unsigned char* smem) { gemm_tile<4>(arow, bs, K, epi, smem); }
struct ARowLin { static constexpr int KSTEP = 32; const half_t* base; int ld; DEV const half_t* operator()(int r) const { return base + (size_t)r * ld; } };
DEV size_t pair_off(size_t r, int k, int K) { return ((r >> 1) * (size_t)(K >> 5) + (k >> 5)) * 64 + (r & 1) * 32 + (k & 31); }
struct ARowPair { static constexpr int KSTEP = 64; const half_t* base; int row0, K; DEV const half_t* operator()(int r) const { return base + pair_off((size_t)(row0 + r), 0, K); } };
struct ARowGather { static constexpr int KSTEP = 64; const half_t* base; int ld; const int* idx; int nvalid; DEV const half_t* operator()(int r) const { const int t = r < nvalid ? idx[r] : 0; return base + pair_off((size_t)t, 0, ld); } };

constexpr int EP_LD = 144;
constexpr int EP_LD2 = 72;
struct EpiStoreH {
    half_t* out; int ld;
    template <int MT> DEV void run(const f32x4 (&acc)[MT][8], int w, int g, int li, unsigned char* smem) const {
        half_t* st = (half_t*)smem + w * 16 * MT * EP_LD;
#pragma unroll
        for (int mt = 0; mt < MT; ++mt)
#pragma unroll
            for (int nt = 0; nt < 8; ++nt) *(half4*)(st + (16 * mt + li) * EP_LD + 16 * nt + 4 * g) = to_half4(acc[mt][nt]);
        WAVE_BARRIER();
        half8 v[4 * MT];
#pragma unroll
        for (int i = 0; i < 4 * MT; ++i) v[i] = *(const half8*)(st + (4 * i + g) * EP_LD + 8 * li);
#pragma unroll
        for (int i = 0; i < 4 * MT; ++i) *(half8*)(out + (size_t)(16 * MT * w + 4 * i + g) * ld + 8 * li) = v[i];
    }
};
struct EpiResid {
    half_t* x; const float* xin; const float* gate;
    template <int MT> DEV void run(const f32x4 (&acc)[MT][8], int w, int g, int li, unsigned char* smem) const {
        half_t* st = (half_t*)smem + w * 16 * MT * EP_LD;
#pragma unroll
        for (int nt = 0; nt < 8; ++nt) {
            const f32x4 gt = *(const f32x4*)(gate + 16 * nt + 4 * g);
#pragma unroll
            for (int mt = 0; mt < MT; ++mt) *(half4*)(st + (16 * mt + li) * EP_LD + 16 * nt + 4 * g) = to_half4(gt * acc[mt][nt]);
        }
        WAVE_BARRIER();
#pragma unroll
        for (int i0 = 0; i0 < 4 * MT; i0 += 4) {
            half8 dv[4], xo[4];
#pragma unroll
            for (int i = 0; i < 4; ++i) dv[i] = *(const half8*)(st + (4 * (i0 + i) + g) * EP_LD + 8 * li);
            if (xin) {
                f32x4 xa[4], xb[4];
#pragma unroll
                for (int i = 0; i < 4; ++i) { const float* xp = xin + (size_t)(16 * MT * w + 4 * (i0 + i) + g) * D + 8 * li; xa[i] = *(const f32x4*)xp; xb[i] = *(const f32x4*)(xp + 4); }
                SCHED_FENCE();
#pragma unroll
                for (int i = 0; i < 4; ++i)
#pragma unroll
                    for (int e = 0; e < 4; ++e) { xo[i][e] = (half_t)(xa[i][e] + (float)dv[i][e]); xo[i][4 + e] = (half_t)(xb[i][e] + (float)dv[i][4 + e]); }
            } else {
                half8 xh[4];
#pragma unroll
                for (int i = 0; i < 4; ++i) xh[i] = *(const half8*)(x + (size_t)(16 * MT * w + 4 * (i0 + i) + g) * D + 8 * li);
                SCHED_FENCE();
#pragma unroll
                for (int i = 0; i < 4; ++i)
#pragma unroll
                    for (int e = 0; e < 8; ++e) xo[i][e] = (half_t)((float)xh[i][e] + (float)dv[i][e]);
            }
#pragma unroll
            for (int i = 0; i < 4; ++i) *(half8*)(x + (size_t)(16 * MT * w + 4 * (i0 + i) + g) * D + 8 * li) = xo[i];
        }
    }
};
struct EpiGlu {
    half_t* act; int row0, col0;
    template <int MT> DEV void run(const f32x4 (&acc)[MT][8], int w, int g, int li, unsigned char* smem) const {
        half_t* st = (half_t*)smem + w * 16 * MT * EP_LD2;
        const int lane = 16 * g + li;
#pragma unroll
        for (int mt = 0; mt < MT; ++mt)
#pragma unroll
            for (int nt = 0; nt < 4; ++nt) {
                f32x4 o;
#pragma unroll
                for (int r = 0; r < 4; ++r) o[r] = silu_f(acc[mt][nt][r]) * acc[mt][nt + 4][r];
                *(half4*)(st + (16 * mt + li) * EP_LD2 + 16 * nt + 4 * g) = to_half4(o);
            }
        WAVE_BARRIER();
        half8 v[2 * MT];
#pragma unroll
        for (int i = 0; i < 2 * MT; ++i) v[i] = *(const half8*)(st + (8 * i + (lane >> 3)) * EP_LD2 + 8 * (lane & 7));
#pragma unroll
        for (int i = 0; i < 2 * MT; ++i) *(half8*)(act + pair_off((size_t)(row0 + 16 * MT * w + 8 * i + (lane >> 3)), col0 + 8 * (lane & 7), 512)) = v[i];
    }
};
struct EpiRowsGate {
    half_t* out; const float* gate; int nvalid;
    template <int MT> DEV void run(const f32x4 (&acc)[MT][8], int w, int g, int li, unsigned char* smem) const {
        half_t* st = (half_t*)smem + w * 16 * MT * EP_LD;
#pragma unroll
        for (int mt = 0; mt < MT; ++mt) {
            const int row = 16 * MT * w + 16 * mt + li;
            const float gt = row < nvalid ? gate[row] : 0.f;
#pragma unroll
            for (int nt = 0; nt < 8; ++nt) *(half4*)(st + (16 * mt + li) * EP_LD + 16 * nt + 4 * g) = to_half4(acc[mt][nt] * gt);
        }
        WAVE_BARRIER();
        half8 v[4 * MT];
#pragma unroll
        for (int i = 0; i < 4 * MT; ++i) v[i] = *(const half8*)(st + (4 * i + g) * EP_LD + 8 * li);
#pragma unroll
        for (int i = 0; i < 4 * MT; ++i) { const int row = 16 * MT * w + 4 * i + g; if (row < nvalid) *(half8*)(out + (size_t)row * D + 8 * li) = v[i]; }
    }
};

DEV void phase_prologue_a(CP& P, unsigned char* smem) {
    const int tid = TID(), gtid = blockIdx.x * NTHREADS + tid, gsz = gridDim.x * NTHREADS;
    {
        constexpr size_t TOT = (size_t)NL * D * (PPAD / 8);
        for (size_t i0 = gtid; i0 < TOT; i0 += 4 * (size_t)gsz) {
            RawF r[4];
#pragma unroll
            for (int u = 0; u < 4; ++u) {
                const size_t i = i0 + (size_t)u * gsz;
                r[u].a = (f32x4){0.f, 0.f, 0.f, 0.f}; r[u].b = r[u].a;
                if (i < TOT) {
                    const int cc = (int)(i % (PPAD / 8)) * 8; const size_t rk = i / (PPAD / 8);
                    if (cc < P_GAP || cc >= P_GAP + P_SHIFT) {
                        const float* src = P.w_in + rk * PTOT + (cc < P_GAP ? cc : cc - P_SHIFT);
                        r[u].a = *(const f32x4*)src; r[u].b = *(const f32x4*)(src + 4);
                    }
                }
            }
            SCHED_FENCE();
#pragma unroll
            for (int u = 0; u < 4; ++u) { const size_t i = i0 + (size_t)u * gsz; if (i < TOT) *(half8*)(P.win16 + i * 8) = cvt_rawf(r[u]); }
        }
    }
    {
        constexpr size_t TOT = (size_t)NL * D * D / 8;
        for (size_t i0 = gtid; i0 < TOT; i0 += 4 * (size_t)gsz) {
            RawF r[4];
#pragma unroll
            for (int u = 0; u < 4; ++u) { const size_t i = i0 + (size_t)u * gsz; r[u].a = (f32x4){0.f, 0.f, 0.f, 0.f}; r[u].b = r[u].a; if (i < TOT) { r[u].a = *(const f32x4*)(P.w_out + i * 8); r[u].b = *(const f32x4*)(P.w_out + i * 8 + 4); } }
            SCHED_FENCE();
#pragma unroll
            for (int u = 0; u < 4; ++u) { const size_t i = i0 + (size_t)u * gsz; if (i < TOT) *(half8*)(P.wout16 + i * 8) = cvt_rawf(r[u]); }
        }
    }
    for (int i = gtid; i < NL * 192 * 384 / 8; i += gsz) {
        const int l = i / (192 * 48), k = (i / 48) % 192; const float gk = P.mla_g_cq[l * 192 + k];
        RawF r; r.a = *(const f32x4*)(P.mla_w_uq + (size_t)i * 8) * gk; r.b = *(const f32x4*)(P.mla_w_uq + (size_t)i * 8 + 4) * gk;
        *(half8*)(P.wuq16 + (size_t)i * 8) = cvt_rawf(r);
    }
    for (int i = gtid; i < NL * 128 * 512 / 8; i += gsz) {
        const int l = i / (128 * 64), k = (i / 64) % 128; const float gk = P.mla_g_ckv[l * 128 + k];
        RawF r; r.a = *(const f32x4*)(P.mla_w_ukv + (size_t)i * 8) * gk; r.b = *(const f32x4*)(P.mla_w_ukv + (size_t)i * 8 + 4) * gk;
        *(half8*)(P.wukv16 + (size_t)i * 8) = cvt_rawf(r);
    }
    for (int i = gtid; i < 256; i += gsz) {
        float mx = -1e30f; for (int l = 0; l < NL; ++l) mx = fmaxf(mx, P.hg_lb_raw[l * 256 + i]);
        float den = 0.f; for (int l = 0; l < NL; ++l) den += fexp(P.hg_lb_raw[l * 256 + i] - mx);
        float cum = 0.f;
        for (int l = 0; l < NL; ++l) { const float wv = fexp(P.hg_lb_raw[l * 256 + i] - mx) / den; if (l > 0) cum += wv; P.hglb[l * 256 + i] = cum; }
    }
    for (int i = gtid; i < NL * D * 48; i += gsz) {
        const int n = i % 48, lk = i / 48;
        P.wr[i] = n < 4 ? P.moe_w_rg[lk * 4 + n] : (n < 36 ? P.moe_w_re[lk * 32 + (n - 4)] : 0.f);
    }
    for (int i = gtid; i < NL * NEXP; i += gsz) P.cnt[i] = 0;
    for (int i = gtid; i < NL * 16; i += gsz) P.sched[i] = 0;
    for (int i = gtid; i < SEQ * 16; i += gsz) {
        const int n = i >> 4, j = i & 15, ax = j >> 3, fi = j & 7;
        const float ang = (float)(ax == 0 ? n / 64 : n % 64) * fexp(-9.210340371976184f * (float)fi * 0.125f);
        P.rope[n * 32 + j] = cosf(ang); P.rope[n * 32 + 16 + j] = sinf(ang);
    }
    float* sc = (float*)smem;
    SYNC();
    for (int i = tid; i < (B_ + 1) * D; i += NTHREADS) { const int r = i / D, k = i % D; const float v = r < B_ ? P.c[r * D + k] : P.c_ctx[k]; sc[i] = silu_f(v); }
    SYNC();
    float* red = sc + (B_ + 1) * D;
    for (int item = blockIdx.x; item < NL * (MODW / 64); item += gridDim.x) {
        const int l = item / (MODW / 64), n0 = (item % (MODW / 64)) * 64, kq = tid >> 6, lane = tid & 63, r4 = lane >> 4, c4 = lane & 15;
        f32x4 acc[B_ + 1];
#pragma unroll
        for (int r = 0; r <= B_; ++r) acc[r] = (f32x4){0.f, 0.f, 0.f, 0.f};
        const float* wp = P.w_ada + (size_t)l * D * MODW + (size_t)(256 * kq + r4) * MODW + n0 + 4 * c4;
        const float* scp = sc + 256 * kq + r4;
        for (int k0 = 0; k0 < 256; k0 += 32) {
            f32x4 wv[8];
#pragma unroll
            for (int j = 0; j < 8; ++j) wv[j] = *(const f32x4*)(wp + (size_t)(k0 + 4 * j) * MODW);
#pragma unroll
            for (int j = 0; j < 8; ++j)
#pragma unroll
                for (int r = 0; r <= B_; ++r) acc[r] += wv[j] * scp[r * D + k0 + 4 * j];
        }
        float accs[B_ + 1];
#pragma unroll
        for (int r = 0; r <= B_; ++r) {
            f32x4 t = acc[r];
#pragma unroll
            for (int e = 0; e < 4; ++e) t[e] = sum_x32(sum_x16(t[e]));
            accs[r] = r4 == 0 ? t[0] : (r4 == 1 ? t[1] : (r4 == 2 ? t[2] : t[3]));
        }
        SYNC();
#pragma unroll
        for (int r = 0; r <= B_; ++r) red[(kq * 64 + 4 * c4 + r4) * (B_ + 1) + r] = accs[r];
        SYNC();
        if (kq == 0) {
            const int n = n0 + (tid & 63);
            const float bv = P.b_ada[l * MODW + n];
#pragma unroll
            for (int r = 0; r <= B_; ++r) {
                const int o = (tid & 63) * (B_ + 1) + r;
                P.mod[((size_t)l * (B_ + 1) + r) * MODW + n] = ((red[o] + red[64 * (B_ + 1) + o]) + (red[128 * (B_ + 1) + o] + red[192 * (B_ + 1) + o])) + bv;
            }
        }
    }
}

DEV void row_modulate_store(const f32x4 (&v)[4], const float* sh, const float* sc, half_t* hbuf, int t, int lane) {
    f32x4 s4[4], h4[4];
#pragma unroll
    for (int j = 0; j < 4; ++j) { s4[j] = *(const f32x4*)(sc + 256 * j + 4 * lane); h4[j] = *(const f32x4*)(sh + 256 * j + 4 * lane); }
    float ss = 0.f;
#pragma unroll
    for (int j = 0; j < 4; ++j) ss += v[j][0] * v[j][0] + v[j][1] * v[j][1] + v[j][2] * v[j][2] + v[j][3] * v[j][3];
    ss = wave_sum(ss);
    const float rstd = frsqrt(ss * (1.0f / D) + EPS);
#pragma unroll
    for (int j = 0; j < 4; ++j) {
        f32x4 o;
#pragma unroll
        for (int e = 0; e < 4; ++e) o[e] = v[j][e] * rstd * (1.0f + s4[j][e]) + h4[j][e];
        *(half4*)(hbuf + pair_off((size_t)t, 256 * j + 4 * lane, D)) = to_half4(o);
    }
}
DEV void phase_prologue_b(CP& P) {
    const int lane = TID() & 63, gw = blockIdx.x * 4 + (TID() >> 6), nw = gridDim.x * 4;
    for (int t = gw; t < NT; t += nw) {
        const float* src = t < NLAT ? P.x + (size_t)t * D : P.ctx + (size_t)(t - NLAT) * D;
        f32x4 v[4];
#pragma unroll
        for (int j = 0; j < 4; ++j) v[j] = *(const f32x4*)(src + 256 * j + 4 * lane);
        const float* md = P.mod + (size_t)tok_brow(t) * MODW;
        row_modulate_store(v, md + 0, md + D, P.h, t, lane);
    }
    for (int it = gw; it < NL * (B_ + 1) * 36; it += nw) {
        const int n = it % 36, lr = it / 36, l = lr / (B_ + 1);
        const float* sh = P.mod + (size_t)lr * MODW + 3 * D;
        float s = 0.f;
        for (int k = lane; k < D; k += 64) s += sh[k] * P.wr[((size_t)l * D + k) * 48 + n];
        s = wave_sum(s);
        if (lane == 0) P.cshift[lr * 48 + n] = s + (n < 4 ? P.moe_b_rg[l * 4 + n] : P.moe_b_re[l * 32 + n - 4]);
    }
}

DEV bool gemm_tile_idx(int idx, int ntm, int ntn, int& tm, int& tn) {
    if (idx >= ntm * ntn) return false;
    const int nig = 4 * ntn, gid = idx / nig, fm = gid * 4, gsz = (ntm - fm) < 4 ? (ntm - fm) : 4, rem = idx - gid * nig;
    tm = fm + rem % gsz; tn = rem / gsz; return true;
}
DEV bool gemm_tile_order(int round, int ntm, int ntn, int& tm, int& tn) {
    const int per = gridDim.x >> 3;
    const int idx = ((round << 3) + (blockIdx.x & 7)) * per + (blockIdx.x >> 3);
    if (idx >= ntm * ntn) return false;
    const int nig = 4 * ntn, gid = idx / nig, fm = gid * 4, gsz = (ntm - fm) < 4 ? (ntm - fm) : 4, rem = idx - gid * nig;
    tm = fm + rem % gsz; tn = rem / gsz; return true;
}
DEV void phase_inproj(CP& P, int l, unsigned char* smem) {
    constexpr int NTN = PPAD / 128, NTM = NT / 256;
    const int full = (NTM * NTN) / gridDim.x;
    for (int rep = 0; rep < ((PROBE & 1) ? 2 : 1); ++rep) {
        for (int round = 0; round < full; ++round) {
            int tm, tn;
            if (!gemm_tile_order(round, NTM, NTN, tm, tn)) continue;
            ARowPair ar{P.h, tm * 256, D};
            BSrcH bs{P.win16 + (size_t)l * D * PPAD + tn * 128, PPAD};
            EpiStoreH epi{P.p + (size_t)tm * 256 * PPAD + tn * 128, PPAD};
            gemm_tile<4>(ar, bs, D, epi, smem);
        }
        const int base = full * gridDim.x, left = NTM * NTN - base;
        for (int i = blockIdx.x; i < 4 * left; i += gridDim.x) {
            int tm, tn; gemm_tile_idx(base + (i >> 2), NTM, NTN, tm, tn);
            const size_t r0 = (size_t)tm * 256 + 64 * (i & 3);
            ARowPair ar{P.h, (int)r0, D};
            BSrcH bs{P.win16 + (size_t)l * D * PPAD + tn * 128, PPAD};
            EpiStoreH epi{P.p + r0 * PPAD + tn * 128, PPAD};
            gemm_tile<1>(ar, bs, D, epi, smem);
        }
    }
}

constexpr int GQ_LD = 68, GH_LD = 72, GS_LD = 24;
constexpr int G_QF = 0, G_KF = 17408, G_KH = 34816, G_VH = 44032, G_SC = 53248, G_DK = 56320, G_RED = 57344;
constexpr int G_STG = 58368, STG_LD = 72;
DEV float ret_loggamma(int h, int dir) { return log1pf(-exp2f(-5.0f - (float)(2 * h + dir))); }
template <int MIX, bool OUT, int dir>
DEV void gla_stage(CP& P, int l, int h, int tok0, float lgam, float& totsum, unsigned char* smem) {
    float* Qf = (float*)(smem + G_QF); float* Kf = (float*)(smem + G_KF); half_t* Kh = (half_t*)(smem + G_KH); half_t* Vh = (half_t*)(smem + G_VH);
    float* dk = (float*)(smem + G_DK);
    const int tid = TID(), d = tid & 63, I = tid >> 6;
    const half_t* pr = P.p + (size_t)(tok0 + 16 * I) * PPAD + h * 64 + d;
    float lf[16], kk[16], qq[16];
    half_t vv[16], rq[16], rk[16];
    float lb = 0.f;
    if (MIX == 1) lb = P.hglb[l * 256 + h * 64 + d];
#pragma unroll
    for (int i = 0; i < 16; ++i) {
        const half_t* pi = pr + (size_t)i * PPAD;
        if (MIX == 0) { rq[i] = OUT ? pi[O_RQ] : (half_t)0.f; rk[i] = pi[O_RK]; vv[i] = pi[O_RV]; }
        else { rq[i] = OUT ? pi[O_HQ] : (half_t)0.f; rk[i] = pi[dir ? O_HB : O_HF]; vv[i] = pi[O_HI]; }
    }
    SCHED_FENCE();
    float tot = 0.f;
#pragma unroll
    for (int i = 0; i < 16; ++i) {
        if (MIX == 0) {
            qq[i] = (float)rq[i]; kk[i] = (float)rk[i] * 0.125f; lf[i] = lgam;
        } else {
            qq[i] = OUT ? silu_f((float)rq[i]) : 0.f;
            const float sg = sigmoid_f((float)rk[i]), f = lb + (1.0f - lb) * sg;
            lf[i] = flog(fmaxf(f, 1e-20f)); kk[i] = (1.0f - lb) * (1.0f - sg);
        }
        tot += lf[i];
    }
    float bc = 0.f;
#pragma unroll
    for (int ii = 0; ii < 16; ++ii) {
        const int i = dir == 0 ? ii : 15 - ii;
        bc += lf[i];
        const int o = (I * 16 + i);
        if (OUT) { Qf[o * GQ_LD + d] = qq[i] * fexp(bc); Kf[o * GQ_LD + d] = kk[i] * fexp(fminf(-bc, 80.0f)); }
        Kh[o * GH_LD + d] = (half_t)(kk[i] * fexp(tot - bc));
        Vh[o * GH_LD + d] = vv[i];
    }
    dk[I * 64 + d] = fexp(tot);
    totsum += tot;
}
DEV half8 tok_frag(const half_t* img, int col0, int lane) {
    const int g = lane >> 4, li = lane & 15, q = li >> 2, p = li & 3;
    const half_t* a = img + (8 * (g & 1) + q) * GH_LD + col0 + 4 * p;
    const half4 lo = tr16(a), hi = tr16(a + 4 * GH_LD);
    half8 r;
    const bool z = g >= 2;
    r[0] = z ? (half_t)0.f : lo[0]; r[1] = z ? (half_t)0.f : lo[1]; r[2] = z ? (half_t)0.f : lo[2]; r[3] = z ? (half_t)0.f : lo[3];
    r[4] = z ? (half_t)0.f : hi[0]; r[5] = z ? (half_t)0.f : hi[1]; r[6] = z ? (half_t)0.f : hi[2]; r[7] = z ? (half_t)0.f : hi[3];
    return r;
}
DEV void gla_scores(int dir, unsigned char* smem) {
    const float* Qf = (const float*)(smem + G_QF); const float* Kf = (const float*)(smem + G_KF); half_t* sc = (half_t*)(smem + G_SC);
    const int tid = TID(), lane = tid & 63, w = tid >> 6, g = lane >> 4, li = lane & 15;
    f32x4 s0 = {0.f, 0.f, 0.f, 0.f}, s1 = {0.f, 0.f, 0.f, 0.f};
    const float* kp = Kf + (w * 16 + li) * GQ_LD + g; const float* qp = Qf + (w * 16 + li) * GQ_LD + g;
#pragma unroll
    for (int kk = 0; kk < 16; kk += 2) { s0 = mfmaf(kp[4 * kk], qp[4 * kk], s0); s1 = mfmaf(kp[4 * kk + 4], qp[4 * kk + 4], s1); }
    half4 o;
#pragma unroll
    for (int r = 0; r < 4; ++r) { const int sj = 4 * g + r; const bool keep = dir == 0 ? (sj <= li) : (sj >= li); o[r] = keep ? (half_t)(s0[r] + s1[r]) : (half_t)0.f; }
    *(half4*)(sc + (w * 16 + li) * GS_LD + 4 * g) = o;
}
template <bool OUT>
DEV void gla_main_sub(int I, f32x4 (&st)[4], f32x4& oacc, unsigned char* smem) {
    const float* Qf = (const float*)(smem + G_QF); const half_t* Kh = (const half_t*)(smem + G_KH); const half_t* Vh = (const half_t*)(smem + G_VH);
    const half_t* sc = (const half_t*)(smem + G_SC); const float* dk = (const float*)(smem + G_DK);
    const int tid = TID(), lane = tid & 63, w = tid >> 6, g = lane >> 4, li = lane & 15;
    const half8 vfr = tok_frag(Vh + I * 16 * GH_LD, 16 * w, lane);
    if (OUT) {
        const half8 sf = *(const half8*)(sc + (I * 16 + li) * GS_LD + 8 * (g & 1));
        oacc = mfma16(vfr, sf, oacc);
#pragma unroll
        for (int ks = 0; ks < 2; ++ks) {
            half8 sa, qb;
            const f32x4 q0 = *(const f32x4*)(Qf + (I * 16 + li) * GQ_LD + 32 * ks + 4 * g), q1 = *(const f32x4*)(Qf + (I * 16 + li) * GQ_LD + 32 * ks + 16 + 4 * g);
#pragma unroll
            for (int j = 0; j < 4; ++j) { sa[j] = (half_t)st[2 * ks][j]; sa[4 + j] = (half_t)st[2 * ks + 1][j]; qb[j] = (half_t)q0[j]; qb[4 + j] = (half_t)q1[j]; }
            oacc = mfma16(sa, qb, oacc);
        }
    }
#pragma unroll
    for (int dt = 0; dt < 4; ++dt) {
        const f32x4 dv = *(const f32x4*)(dk + I * 64 + 16 * dt + 4 * g);
#pragma unroll
        for (int r = 0; r < 4; ++r) st[dt][r] *= dv[r];
        st[dt] = mfma16(tok_frag(Kh + I * 16 * GH_LD, 16 * dt, lane), vfr, st[dt]);
    }
}
DEV int gla_tok0(int b, int gidx) { return gidx < CG ? NLAT + b * CTX + 64 * gidx : b * SEQ + 64 * (gidx - CG); }
DEV int gla_chainpos(int gidx, int dir) { return dir == 0 ? gidx : (gidx < CG ? CG - 1 - gidx : CG + (LG - 1 - (gidx - CG))); }
DEV size_t gla_chain(int mix, int b, int h, int dir) { return (((size_t)mix * B_ + b) * 4 + h) * 2 + dir; }
template <int MIX>
DEV void gla_step_a(CP& P, int l, int b, int h, int dir, int gidx, unsigned char* smem) {
    const int tid = TID(), lane = tid & 63, w = tid >> 6, g = lane >> 4, li = lane & 15;
    f32x4 st[4]; f32x4 od = {0.f, 0.f, 0.f, 0.f};
#pragma unroll
    for (int dt = 0; dt < 4; ++dt) st[dt] = (f32x4){0.f, 0.f, 0.f, 0.f};
    float totsum = 0.f;
    const float lgam = MIX == 0 ? ret_loggamma(h, dir) : 0.f;
    SYNC();
    if (dir == 0) gla_stage<MIX, false, 0>(P, l, h, gla_tok0(b, gidx), lgam, totsum, smem); else gla_stage<MIX, false, 1>(P, l, h, gla_tok0(b, gidx), lgam, totsum, smem);
    SYNC();
#pragma unroll
    for (int ii = 0; ii < 4; ++ii) gla_main_sub<false>(dir == 0 ? ii : 3 - ii, st, od, smem);
    const size_t slot = gla_chain(MIX, b, h, dir) * NCH + gla_chainpos(gidx, dir);
    half_t* dst = (half_t*)P.gst + slot * 4096;
    half_t* stg = (half_t*)(smem + G_STG);
#pragma unroll
    for (int dt = 0; dt < 4; ++dt)
#pragma unroll
        for (int r = 0; r < 4; ++r) stg[(16 * dt + 4 * g + r) * STG_LD + 16 * w + li] = (half_t)st[dt][r];
    if (tid < 64) { const float* dk = (const float*)(smem + G_DK); P.gdec[slot * 64 + tid] = dk[tid] * dk[64 + tid] * dk[128 + tid] * dk[192 + tid]; }
    SYNC();
#pragma unroll
    for (int ps = 0; ps < 2; ++ps) { const int row = (tid >> 3) + 32 * ps; *(half8*)(dst + row * 64 + 8 * (tid & 7)) = *(const half8*)(stg + row * STG_LD + 8 * (tid & 7)); }
    SYNC();
}
template <int MIX>
DEV void gla_step_c(CP& P, int l, int b, int h, int gidx, unsigned char* smem) {
    const int tid = TID(), lane = tid & 63, w = tid >> 6, g = lane >> 4, li = lane & 15;
    f32x4 oacc[4];
#pragma unroll
    for (int I = 0; I < 4; ++I) oacc[I] = (f32x4){0.f, 0.f, 0.f, 0.f};
    const int tok0 = gla_tok0(b, gidx);
    float totsum = 0.f;
#pragma unroll
    for (int dir = 0; dir < 2; ++dir) {
        const size_t slot = gla_chain(MIX, b, h, dir) * NCH + gla_chainpos(gidx, dir);
        const half_t* src = (const half_t*)P.gst + slot * 4096;
        half_t* stg = (half_t*)(smem + G_STG);
        const half8 sv0 = *(const half8*)(src + (tid >> 3) * 64 + 8 * (tid & 7)), sv1 = *(const half8*)(src + ((tid >> 3) + 32) * 64 + 8 * (tid & 7));
        const float lgam = MIX == 0 ? ret_loggamma(h, dir) : 0.f;
        if (dir == 1) SYNC();
        *(half8*)(stg + (tid >> 3) * STG_LD + 8 * (tid & 7)) = sv0; *(half8*)(stg + ((tid >> 3) + 32) * STG_LD + 8 * (tid & 7)) = sv1;
        if (dir == 0) gla_stage<MIX, true, 0>(P, l, h, tok0, lgam, totsum, smem); else gla_stage<MIX, true, 1>(P, l, h, tok0, lgam, totsum, smem);
        SYNC();
        f32x4 st[4];
#pragma unroll
        for (int dt = 0; dt < 4; ++dt)
#pragma unroll
            for (int r = 0; r < 4; ++r) st[dt][r] = (float)stg[(16 * dt + 4 * g + r) * STG_LD + 16 * w + li];
        gla_scores(dir, smem);
        SYNC();
#pragma unroll
        for (int ii = 0; ii < 4; ++ii) { const int I = dir == 0 ? ii : 3 - ii; gla_main_sub<true>(I, st, oacc[I], smem); }
    }
    float* red = (float*)(smem + G_RED);
#pragma unroll
    for (int I = 0; I < 4; ++I) {
        float ss = oacc[I][0] * oacc[I][0] + oacc[I][1] * oacc[I][1] + oacc[I][2] * oacc[I][2] + oacc[I][3] * oacc[I][3];
        ss = sum_x32(sum_x16(ss));
        if (g == 0) red[w * 64 + 16 * I + li] = ss;
    }
    SYNC();
    const float* gain = (MIX == 0 ? P.ret_g_out : P.hg_g_out) + l * 64;
    const int ycol = (MIX == 0 ? 512 : 768) + h * 64 + 8 * (tid & 7), gcol = (MIX == 0 ? O_RG : O_HG) + h * 64 + 8 * (tid & 7);
    half8 gt[2];
#pragma unroll
    for (int ps = 0; ps < 2; ++ps) gt[ps] = *(const half8*)(P.p + (size_t)(tok0 + (tid >> 3) + 32 * ps) * PPAD + gcol);
    half_t* stg = (half_t*)(smem + G_STG);
    const f32x4 gn = *(const f32x4*)(gain + 16 * w + 4 * g);
#pragma unroll
    for (int I = 0; I < 4; ++I) {
        const int ti = 16 * I + li;
        const float tot = red[ti] + red[64 + ti] + red[128 + ti] + red[192 + ti];
        const float rstd = frsqrt(tot * (1.0f / 64.0f) + EPS);
        f32x4 o;
#pragma unroll
        for (int r = 0; r < 4; ++r) o[r] = oacc[I][r] * rstd * gn[r];
        *(half4*)(stg + ti * STG_LD + 16 * w + 4 * g) = to_half4(o);
    }
    SYNC();
#pragma unroll
    for (int ps = 0; ps < 2; ++ps) {
        const int row = (tid >> 3) + 32 * ps;
        const half8 ov = *(const half8*)(stg + row * STG_LD + 8 * (tid & 7));
        half8 yo;
#pragma unroll
        for (int e = 0; e < 8; ++e) yo[e] = (half_t)((float)ov[e] * silu_f((float)gt[ps][e]));
        *(half8*)(P.y + pair_off((size_t)(tok0 + row), ycol, D)) = yo;
    }
    SYNC();
}
DEV void gla_scan(CP& P, int item, half_t* gst, int chain_off) {
    const int chain = item >> 1, e8 = ((item & 1) << 8) + TID(), d = e8 >> 3;
    half_t* base = gst + (size_t)(chain - chain_off) * NCH * 4096 + 8 * e8;
    const float* dec = P.gdec + (size_t)chain * NCH * 64 + d;
    const float z0 = opaque0();
    float s[8];
#pragma unroll
    for (int i = 0; i < 8; ++i) s[i] = z0;
    static_assert(NCH % 17 == 0 || NCH % 4 == 0, "scan batch");
    constexpr int BT = (NCH % 17 == 0) ? 17 : 4;
    for (int pos = 0; pos < NCH; pos += BT) {
        half8 ds[BT]; float dc[BT];
#pragma unroll
        for (int j = 0; j < BT; ++j) { ds[j] = *(const half8*)(base + (size_t)(pos + j) * 4096); dc[j] = dec[(pos + j) * 64]; }
#pragma unroll
        for (int j = 0; j < BT; ++j) {
            half8 o;
#pragma unroll
            for (int i = 0; i < 8; ++i) { o[i] = (half_t)s[i]; s[i] = s[i] * dc[j] + (float)ds[j][i]; }
            *(half8*)(base + (size_t)(pos + j) * 4096) = o;
        }
    }
}

DEV void up_glaa_item(CP& P, int l, int item, unsigned char* smem) {
    constexpr int NTM = NT / 256, NQ = NTM * 3, NKV = NTM * 4;
    if (item < NQ + NKV) {
        const bool isq = item < NQ;
        const int it = isq ? item : item - NQ, nn = isq ? 3 : 4, tm = it / nn, tn = it % nn;
        const int ldo = isq ? 384 : 512, kk = isq ? 192 : 128;
        ARowLin ar{P.p + (size_t)tm * 256 * PPAD + (isq ? O_CQ : O_CKV), PPAD};
        BSrcH bs{(isq ? P.wuq16 + (size_t)l * 192 * 384 : P.wukv16 + (size_t)l * 128 * 512) + tn * 128, ldo};
        EpiStoreH epi{(isq ? P.qraw : P.kvraw) + (size_t)tm * 256 * ldo + tn * 128, ldo};
        gemm256(ar, bs, kk, epi, smem);
    } else {
        int it = item - NQ - NKV;
        const int gidx = it % NCH; it /= NCH; const int dir = it & 1; it >>= 1; const int h = it & 3; it >>= 2; const int b = it % B_; const int mix = it / B_;
        SYNC();
        if (mix == 0) gla_step_a<0>(P, l, b, h, dir, gidx, smem); else gla_step_a<1>(P, l, b, h, dir, gidx, smem);
    }
}
DEV void phase_up_glaa(CP& P, int l, unsigned char* smem) {
    constexpr int NTM = NT / 256, NQ = NTM * 3, NKV = NTM * 4, NGA = 2 * B_ * 4 * 2 * NCH;
    for (int item = blockIdx.x; item < NQ + NKV + NGA; item += gridDim.x) up_glaa_item(P, l, item, smem);
    if (PROBE & 2) for (int item = blockIdx.x; item < NQ + NKV; item += gridDim.x) up_glaa_item(P, l, item, smem);
    if (PROBE & 4) for (int item = blockIdx.x; item < NGA; item += gridDim.x) up_glaa_item(P, l, NQ + NKV + item, smem);
}

DEV float sumsq8(half8 v) { float s = 0.f;
#pragma unroll
    for (int j = 0; j < 8; ++j) s += (float)v[j] * (float)v[j];
    return s; }
struct PrepRegs {
    half8 pre[3], r1, r2, r3; f32x4 ga, gb, gc, gd, cs0, cs1, sn0, sn1; const float* g2; size_t row; bool lat;
};
DEV void prep_load(CP& P, int l, int t, int c, int job, int h, PrepRegs& R) {
    const half8 zero8 = {0, 0, 0, 0, 0, 0, 0, 0};
    const int b = t < NLAT ? t / SEQ : (t - NLAT) / CTX;
    R.lat = t < NLAT;
    const int n = R.lat ? t % SEQ : 0;
    const int pos = R.lat ? n : SEQ + (t - NLAT) % CTX;
    const half_t* pr = P.p + (size_t)t * PPAD;
    R.row = (size_t)(b * 4 + h) * KEYS + pos;
    R.pre[0] = zero8; R.pre[1] = zero8; R.pre[2] = zero8; R.r1 = zero8; R.r2 = zero8; R.r3 = zero8;
    const float* g1 = P.mla_g_qn; R.g2 = P.mla_g_qr;
    if (job < 4) {
        const half_t* qr = P.qraw + (size_t)t * 384 + h * 96;
#pragma unroll
        for (int i = 0; i < 3; ++i) R.pre[i] = *(const half8*)(pr + O_CQ + 8 * (c + 8 * i));
        R.r1 = *(const half8*)(qr + 8 * c); if (c < 4) R.r2 = *(const half8*)(qr + 64 + 8 * c);
        g1 = P.mla_g_qn + l * 64; R.g2 = P.mla_g_qr + l * 32;
    } else if (job < 8) {
        const half_t* kr = P.kvraw + (size_t)t * 512 + h * 128;
#pragma unroll
        for (int i = 0; i < 2; ++i) R.pre[i] = *(const half8*)(pr + O_CKV + 8 * (c + 8 * i));
        R.r1 = *(const half8*)(kr + 8 * c); R.r3 = *(const half8*)(kr + 64 + 8 * c); if (c < 4) R.r2 = *(const half8*)(pr + O_KR + 8 * c);
        g1 = P.mla_g_kn + l * 64; R.g2 = P.mla_g_kr + l * 32;
    } else if (job < 12) {
        R.r3 = *(const half8*)(pr + O_NAK + h * 64 + 8 * c);
        g1 = P.na_g_q + l * 64; R.g2 = P.na_g_k + l * 64;
    } else {
        R.r1 = *(const half8*)(pr + O_NAV + h * 64 + 8 * c);
    }
    R.ga = *(const f32x4*)(g1 + 8 * c); R.gb = *(const f32x4*)(g1 + 8 * c + 4);
    const int c2 = (job >= 8 && job < 12) ? c : (c & 3);
    R.gc = *(const f32x4*)(R.g2 + 8 * c2); R.gd = *(const f32x4*)(R.g2 + 8 * c2 + 4);
    R.cs0 = (f32x4){1.f, 1.f, 1.f, 1.f}; R.cs1 = R.cs0; R.sn0 = (f32x4){0.f, 0.f, 0.f, 0.f}; R.sn1 = R.sn0;
    if (R.lat && job < 8) { const float* cst = P.rope + (size_t)n * 32 + 8 * ((c >> 1) & 1); R.cs0 = *(const f32x4*)cst; R.cs1 = *(const f32x4*)(cst + 4); R.sn0 = *(const f32x4*)(cst + 16); R.sn1 = *(const f32x4*)(cst + 20); }
}
DEV void prep_finish(CP& P, int c, int job, PrepRegs& R) {
    const half8& r1 = R.r1; const half8& r2 = R.r2; const half8& r3 = R.r3;
    const f32x4 ga = R.ga, gb = R.gb, gc = R.gc, gd = R.gd, cs0 = R.cs0, cs1 = R.cs1, sn0 = R.sn0, sn1 = R.sn1;
    const float* g2 = R.g2; const size_t row = R.row;
    const float spre = group8_sum(sumsq8(R.pre[0]) + sumsq8(R.pre[1]) + sumsq8(R.pre[2]));
    const float s1 = group8_sum(sumsq8(r1)), s2 = group8_sum(sumsq8(r2)), s3 = group8_sum(sumsq8(r3));
    float part[8];
#pragma unroll
    for (int j = 0; j < 8; ++j) part[j] = xor1_f((float)r2[j]);
    const float rpre = job < 4 ? frsqrt(spre * (1.0f / 192.0f) + EPS) : (job < 8 ? frsqrt(spre * (1.0f / 128.0f) + EPS) : 1.0f);
    if (job < 8) {
        const float qs = job < 4 ? 0.10206207261596575f * LOG2E : 1.0f;
        const float pre1 = rpre;
        const float rn = frsqrt(s1 * pre1 * pre1 * (1.0f / 64.0f) + EPS) * pre1 * qs;
        half8 o1;
#pragma unroll
        for (int j = 0; j < 4; ++j) { o1[j] = (half_t)((float)r1[j] * rn * ga[j]); o1[4 + j] = (half_t)((float)r1[4 + j] * rn * gb[j]); }
        half_t* d1 = (job < 4 ? P.mq : P.mk) + row * 96;
        *(half8*)(d1 + 8 * c) = o1;
        const float pre2 = job < 4 ? rpre : 1.0f;
        const float rr = frsqrt(s2 * pre2 * pre2 * (1.0f / 32.0f) + EPS) * pre2;
        half8 o2;
        const f32x4 pc = *(const f32x4*)(g2 + 8 * ((c & 3) ^ 1)), pd = *(const f32x4*)(g2 + 8 * ((c & 3) ^ 1) + 4);
        const float sgn = (c & 1) ? 1.f : -1.f;
#pragma unroll
        for (int j = 0; j < 8; ++j) {
            const float gown = j < 4 ? gc[j] : gd[j - 4], gp = j < 4 ? pc[j] : pd[j - 4];
            const float own = (float)r2[j] * rr * gown, oth = part[j] * rr * gp;
            const float cj = j < 4 ? cs0[j] : cs1[j - 4], sj = j < 4 ? sn0[j] : sn1[j - 4];
            o2[j] = (half_t)((own * cj + sgn * oth * sj) * qs);
        }
        if (c < 4) *(half8*)(d1 + 64 + 8 * c) = o2;
        if (job >= 4) {
            half8 o3;
#pragma unroll
            for (int j = 0; j < 8; ++j) o3[j] = (half_t)((float)r3[j] * rpre);
            *(half8*)(P.mv + row * 64 + 8 * c) = o3;
        }
    } else if (job < 12) {
        const float rk = frsqrt(s3 * (1.0f / 64.0f) + EPS);
        half8 o3;
#pragma unroll
        for (int j = 0; j < 4; ++j) {
            o3[j] = (half_t)((float)r3[j] * rk * gc[j]); o3[4 + j] = (half_t)((float)r3[4 + j] * rk * gd[j]);
        }
        *(half8*)(P.nk + row * 64 + 8 * c) = o3;
    } else {
        *(half8*)(P.nv + row * 64 + 8 * c) = r1;
    }
}
DEV void mixer_prep_item(CP& P, int l, int item) {
    const int tid = TID(), c = tid & 7, grp = tid >> 3;
    for (int pass = 0; pass < 6; pass += 2) {
        const int sa = pass * 32 + grp, sb = sa + 32;
        const int ja = sa % 12, jb = sb % 12;
        PrepRegs Ra, Rb;
        prep_load(P, l, item * 16 + sa / 12, c, ja, ja & 3, Ra);
        prep_load(P, l, item * 16 + sb / 12, c, jb, jb & 3, Rb);
        SCHED_FENCE();
        prep_finish(P, c, ja, Ra);
        prep_finish(P, c, jb, Rb);
    }
}
DEV void phase_prep_scan(CP& P, int l, int rep) {
    constexpr int NSCAN = 2 * B_ * 4 * 2 * 2;
    constexpr int NPREP = NT / 16;
    for (int item = blockIdx.x; item < NSCAN + NPREP; item += gridDim.x) {
        if (item < NSCAN) {
            if (!rep) gla_scan(P, item, (half_t*)P.gst, 0);
            else gla_scan(P, item, P.y, 0);
        }
        else mixer_prep_item(P, l, item - NSCAN);
    }
    if (PROBE & 8) for (int item = blockIdx.x; item < NPREP; item += gridDim.x) mixer_prep_item(P, l, item);
}

DEV half8 vt_frag(const half_t* Vs, int ldv, int kbase, int dv0, int lane) {
    const int grp = lane >> 4, hh = lane >> 5, i = lane & 15, q = i >> 2, pp = i & 3;
    const half_t* a = Vs + (kbase + 4 * hh + q) * ldv + dv0 + 16 * (grp & 1) + 4 * pp;
    const half4 lo = tr16(a), hi = tr16(a + 8 * ldv);
    half8 r; r[0] = lo[0]; r[1] = lo[1]; r[2] = lo[2]; r[3] = lo[3]; r[4] = hi[0]; r[5] = hi[1]; r[6] = hi[2]; r[7] = hi[3]; return r;
}
DEV void softmax_pv_step(const f32x16& s, float& m, float& lsum, f32x16 (&o)[2], const half_t* Vs, int ldv, int lane) {
    float mx = s[0];
#pragma unroll
    for (int r = 1; r < 16; ++r) mx = fmaxf(mx, s[r]);
    mx = max_x32(mx);
    const float mn = fmaxf(m, mx);
    const float alpha = fexp2(m - mn);
    m = mn;
    float ps = 0.f; half8 pf[2];
#pragma unroll
    for (int r = 0; r < 16; ++r) { const float pv = fexp2(s[r] - mn); ps += pv; pf[r >> 3][r & 7] = (half_t)pv; }
    lsum = lsum * alpha + ps;
#pragma unroll
    for (int dt = 0; dt < 2; ++dt)
#pragma unroll
        for (int r = 0; r < 16; ++r) o[dt][r] *= alpha;
#pragma unroll
    for (int s2 = 0; s2 < 2; ++s2)
#pragma unroll
        for (int dt = 0; dt < 2; ++dt) o[dt] = mfma32(vt_frag(Vs, ldv, 16 * s2, 32 * dt, lane), pf[s2], o[dt]);
}
DEV void softmax_pv_step2(const f32x16& s0, const f32x16& s1, float& m, float& lsum, f32x16 (&o)[2], const half_t* Vs, int ldv, int lane) {
    float mx = fmaxf(s0[0], s1[0]);
#pragma unroll
    for (int r = 1; r < 16; ++r) mx = fmaxf(mx, fmaxf(s0[r], s1[r]));
    mx = max_x32(mx);
    const float mn = fmaxf(m, mx);
    if (wave_any(mn != m)) {
        const float alpha = fexp2(m - mn);
        lsum *= alpha;
#pragma unroll
        for (int dt = 0; dt < 2; ++dt)
#pragma unroll
            for (int r = 0; r < 16; ++r) o[dt][r] *= alpha;
        m = mn;
    }
    float ps = 0.f; half8 pf[4];
#pragma unroll
    for (int r = 0; r < 16; ++r) { const float pa = fexp2(s0[r] - m), pb = fexp2(s1[r] - m); ps += pa + pb; pf[r >> 3][r & 7] = (half_t)pa; pf[2 + (r >> 3)][r & 7] = (half_t)pb; }
    lsum += ps;
#pragma unroll
    for (int kt2 = 0; kt2 < 2; ++kt2)
#pragma unroll
        for (int s2 = 0; s2 < 2; ++s2)
#pragma unroll
            for (int dt = 0; dt < 2; ++dt) o[dt] = mfma32(vt_frag(Vs + 32 * kt2 * ldv, ldv, 16 * s2, 32 * dt, lane), pf[2 * kt2 + s2], o[dt]);
}
DEV void attn_store(const f32x16 (&o)[2], float lsum, half_t* stg, half_t* y, int row0, int col0, int lane) {
    const float inv = 1.0f / sum_x32(lsum);
    const int hh = lane >> 5, ql = lane & 31;
    WAVE_BARRIER();
#pragma unroll
    for (int dt = 0; dt < 2; ++dt)
#pragma unroll
        for (int rq = 0; rq < 4; ++rq) {
            half4 v;
#pragma unroll
            for (int e = 0; e < 4; ++e) v[e] = (half_t)(o[dt][4 * rq + e] * inv);
            *(half4*)(stg + ql * 72 + 32 * dt + 8 * rq + 4 * hh) = v;
        }
    WAVE_BARRIER();
    half8 v[4];
#pragma unroll
    for (int ps = 0; ps < 4; ++ps) v[ps] = *(const half8*)(stg + (8 * ps + (lane >> 3)) * 72 + 8 * (lane & 7));
#pragma unroll
    for (int ps = 0; ps < 4; ++ps) *(half8*)(y + pair_off((size_t)(row0 + 8 * ps + (lane >> 3)), col0 + 8 * (lane & 7), D)) = v[ps];
}
DEV int attn_qtoken(int b, int qpos) { return qpos < SEQ ? b * SEQ + qpos : NLAT + b * CTX + (qpos - SEQ); }

constexpr int MS_K = 64 * 96, MS_V = 64 * 64, MS_STAGE = MS_K + MS_V;
DEV half8 vt_frag_swz(const half_t* Vs, int kbase, int dv0, int lane) {
    const int grp = lane >> 4, hh = lane >> 5, i = lane & 15, q = i >> 2, pp = i & 3;
    const int r0 = kbase + 4 * hh + q, col = dv0 + 16 * (grp & 1) + 4 * pp;
    const int ch = (col >> 3) ^ (4 * ((r0 >> 1) & 1));
    const half_t* a = Vs + r0 * 64 + ch * 8 + (col & 7);
    const half4 lo = tr16_nowait<0>(a), hi = tr16_nowait<8 * 64 * 2>(a);
    half8 r; r[0] = lo[0]; r[1] = lo[1]; r[2] = lo[2]; r[3] = lo[3]; r[4] = hi[0]; r[5] = hi[1]; r[6] = hi[2]; r[7] = hi[3]; return r;
}
#define MLA_ISSUE(ST, KT)                                                                                                         \
    {                                                                                                                             \
        half_t* sk_ = mring + (ST) * MS_STAGE; half_t* sv_ = sk_ + MS_K;                                                          \
        const half_t* kg_ = kg + (size_t)(KT) * 64 * 96; const half_t* vg_ = vg + (size_t)(KT) * 64 * 64;                         \
        _Pragma("unroll") for (int j = 0; j < 3; ++j) glds16(kg_ + ksrc[j], sk_ + (3 * w + j) * 512);                             \
        _Pragma("unroll") for (int j = 0; j < 2; ++j) glds16(vg_ + vsrc[j], sv_ + (2 * w + j) * 512);                             \
    }
#define MLA_COMPUTE(ST)                                                                                                           \
    {                                                                                                                             \
        const half_t* Ks = mring + (ST) * MS_STAGE; const half_t* Vs = Ks + MS_K;                                                 \
        f32x16 s0, s1;                                                                                                            \
        _Pragma("unroll") for (int r = 0; r < 16; ++r) { s0[r] = 0.f; s1[r] = 0.f; }                                              \
        half8 kf0[6], kf1[6];                                                                                                     \
        _Pragma("unroll") for (int ks = 0; ks < 6; ++ks) {                                                                        \
            const int p = 2 * ks + hh, pz = (p & ~3) | ((p & 3) ^ ((ql >> 2) & 3));      \
            kf0[ks] = *(const half8*)(Ks + ql * 96 + pz * 8); kf1[ks] = *(const half8*)(Ks + (32 + ql) * 96 + pz * 8);            \
        }                                                                                                                         \
        SCHED_FENCE();                                                \
        _Pragma("unroll") for (int ks = 0; ks < 6; ++ks) { s0 = mfma32(kf0[ks], qf[ks], s0); s1 = mfma32(kf1[ks], qf[ks], s1); }  \
        softmax_pv_step2s(s0, s1, m, lsum, o, Vs, lane);                                                                          \
    }
#define MLA_STEP(ST, ST2, ktv)                                                                                                    \
    {                                                                                                                             \
        const int kt_ = (ktv);                                                                                                    \
        if (kt_ + 1 < nkt) { WAIT_VM(5); } else { WAIT_VM(0); }                                                                   \
        RAW_BARRIER();                                                                                                            \
        if (kt_ + 2 < nkt) MLA_ISSUE(ST2, kt_ + 2)                                                                                \
        MLA_COMPUTE(ST)                                                                                                           \
    }
DEV void softmax_pv_step2s(const f32x16& s0, const f32x16& s1, float& m, float& lsum, f32x16 (&o)[2], const half_t* Vs, int lane) {
    float mx = fmaxf(s0[0], s1[0]);
#pragma unroll
    for (int r = 1; r < 16; ++r) mx = fmaxf(mx, fmaxf(s0[r], s1[r]));
    mx = max_x32(mx);
    const float mn = fmaxf(m, mx);
    if (wave_any(mn != m)) {
        const float alpha = fexp2(m - mn);
        lsum *= alpha;
#pragma unroll
        for (int dt = 0; dt < 2; ++dt)
#pragma unroll
            for (int r = 0; r < 16; ++r) o[dt][r] *= alpha;
        m = mn;
    }
    half8 vf[8];
#pragma unroll
    for (int kt2 = 0; kt2 < 2; ++kt2)
#pragma unroll
        for (int s2 = 0; s2 < 2; ++s2)
#pragma unroll
            for (int dt = 0; dt < 2; ++dt) vf[4 * kt2 + 2 * s2 + dt] = vt_frag_swz(Vs, 32 * kt2 + 16 * s2, 32 * dt, lane);
    float ps = 0.f; half8 pf[4];
#pragma unroll
    for (int r = 0; r < 16; ++r) { const float pa = fexp2(s0[r] - m), pb = fexp2(s1[r] - m); ps += pa + pb; pf[r >> 3][r & 7] = (half_t)pa; pf[2 + (r >> 3)][r & 7] = (half_t)pb; }
    lsum += ps;
    TR_WAIT();
#pragma unroll
    for (int kt2 = 0; kt2 < 2; ++kt2)
#pragma unroll
        for (int s2 = 0; s2 < 2; ++s2)
#pragma unroll
            for (int dt = 0; dt < 2; ++dt) o[dt] = mfma32(vf[4 * kt2 + 2 * s2 + dt], pf[2 * kt2 + s2], o[dt]);
}
DEV void mla_attn_item(CP& P, int b, int h, int qt, unsigned char* smem) {
    half_t* mring = (half_t*)smem;
    const int tid = TID(), lane = tid & 63, w = WID(tid), hh = lane >> 5, ql = lane & 31;
    const size_t bh = (size_t)(b * 4 + h) * KEYS;
    const int q0 = qt * 128 + 32 * w;
    const bool ctxq = q0 >= SEQ;
    const int kbeg = ctxq ? SEQ : 0, nkt = (ctxq ? CTX : KEYS) / 64;
    half8 qf[6];
#pragma unroll
    for (int ks = 0; ks < 6; ++ks) qf[ks] = *(const half8*)(P.mq + (bh + q0 + ql) * 96 + 16 * ks + 8 * hh);
    f32x16 o[2]; float m = -1e30f, lsum = 0.f;
#pragma unroll
    for (int dt = 0; dt < 2; ++dt)
#pragma unroll
        for (int r = 0; r < 16; ++r) o[dt][r] = 0.f;
    const half_t* kg = P.mk + (bh + kbeg) * 96; const half_t* vg = P.mv + (bh + kbeg) * 64;
    int ksrc[3], vsrc[2];
#pragma unroll
    for (int j = 0; j < 3; ++j) { const int L = (3 * w + j) * 64 + lane, r = L / 12, p = L % 12; ksrc[j] = r * 96 + 8 * ((p & ~3) | ((p & 3) ^ ((r >> 2) & 3))); }
#pragma unroll
    for (int j = 0; j < 2; ++j) { const int L = (2 * w + j) * 64 + lane, r = L >> 3, p = L & 7; vsrc[j] = r * 64 + 8 * (p ^ (4 * ((r >> 1) & 1))); }
    SYNC();
    MLA_ISSUE(0, 0)
    MLA_ISSUE(1, 1)
#pragma clang loop unroll(disable)
    for (int kt = 0; kt < nkt; kt += 3) {
        MLA_STEP(0, 2, kt)
        if (kt + 1 < nkt) MLA_STEP(1, 0, kt + 1)
        if (kt + 2 < nkt) MLA_STEP(2, 1, kt + 2)
    }
    SYNC();
    attn_store(o, lsum, mring + w * 32 * 72, P.y, attn_qtoken(b, q0), 0 + h * 64, lane);
}

constexpr int NV_LD = 72, NA_WAVE_LDS = 32 * NV_LD * 2 + 15 * 32 * 4;
DEV void na_attn_unit(CP& P, int l, int unit, unsigned char* wlds, int lane) {
    constexpr int NLATU = B_ * 4 * ROWS * 2;
    half_t* Vw = (half_t*)wlds; float* bt = (float*)(wlds + 32 * NV_LD * 2);
    const int hh = lane >> 5, ql = lane & 31;
    int b, h, q0, ntile, R0 = 0, r = 0, hf = 0; bool lat;
    if (unit < NLATU) { lat = true; hf = unit & 1; r = (unit >> 1) % ROWS; const int bh = unit / (2 * ROWS); h = bh & 3; b = bh >> 2; q0 = r * 64 + 32 * hf; ntile = 16 + CTX / 32;
        R0 = r - 4 < 0 ? 0 : (r - 4 > ROWS - 8 ? ROWS - 8 : r - 4); }
    else { lat = false; const int u = unit - NLATU; const int cb = u % (CTX / 32); const int bh = u / (CTX / 32); h = bh & 3; b = bh >> 2; q0 = SEQ + 32 * cb; ntile = CTX / 32; }
    const size_t bhk = (size_t)(b * 4 + h) * KEYS;
    WAVE_BARRIER();
    if (lat) {
        const float* rp = P.na_rpb + (size_t)(l * 4 + h) * 15 * 31;
        for (int i = lane; i < 15 * 32; i += 64) { const int dr = i >> 5, dc = i & 31; bt[i] = dc < 31 ? rp[dr * 31 + dc] * LOG2E : 0.f; }
    }
    half8 qf[4];
    {
        const half_t* qrow = P.p + (size_t)attn_qtoken(b, q0 + ql) * PPAD + O_NAQ + h * 64 + 8 * hh;
        const float* gq = P.na_g_q + l * 64 + 8 * hh;
        half8 qr[4]; f32x4 ga[4], gb[4];
#pragma unroll
        for (int ks = 0; ks < 4; ++ks) { qr[ks] = *(const half8*)(qrow + 16 * ks); ga[ks] = *(const f32x4*)(gq + 16 * ks); gb[ks] = *(const f32x4*)(gq + 16 * ks + 4); }
        float ss = 0.f;
#pragma unroll
        for (int ks = 0; ks < 4; ++ks)
#pragma unroll
            for (int j = 0; j < 8; ++j) ss += (float)qr[ks][j] * (float)qr[ks][j];
        ss = sum_x32(ss);
        const float rq = frsqrt(ss * (1.0f / 64.0f) + EPS) * (0.125f * LOG2E);
#pragma unroll
        for (int ks = 0; ks < 4; ++ks)
#pragma unroll
            for (int j = 0; j < 4; ++j) { qf[ks][j] = (half_t)((float)qr[ks][j] * rq * ga[ks][j]); qf[ks][4 + j] = (half_t)((float)qr[ks][4 + j] * rq * gb[ks][j]); }
    }
    f32x16 o[2]; float m = -1e30f, lsum = 0.f;
#pragma unroll
    for (int dt = 0; dt < 2; ++dt)
#pragma unroll
        for (int rr = 0; rr < 16; ++rr) o[dt][rr] = 0.f;
    const int wq = 32 * hf + ql;
    const int cs = wq - 8 < 0 ? 0 : (wq - 8 > 48 ? 48 : wq - 8);
    auto tile_kpos = [&](int tile) { return (lat && tile < 16) ? (R0 + (tile >> 1)) * 64 + 32 * (tile & 1) : SEQ + 32 * (lat ? tile - 16 : tile); };
    half8 kf[4], vf[4];
    {
        const int kp = tile_kpos(0);
#pragma unroll
        for (int ks = 0; ks < 4; ++ks) kf[ks] = *(const half8*)(P.nk + (bhk + kp + ql) * 64 + 16 * ks + 8 * hh);
#pragma unroll
        for (int i = 0; i < 4; ++i) { const int c = lane + 64 * i; vf[i] = *(const half8*)(P.p + (size_t)attn_qtoken(b, kp + (c >> 3)) * PPAD + O_NAV + h * 64 + (c & 7) * 8); }
    }
    for (int tile = 0; tile < ntile; ++tile) {
        const bool win = lat && tile < 16;
        const int krow = R0 + (tile >> 1), kh2 = tile & 1;
        f32x16 s;
#pragma unroll
        for (int rr = 0; rr < 16; ++rr) s[rr] = 0.f;
#pragma unroll
        for (int ks = 0; ks < 4; ++ks) s = mfma32(kf[ks], qf[ks], s);
        WAVE_BARRIER();
#pragma unroll
        for (int i = 0; i < 4; ++i) { const int c = lane + 64 * i; *(half8*)(Vw + (c >> 3) * NV_LD + (c & 7) * 8) = vf[i]; }
        if (tile + 1 < ntile) {
            const int kp = tile_kpos(tile + 1);
#pragma unroll
            for (int ks = 0; ks < 4; ++ks) kf[ks] = *(const half8*)(P.nk + (bhk + kp + ql) * 64 + 16 * ks + 8 * hh);
#pragma unroll
            for (int i = 0; i < 4; ++i) { const int c = lane + 64 * i; vf[i] = *(const half8*)(P.p + (size_t)attn_qtoken(b, kp + (c >> 3)) * PPAD + O_NAV + h * 64 + (c & 7) * 8); }
        }
        SCHED_FENCE();
        if (win) {
            const float* brow = bt + (krow - r + 7) * 32;
            float bv[16];
#pragma unroll
            for (int rr = 0; rr < 16; ++rr) {
                const int wk = 32 * kh2 + (rr & 3) + 8 * (rr >> 2) + 4 * hh;
                int dc = wk - wq + 15; dc = dc < 0 ? 0 : (dc > 30 ? 30 : dc);
                bv[rr] = brow[dc];
            }
#pragma unroll
            for (int rr = 0; rr < 16; ++rr) {
                const int wk = 32 * kh2 + (rr & 3) + 8 * (rr >> 2) + 4 * hh;
                const bool valid = wk >= cs && wk < cs + 16;
                s[rr] = valid ? s[rr] + bv[rr] : -INFINITY;
            }
        }
        WAVE_BARRIER();
        softmax_pv_step(s, m, lsum, o, Vw, NV_LD, lane);
    }
    attn_store(o, lsum, Vw, P.y, attn_qtoken(b, q0), 256 + h * 64, lane);
}

DEV void mixers_item(CP& P, int l, int item, unsigned char* smem) {
    const bool last = l == NL - 1;
    const int QT = (last ? SEQ : KEYS) / 128;
    const int NMLA = B_ * 4 * QT;
    const int NNA = (B_ * 4 * ROWS * 2 + (last ? 0 : B_ * 4 * (CTX / 32))) / 4;
    const int NGRP = last ? LG : NCH;
    const int lane = TID() & 63, w = TID() >> 6;
    if (item < NMLA) {
        const int qt = item % QT, bh = item / QT;
        mla_attn_item(P, bh >> 2, bh & 3, qt, smem);
    } else if (item < NMLA + NNA) {
        SYNC();
        na_attn_unit(P, l, (item - NMLA) * 4 + w, smem + w * NA_WAVE_LDS, lane);
    } else {
        int it = item - NMLA - NNA;
        const int gi = it % NGRP; it /= NGRP; const int h = it & 3; it >>= 2; const int b = it % B_; const int mix = it / B_;
        const int gidx = last ? gi + CG : gi;
        SYNC();
        if (mix == 0) gla_step_c<0>(P, l, b, h, gidx, smem); else gla_step_c<1>(P, l, b, h, gidx, smem);
    }
}
DEV int sched_next(int* ctr, unsigned char* smem) {
    int* slot = (int*)(smem + SMEM_BYTES - 16);
    SYNC();
    if (TID() == 0) *slot = atomic_add_i(ctr, 1);
    SYNC();
    return *slot;
}
constexpr int NCONV = 1024;
constexpr int CV_W13 = NEXP * D * 1024 / 8, CV_W2 = NEXP * 512 * D / 8;
DEV void moe_convert_unit(CP& P, int l, int u) {
    constexpr int PER = (CV_W13 + CV_W2) / NCONV;
    static_assert((CV_W13 + CV_W2) % NCONV == 0 && PER % NTHREADS == 0, "conversion split");
    const int tid = TID();
    for (int i0 = 0; i0 < PER; i0 += 4 * NTHREADS) {
        RawF r[4]; int c[4];
#pragma unroll
        for (int j = 0; j < 4; ++j) {
            c[j] = u * PER + i0 + j * NTHREADS + tid;
            const float* src;
            if (c[j] < CV_W13) {
                const int v = (c[j] & 127) * 8, k = (c[j] >> 7) & 1023, e = c[j] >> 17;
                const int tn = v >> 7, half = (v >> 6) & 1, col = 64 * tn + (v & 63);
                src = (half ? P.moe_w3 : P.moe_w1) + (((size_t)l * NEXP + e) * D + k) * 512 + col;
            } else { src = P.moe_w2 + (size_t)l * NEXP * 512 * D + (size_t)(c[j] - CV_W13) * 8; }
            r[j].a = *(const f32x4*)src; r[j].b = *(const f32x4*)(src + 4);
        }
        SCHED_FENCE();
#pragma unroll
        for (int j = 0; j < 4; ++j) {
            half_t* dst = c[j] < CV_W13 ? P.w13h + (size_t)c[j] * 8 : P.w2h + (size_t)(c[j] - CV_W13) * 8;
            *(half8*)dst = cvt_rawf(r[j]);
        }
    }
}
DEV void phase_mixers(CP& P, int l, unsigned char* smem, int rep) {
    const bool last = l == NL - 1;
    const int QT = (last ? SEQ : KEYS) / 128;
    const int NMLA = B_ * 4 * QT;
    const int NNA = (B_ * 4 * ROWS * 2 + (last ? 0 : B_ * 4 * (CTX / 32))) / 4;
    const int NGC = 2 * B_ * 4 * (last ? LG : NCH);
    const int NCV = rep ? 0 : NCONV;
    const int NIL = NMLA < NCV ? NMLA : NCV;
    const int NU = NMLA + NCV + NNA + NGC / 4;
    int* ctr = P.sched + l * 16 + rep;
    for (int u = sched_next(ctr, smem); u < NU; u = sched_next(ctr, smem)) {
        if (u < 2 * NIL) { if (u & 1) moe_convert_unit(P, l, u >> 1); else mixers_item(P, l, u >> 1, smem); }
        else if (u < NMLA + NCV) { const int v = u - 2 * NIL; if (NMLA > NCV) mixers_item(P, l, NIL + v, smem); else moe_convert_unit(P, l, NIL + v); }
        else if (u < NMLA + NCV + NNA) mixers_item(P, l, u - NCV, smem);
        else { const int g0 = NMLA + NNA + (u - NMLA - NCV - NNA) * 4; for (int j = 0; j < 4; ++j) mixers_item(P, l, g0 + j, smem); }
    }
    if (PROBE & 16) for (int item = blockIdx.x; item < NMLA; item += gridDim.x) mixers_item(P, l, item, smem);
    if (PROBE & 32) for (int item = blockIdx.x; item < NNA; item += gridDim.x) mixers_item(P, l, NMLA + item, smem);
    if (PROBE & 64) for (int item = blockIdx.x; item < NGC; item += gridDim.x) mixers_item(P, l, NMLA + NNA + item, smem);
}

DEV void phase_outproj(CP& P, int l, unsigned char* smem, int rep0) {
    const bool last = l == NL - 1;
    const int NTM = (last ? NLAT : NT) / 256;
    const int full = (NTM * 8) / gridDim.x;
    for (int rep = rep0; rep < ((PROBE & 512) ? 2 : rep0 + 1); ++rep) {
        for (int round = 0; round < full; ++round) {
            int tm, tn;
            if (!gemm_tile_order(round, NTM, 8, tm, tn)) continue;
            const int t0 = tm * 256;
            ARowPair ar{P.y, t0, D};
            BSrcH bs{P.wout16 + (size_t)l * D * D + tn * 128, D};
            EpiResid epi{(rep ? (half_t*)P.gst + (size_t)t0 * D : xrow_ptr(P, t0)) + tn * 128, l == 0 ? xin_ptr(P, t0) + tn * 128 : (const float*)nullptr, P.mod + ((size_t)l * (B_ + 1) + tok_brow(t0)) * MODW + 2 * D + tn * 128};
            gemm_tile<4>(ar, bs, D, epi, smem);
        }
        const int base = full * gridDim.x, left = NTM * 8 - base;
        for (int i = blockIdx.x; i < 4 * left; i += gridDim.x) {
            int tm, tn; gemm_tile_idx(base + (i >> 2), NTM, 8, tm, tn);
            const int t0 = tm * 256 + 64 * (i & 3);
            ARowPair ar{P.y, t0, D};
            BSrcH bs{P.wout16 + (size_t)l * D * D + tn * 128, D};
            EpiResid epi{(rep ? (half_t*)P.gst + (size_t)t0 * D : xrow_ptr(P, t0)) + tn * 128, l == 0 ? xin_ptr(P, t0) + tn * 128 : (const float*)nullptr, P.mod + ((size_t)l * (B_ + 1) + tok_brow(t0)) * MODW + 2 * D + tn * 128};
            gemm_tile<1>(ar, bs, D, epi, smem);
        }
    }
}

template <bool DRY> DEV void phase_router_t(CP& P, int l, unsigned char* smem) {
    const bool last = l == NL - 1;
    const int NU = (last ? NLAT : NT) / 16;
    const int tid = TID(), lane = tid & 63, w = WID(tid), g = lane >> 4, li = lane & 15;
    float* wrs = (float*)smem + w * 64 * 52;
    float* red = (float*)(smem + 4 * 64 * 52 * 4);
    float* lg = red + 4 * 64 * 13;
    const float* wr = P.wr + (size_t)l * D * 48;
    for (int unit = blockIdx.x; unit < NU; unit += gridDim.x) {
        const int tok0 = unit * 16, br = tok_brow(tok0);
        const half_t* xr = xrow_ptr(P, tok0 + li);
        const float* md = P.mod + ((size_t)l * (B_ + 1) + br) * MODW;
        const float* sh = md + 3 * D; const float* sc = md + 4 * D;
        const int kbase = 256 * w;
        f32x4 acc[3];
#pragma unroll
        for (int nt = 0; nt < 3; ++nt) acc[nt] = (f32x4){0.f, 0.f, 0.f, 0.f};
        float ssq = 0.f;
        f32x4 wv[6], sv[2]; half8 xv;
#pragma unroll
        for (int i = 0; i < 6; ++i) { const int idx = lane + 64 * i; wv[i] = *(const f32x4*)(wr + (size_t)(kbase + idx / 12) * 48 + (idx % 12) * 4); }
        xv = *(const half8*)(xr + kbase + 8 * g);
#pragma unroll
        for (int j = 0; j < 2; ++j) sv[j] = *(const f32x4*)(sc + kbase + 8 * g + 4 * j);
        for (int ch = 0; ch < 8; ++ch) {
            WAVE_BARRIER();
#pragma unroll
            for (int i = 0; i < 6; ++i) { const int idx = lane + 64 * i; *(f32x4*)(wrs + (idx / 12) * 52 + (idx % 12) * 4) = wv[i]; }
            WAVE_BARRIER();
            f32x4 xc[2], sk[2];
#pragma unroll
            for (int j = 0; j < 2; ++j) { sk[j] = sv[j];
#pragma unroll
                for (int c = 0; c < 4; ++c) xc[j][c] = (float)xv[4 * j + c]; }
            if (ch + 1 < 8) {
                const int k1 = kbase + 32 * (ch + 1);
#pragma unroll
                for (int i = 0; i < 6; ++i) { const int idx = lane + 64 * i; wv[i] = *(const f32x4*)(wr + (size_t)(k1 + idx / 12) * 48 + (idx % 12) * 4); }
#pragma unroll
                for (int j = 0; j < 2; ++j) sv[j] = *(const f32x4*)(sc + k1 + 8 * g + 4 * j);
                xv = *(const half8*)(xr + k1 + 8 * g);
            }
            SCHED_FENCE();
#pragma unroll
            for (int j = 0; j < 2; ++j) {
                ssq += xc[j][0] * xc[j][0] + xc[j][1] * xc[j][1] + xc[j][2] * xc[j][2] + xc[j][3] * xc[j][3];
#pragma unroll
                for (int c = 0; c < 4; ++c) {
                    const float a = xc[j][c] * (1.0f + sk[j][c]);
                    const float* wrow_l = wrs + (8 * g + 4 * j + c) * 52 + li;
#pragma unroll
                    for (int nt = 0; nt < 3; ++nt) acc[nt] = mfmaf(a, wrow_l[16 * nt], acc[nt]);
                }
            }
        }
        SYNC();
        {
            float* rp = red + (w * 64 + lane) * 13;
#pragma unroll
            for (int nt = 0; nt < 3; ++nt)
#pragma unroll
                for (int r = 0; r < 4; ++r) rp[4 * nt + r] = acc[nt][r];
            rp[12] = ssq;
        }
        SYNC();
        float tot[13];
#pragma unroll
        for (int i = 0; i < 13; ++i) tot[i] = (red[lane * 13 + i] + red[(64 + lane) * 13 + i]) + (red[(128 + lane) * 13 + i] + red[(192 + lane) * 13 + i]);
        float sq = tot[12];
        sq = sum_x32(sum_x16(sq));
        const float rstd = frsqrt(sq * (1.0f / D) + EPS);
        const float* csh = P.cshift + ((size_t)l * (B_ + 1) + br) * 48;
        if (w == 0) {
#pragma unroll
            for (int r = 0; r < 4; ++r) {
                const float rs = shfl_f(rstd, 4 * g + r);
#pragma unroll
                for (int nt = 0; nt < 3; ++nt) lg[(4 * g + r) * 48 + 16 * nt + li] = tot[4 * nt + r] * rs + csh[16 * nt + li];
            }
            WAVE_BARRIER();
            if (lane < 16) {
                const float* lt = lg + lane * 48;
                int gi = 0; float gm = lt[0];
                for (int j = 1; j < 4; ++j) if (lt[j] > gm) { gm = lt[j]; gi = j; }
                float gden = 0.f; for (int j = 0; j < 4; ++j) gden += fexp(lt[j] - gm);
                const float pg = 1.0f / gden;
                const float* ft = lt + 4 + gi * 8;
                int e0 = 0; float f0 = ft[0];
                for (int j = 1; j < 8; ++j) if (ft[j] > f0) { f0 = ft[j]; e0 = j; }
                int e1 = -1; float f1 = -3.0e38f;
                for (int j = 0; j < 8; ++j) if (j != e0 && ft[j] > f1) { f1 = ft[j]; e1 = j; }
                const float p1 = fexp(f1 - f0);
                const float g0 = pg / (1.0f + p1), g1 = pg * p1 / (1.0f + p1);
                const int t = tok0 + lane, x0 = gi * 8 + e0, x1 = gi * 8 + e1;
                if (DRY) { float* dd = (float*)P.act + (size_t)t * 4; dd[0] = g0; dd[1] = g1; dd[2] = (float)x0; dd[3] = (float)x1; }
                else {
                const int s0 = atomic_add_i(P.cnt + l * NEXP + x0, 1), s1 = atomic_add_i(P.cnt + l * NEXP + x1, 1);
                P.list_tok[(size_t)x0 * NT + s0] = t; P.list_gate[(size_t)x0 * NT + s0] = g0;
                P.list_tok[(size_t)x1 * NT + s1] = t; P.list_gate[(size_t)x1 * NT + s1] = g1;
                P.tokslot[2 * t] = (x0 << 20) | s0; P.tokslot[2 * t + 1] = (x1 << 20) | s1;
                }
            }
        }
        float rs4[4];
#pragma unroll
        for (int i = 0; i < 4; ++i) rs4[i] = shfl_f(rstd, 4 * i + g);
#pragma unroll
        for (int hf = 0; hf < 2; ++hf) {
            const int col = kbase + 128 * hf + 8 * li;
            half8 xq[4]; f32x4 sa = *(const f32x4*)(sc + col), sb = *(const f32x4*)(sc + col + 4), ha = *(const f32x4*)(sh + col), hb = *(const f32x4*)(sh + col + 4);
#pragma unroll
            for (int i = 0; i < 4; ++i) xq[i] = *(const half8*)(xrow_ptr(P, tok0 + 4 * i + g) + col);
            SCHED_FENCE();
#pragma unroll
            for (int i = 0; i < 4; ++i) {
                half8 o;
#pragma unroll
                for (int c = 0; c < 4; ++c) { o[c] = (half_t)((float)xq[i][c] * rs4[i] * (1.0f + sa[c]) + ha[c]); o[4 + c] = (half_t)((float)xq[i][4 + c] * rs4[i] * (1.0f + sb[c]) + hb[c]); }
                *(half8*)((DRY ? P.y : P.h) + pair_off((size_t)(tok0 + 4 * i + g), col, D)) = o;
            }
        }
    }
}

DEV void phase_router(CP& P, int l, unsigned char* smem, int rep) {
    if (rep) { phase_router_t<true>(P, l, smem); return; }
    phase_router_t<false>(P, l, smem);
    if (PROBE & 1024) phase_router_t<true>(P, l, smem);
}
DEV void moe_tables(CP& P, int l, int* ab, int* tb) {
    if (TID() == 0) {
        int a = 0, t = 0;
        for (int e = 0; e < NEXP; ++e) { const int c = P.cnt[l * NEXP + e], nt = (c + 255) >> 8; ab[e] = a; tb[e] = t; a += nt * 256; t += nt; }
        ab[NEXP] = a; tb[NEXP] = t;
    }
    SYNC();
}
DEV int moe_find(const int* tb, int tile) { int e = 0; while (e < NEXP - 1 && tile >= tb[e + 1]) ++e; return e; }
DEV bool moe_item(const int* tb, int idx, int& e, int& mt, int& tn) {
    const int x = blockIdx.x & 7;
#pragma unroll
    for (int eg = 0; eg < 4; ++eg) {
        e = x + 8 * eg; const int n = (tb[e + 1] - tb[e]) * 8;
        if (idx < n) { mt = idx >> 3; tn = idx & 7; return true; }
        idx -= n;
    }
    return false;
}

DEV void phase_moe1(CP& P, int l, unsigned char* smem) {
    int* ab = (int*)(smem + SMEM_BYTES - 512); int* tb = ab + 40;
    moe_tables(P, l, ab, tb);
    for (int rep = 0; rep < ((PROBE & 128) ? 2 : 1); ++rep)
    for (int idx = blockIdx.x >> 3;; idx += gridDim.x >> 3) {
        int e, mt, tn; if (!moe_item(tb, idx, e, mt, tn)) break;
        const int cnt = P.cnt[l * NEXP + e], nvalid = cnt - mt * 256 < 256 ? cnt - mt * 256 : 256;
        ARowGather ar{P.h, D, P.list_tok + (size_t)e * NT + mt * 256, nvalid};
        BSrcH bs{P.w13h + (size_t)e * D * 1024 + tn * 128, 1024};
        EpiGlu epi{P.act, ab[e] + mt * 256, tn * 64};
        gemm256(ar, bs, D, epi, smem);
    }
}
DEV void phase_moe2(CP& P, int l, unsigned char* smem) {
    int* ab = (int*)(smem + SMEM_BYTES - 512); int* tb = ab + 40;
    moe_tables(P, l, ab, tb);
    for (int rep = 0; rep < ((PROBE & 256) ? 2 : 1); ++rep)
    for (int idx = blockIdx.x >> 3;; idx += gridDim.x >> 3) {
        int e, mt, tn; if (!moe_item(tb, idx, e, mt, tn)) break;
        const int cnt = P.cnt[l * NEXP + e], nvalid = cnt - mt * 256 < 256 ? cnt - mt * 256 : 256;
        const size_t r0 = (size_t)ab[e] + mt * 256;
        ARowPair ar{P.act, (int)r0, 512};
        BSrcH bs{P.w2h + (size_t)e * 512 * D + tn * 128, D};
        EpiRowsGate epi{P.yrows + r0 * D + tn * 128, P.list_gate + (size_t)e * NT + mt * 256, nvalid};
        gemm256(ar, bs, 512, epi, smem);
    }
}
template <bool DRY> DEV void phase_combine_t(CP& P, int l, unsigned char* smem) {
    int* ab = (int*)(smem + SMEM_BYTES - 512); int* tb = ab + 40;
    moe_tables(P, l, ab, tb);
    const bool last = l == NL - 1;
    const int NTK = last ? NLAT : NT;
    const int lane = TID() & 63, gw = blockIdx.x * 4 + (TID() >> 6), nw = gridDim.x * 4;
    for (int t = gw; t < NTK; t += nw) {
        const int ts0 = P.tokslot[2 * t], ts1 = P.tokslot[2 * t + 1];
        const half_t* y0 = P.yrows + (size_t)(ab[ts0 >> 20] + (ts0 & 0xFFFFF)) * D;
        const half_t* y1 = P.yrows + (size_t)(ab[ts1 >> 20] + (ts1 & 0xFFFFF)) * D;
        half_t* xr = xrow_ptr(P, t);
        half_t* xw = DRY ? (half_t*)P.gst + (size_t)t * D : xr;
        float* ow = (DRY ? P.gst : P.out) + (size_t)t * D;
        const float* md = P.mod + ((size_t)l * (B_ + 1) + tok_brow(t)) * MODW;
        f32x4 v[4], gt[4]; half4 xv[4], ya[4], yb[4];
#pragma unroll
        for (int j = 0; j < 4; ++j) {
            const int col = 256 * j + 4 * lane;
            xv[j] = *(const half4*)(xr + col); gt[j] = *(const f32x4*)(md + 5 * D + col); ya[j] = *(const half4*)(y0 + col); yb[j] = *(const half4*)(y1 + col);
        }
        SCHED_FENCE();
#pragma unroll
        for (int j = 0; j < 4; ++j) {
            const int col = 256 * j + 4 * lane;
#pragma unroll
            for (int e = 0; e < 4; ++e) v[j][e] = (float)xv[j][e] + gt[j][e] * ((float)ya[j][e] + (float)yb[j][e]);
            if (last) *(f32x4*)(ow + col) = v[j]; else *(half4*)(xw + col) = to_half4(v[j]);
        }
        if (!last) { const float* mn = md + (size_t)(B_ + 1) * MODW; row_modulate_store(v, mn + 0, mn + D, DRY ? P.y : P.h, t, lane); }
    }
}

DEV void phase_combine(CP& P, int l, unsigned char* smem, int rep) {
    if (rep) { phase_combine_t<true>(P, l, smem); return; }
    if (PROBE & 2048) phase_combine_t<true>(P, l, smem);
    phase_combine_t<false>(P, l, smem);
}
template <int PH> DEV void run_phase(CP& P, int l, unsigned char* smem, int rep = 0) {
    if (PH == 0) { phase_prologue_a(P, smem); if (PROBE & 4096) { SYNC(); phase_prologue_a(P, smem); } }
    if (PH == 1) { phase_prologue_b(P); if (PROBE & 4096) phase_prologue_b(P); }
    if (PH == 2) phase_inproj(P, l, smem);
    if (PH == 3) phase_up_glaa(P, l, smem);
    if (PH == 4) phase_prep_scan(P, l, rep);
    if (PH == 5) phase_mixers(P, l, smem, rep);
    if (PH == 6) phase_outproj(P, l, smem, rep);
    if (PH == 7) phase_router(P, l, smem, rep);
    if (PH == 8) phase_moe1(P, l, smem);
    if (PH == 9) phase_moe2(P, l, smem);
    if (PH == 10) phase_combine(P, l, smem, rep);
}

#ifndef CPU_EMU
#define XB_TMO      128
#define XB_XCNT(j)  (256  + 64 * (j))
#define XB_XSUB(j)  (1280 + 64 * (j))
#define XB_XGEN(j)  (2304 + 64 * (j))
#define XB_TOP      3328
#define XB_TOPGEN   3392
#define XCD_BAR_WORDS 3456
#define XB_SPIN_CAP (1u << 24)
__device__ __forceinline__ unsigned xb_ld(unsigned* p)              { return __hip_atomic_load(p, __ATOMIC_RELAXED, __HIP_MEMORY_SCOPE_AGENT); }
__device__ __forceinline__ unsigned xb_add(unsigned* p, unsigned v) { return __hip_atomic_fetch_add(p, v, __ATOMIC_RELAXED, __HIP_MEMORY_SCOPE_AGENT); }
__device__ __forceinline__ unsigned xb_xcc_id() { return (unsigned)__builtin_amdgcn_s_getreg((3 << 11) | 20) & 0xFu; }
#define XB_SPIN(cond, bar) do { unsigned _sp = 0; while (cond) { __builtin_amdgcn_s_sleep(1); \
    if ((++_sp & 255u) == 0u) { if (xb_ld(&(bar)[XB_TMO])) break; if (_sp > XB_SPIN_CAP) { atomicAdd(&(bar)[XB_TMO], 1u); break; } } } } while (0)
struct XcdBarrier { unsigned* bar; unsigned x; volatile LDSP unsigned* st; };
__device__ __forceinline__ XcdBarrier xcd_barrier_post(unsigned* bar, volatile LDSP unsigned* st) {
    XcdBarrier b; b.bar = bar; b.x = xb_xcc_id(); b.st = st;
    if (threadIdx.x == 0) (void)xb_add(&bar[XB_XCNT(b.x)], 1u);
    return b;
}
__device__ __forceinline__ void xcd_barrier_complete(unsigned* bar, unsigned x, unsigned& nloc, unsigned& nx) {
    const unsigned G = gridDim.x * gridDim.y * gridDim.z;
    unsigned sum, cnt, mine, sp = 0u;
    for (;;) {
        sum = 0u; cnt = 0u; mine = 0u;
#pragma unroll
        for (unsigned j = 0; j < 16; ++j) { const unsigned c = xb_ld(&bar[XB_XCNT(j)]); sum += c; cnt += (c > 0u) ? 1u : 0u; mine = (j == x) ? c : mine; }
        if (sum == G) break;
        __builtin_amdgcn_s_sleep(1);
        if ((++sp & 255u) == 0u) { if (xb_ld(&bar[XB_TMO])) break; if (sp > XB_SPIN_CAP) { atomicAdd(&bar[XB_TMO], 1u); break; } }
    }
    nloc = mine > 0u ? mine : 1u; nx = cnt > 0u ? cnt : 1u;
}
__device__ __forceinline__ void xcd_barrier1(const XcdBarrier& b) {
    asm volatile("s_waitcnt vmcnt(0)" ::: "memory");
    __syncthreads();
    if (threadIdx.x == 0) {
        unsigned* bar = b.bar;
        __builtin_amdgcn_s_waitcnt(0);
        unsigned nloc = b.st[0], nx = b.st[1];
        if (nloc == 0u) { xcd_barrier_complete(bar, b.x, nloc, nx); b.st[0] = nloc; b.st[1] = nx; }
        const unsigned old = xb_add(&bar[XB_XSUB(b.x)], 1u);
        const unsigned gen = old / nloc;
        if (old + 1u == (gen + 1u) * nloc) {
            __builtin_amdgcn_fence(__ATOMIC_RELEASE, "agent");
            asm volatile("s_waitcnt vmcnt(0)" ::: "memory");
            const unsigned og = xb_add(&bar[XB_TOP], 1u);
            const unsigned tg = og / nx;
            if (og + 1u == (tg + 1u) * nx) xb_add(&bar[XB_TOPGEN], 1u);
            else XB_SPIN(xb_ld(&bar[XB_TOPGEN]) == tg, bar);
            __builtin_amdgcn_fence(__ATOMIC_ACQUIRE, "agent");
            xb_add(&bar[XB_XGEN(b.x)], 1u);
            asm volatile("s_waitcnt vmcnt(0)" ::: "memory");
        } else {
            XB_SPIN(xb_ld(&bar[XB_XGEN(b.x)]) == gen, bar);
            __builtin_amdgcn_fence(__ATOMIC_ACQUIRE, "agent");
            asm volatile("s_waitcnt vmcnt(0)" ::: "memory");
        }
    }
    __syncthreads();
}

#ifndef MK_MULTI
#define MK_MULTI 0
#endif
__device__ __forceinline__ void xcd_barrier(const XcdBarrier& b) { xcd_barrier1(b); if (PROBE & 8192) xcd_barrier1(b); }
#if MK_MULTI
template <int PH> __global__ void __launch_bounds__(NTHREADS, 2) k_phase(Params Pv, int l) {
    extern __shared__ __attribute__((aligned(16))) unsigned char smem[];
    CP& P = *(CP*)__builtin_amdgcn_kernarg_segment_ptr();
    run_phase<PH>(P, l, smem);
}
#else
template <int PH> static __device__ __forceinline__ void phase_ni(int l, int rep = 0) {
    extern __shared__ __attribute__((aligned(16))) unsigned char smem[];
    CP& P = *(CP*)__builtin_amdgcn_kernarg_segment_ptr();
    run_phase<PH>(P, l, smem, rep);
}
__global__ void __launch_bounds__(NTHREADS, 2) k_mega(Params Pv) {
    extern __shared__ __attribute__((aligned(16))) unsigned char smem[];
    CP& P = *(CP*)__builtin_amdgcn_kernarg_segment_ptr();
    volatile LDSP unsigned* xbw = (volatile LDSP unsigned*)(smem + SMEM_BYTES);
    if (threadIdx.x == 0) { xbw[0] = 0u; xbw[1] = 0u; xbw[2] = 0u; xbw[3] = 0u; }
    __syncthreads();
    XcdBarrier bar = xcd_barrier_post(P.bar, xbw);
    phase_ni<0>(0); xcd_barrier(bar);
    phase_ni<1>(0); xcd_barrier(bar);
#pragma clang loop unroll(disable)
    for (int l = 0; l < NL; ++l) {
        phase_ni<2>(l); xcd_barrier(bar); if (WPROBE == 2) { phase_ni<2>(l, 1); xcd_barrier(bar); }
        phase_ni<3>(l); xcd_barrier(bar); if (WPROBE == 3) { phase_ni<3>(l, 1); xcd_barrier(bar); }
        phase_ni<4>(l); xcd_barrier(bar); if (WPROBE == 4) { phase_ni<4>(l, 1); xcd_barrier(bar); }
        phase_ni<5>(l); xcd_barrier(bar); if (WPROBE == 5) { phase_ni<5>(l, 1); xcd_barrier(bar); }
        phase_ni<6>(l); xcd_barrier(bar); if (WPROBE == 6) { phase_ni<6>(l, 1); xcd_barrier(bar); }
        phase_ni<7>(l); xcd_barrier(bar); if (WPROBE == 7) { phase_ni<7>(l, 1); xcd_barrier(bar); }
        phase_ni<8>(l); xcd_barrier(bar); if (WPROBE == 8) { phase_ni<8>(l, 1); xcd_barrier(bar); }
        phase_ni<9>(l); xcd_barrier(bar); if (WPROBE == 9) { phase_ni<9>(l, 1); xcd_barrier(bar); }
        phase_ni<10>(l); if (WPROBE == 10) { xcd_barrier(bar); phase_ni<10>(l, 1); } if (l + 1 < NL) xcd_barrier(bar);
    }
}
#endif
#endif

struct Carver { unsigned char* base; size_t off; template <class T> T* take(size_t n) { off = (off + 255) & ~(size_t)255; T* p = (T*)(base + off); off += n * sizeof(T); return p; } };
static inline size_t carve_ws(Params& P, void* d_ws) {
    Carver c{(unsigned char*)d_ws, 0};
    P.bar = c.take<unsigned>(4096);
    P.xs = c.take<half_t>((size_t)NT * D);
    P.mod = c.take<float>((size_t)NL * (B_ + 1) * MODW);
    P.hglb = c.take<float>(NL * 256);
    P.rope = c.take<float>((size_t)SEQ * 32);
    P.wr = c.take<float>((size_t)NL * D * 48);
    P.cshift = c.take<float>(NL * (B_ + 1) * 48);
    P.cnt = c.take<int>(NL * NEXP);
    P.sched = c.take<int>(NL * 16);
    P.list_tok = c.take<int>((size_t)NEXP * NT);
    P.list_gate = c.take<float>((size_t)NEXP * NT);
    P.tokslot = c.take<int>((size_t)NT * 2);
    P.gst = c.take<float>((size_t)2 * B_ * 4 * 2 * NCH * 4096);
    P.gdec = c.take<float>((size_t)2 * B_ * 4 * 2 * NCH * 64);
    P.win16 = c.take<half_t>((size_t)NL * D * PPAD);
    P.wout16 = c.take<half_t>((size_t)NL * D * D);
    P.wuq16 = c.take<half_t>((size_t)NL * 192 * 384);
    P.wukv16 = c.take<half_t>((size_t)NL * 128 * 512);
    P.h = c.take<half_t>((size_t)NT * D);
    P.p = c.take<half_t>((size_t)NT * PPAD);
    P.yrows = P.p;
    P.y = c.take<half_t>((size_t)NT * D);
    P.qraw = c.take<half_t>((size_t)NT * 384);
    P.kvraw = c.take<half_t>((size_t)NT * 512);
    P.mq = c.take<half_t>((size_t)B_ * 4 * KEYS * 96);
    P.mk = c.take<half_t>((size_t)B_ * 4 * KEYS * 96);
    P.mv = c.take<half_t>((size_t)B_ * 4 * KEYS * 64);
    P.nq = c.take<half_t>((size_t)B_ * 4 * KEYS * 64);
    P.nk = c.take<half_t>((size_t)B_ * 4 * KEYS * 64);
    P.nv = c.take<half_t>((size_t)B_ * 4 * KEYS * 64);
    P.act = c.take<half_t>((size_t)ACT_ROWS * 512);
    P.w13h = c.take<half_t>((size_t)NEXP * D * 1024);
    P.w2h = c.take<half_t>((size_t)NEXP * 512 * D);
    return c.off;
}
static inline void fill_inputs(Params& P, void* const* d_in, void* d_out) {
    const float* const* in = (const float* const*)d_in;
    P.x = in[0]; P.c = in[1]; P.ctx = in[2]; P.c_ctx = in[3]; P.w_ada = in[4]; P.b_ada = in[5]; P.w_in = in[6]; P.w_out = in[7];
    P.mla_g_cq = in[8]; P.mla_g_ckv = in[9]; P.mla_w_uq = in[10]; P.mla_w_ukv = in[11]; P.mla_g_qn = in[12]; P.mla_g_qr = in[13];
    P.mla_g_kn = in[14]; P.mla_g_kr = in[15]; P.na_g_q = in[16]; P.na_g_k = in[17]; P.na_rpb = in[18]; P.ret_g_out = in[19];
    P.hg_lb_raw = in[20]; P.hg_g_out = in[21]; P.moe_w_rg = in[22]; P.moe_b_rg = in[23]; P.moe_w_re = in[24]; P.moe_b_re = in[25];
    P.moe_w1 = in[26]; P.moe_w3 = in[27]; P.moe_w2 = in[28];
    P.out = (float*)d_out;
}

#ifndef CPU_EMU
extern "C" void kernel_launch(void* const* d_in, const int* in_sizes, int n_in, void* d_out, int out_size, void* d_ws, size_t ws_size, hipStream_t stream) {
    Params P{};
    fill_inputs(P, d_in, d_out);
    carve_ws(P, d_ws);
    constexpr size_t kDynLds = SMEM_BYTES + 16;
    static int grid = 0;
    if (!grid) {
        int dev = 0, cus = 0, per_cu = 0;
        (void)hipGetDevice(&dev);
        (void)hipDeviceGetAttribute(&cus, hipDeviceAttributeMultiprocessorCount, dev);
        #if MK_MULTI
        (void)hipOccupancyMaxActiveBlocksPerMultiprocessor(&per_cu, k_phase<5>, NTHREADS, kDynLds);
#else
        (void)hipFuncSetAttribute((const void*)k_mega, hipFuncAttributeMaxDynamicSharedMemorySize, (int)kDynLds);
        (void)hipOccupancyMaxActiveBlocksPerMultiprocessor(&per_cu, k_mega, NTHREADS, kDynLds);
#endif
        if (per_cu < 1) per_cu = 1;
        grid = cus * (per_cu < 2 ? per_cu : 2);
    }
#if MK_MULTI
    k_phase<0><<<grid, NTHREADS, kDynLds, stream>>>(P, 0);
    k_phase<1><<<grid, NTHREADS, kDynLds, stream>>>(P, 0);
    for (int l = 0; l < NL; ++l) {
        k_phase<2><<<grid, NTHREADS, kDynLds, stream>>>(P, l);
        k_phase<3><<<grid, NTHREADS, kDynLds, stream>>>(P, l);
        k_phase<4><<<grid, NTHREADS, kDynLds, stream>>>(P, l);
        k_phase<5><<<grid, NTHREADS, kDynLds, stream>>>(P, l);
        k_phase<6><<<grid, NTHREADS, kDynLds, stream>>>(P, l);
        k_phase<7><<<grid, NTHREADS, kDynLds, stream>>>(P, l);
        k_phase<8><<<grid, NTHREADS, kDynLds, stream>>>(P, l);
        k_phase<9><<<grid, NTHREADS, kDynLds, stream>>>(P, l);
        k_phase<10><<<grid, NTHREADS, kDynLds, stream>>>(P, l);
    }
#else
    (void)hipMemsetAsync(P.bar, 0, XCD_BAR_WORDS * sizeof(unsigned), stream);
    k_mega<<<grid, NTHREADS, kDynLds, stream>>>(P);
#endif
}
#endif
```
